# Optimizing an MI355X kernel written in HIP

```python
import jax, jax.numpy as jnp
from jax import lax
import numpy as np

D_MODEL = 2048
BATCH = 4
SEQ = 2048
DEPTH = 1
DEC_BATCH = 128
DEC_SEQ = 4
PAST_LEN = 16384
PAGE_SIZE = 128

EXPAND = 2
D_MIX = EXPAND * D_MODEL
D_POOL = D_MIX // 4
POOL_WINDOWS = (2, 4, 8, 16)
POOL_GROUP = D_POOL // len(POOL_WINDOWS)
POOL_HIST = max(POOL_WINDOWS) - 1
D_SSM = D_MIX - D_POOL
SSM_HEAD_DIM = 64
SSM_HEADS = D_SSM // SSM_HEAD_DIM
SSM_GROUPS = 8
D_STATE = 128
CONV_WIDTH = 4
D_CONV = D_SSM + 2 * SSM_GROUPS * D_STATE
SSD_CHUNK = 128
D_IN_PROJ = 2 * D_POOL + D_SSM + D_CONV + SSM_HEADS
EPS = 1e-5

kernel_name = "pool_ssd_hybrid_step"


def rmsnorm(x, g):
    xf = x.astype(jnp.float32)
    y = xf * lax.rsqrt(jnp.mean(xf * xf, axis=-1, keepdims=True) + EPS) * g.astype(jnp.float32)
    return y.astype(x.dtype)


def pool_mix(u, hist, start_pos):
    L = u.shape[1]
    uf = u.astype(jnp.float32)
    ext = jnp.concatenate([hist.astype(jnp.float32), uf], axis=1)
    cs = jnp.cumsum(jnp.pad(ext, ((0, 0), (1, 0), (0, 0))), axis=1)
    pos = start_pos + jnp.arange(L)
    outs = []
    for gi, w in enumerate(POOL_WINDOWS):
        lo_c, hi_c = gi * POOL_GROUP, (gi + 1) * POOL_GROUP
        hi = cs[:, POOL_HIST + 1:POOL_HIST + 1 + L, lo_c:hi_c]
        lo = cs[:, POOL_HIST + 1 - w:POOL_HIST + 1 - w + L, lo_c:hi_c]
        cnt = jnp.minimum(w, pos + 1).astype(jnp.float32)[None, :, None]
        outs.append((hi - lo) / cnt - uf[:, :, lo_c:hi_c])
    pooled = jnp.stack(outs, axis=2)
    new_hist = ext[:, -POOL_HIST:].astype(hist.dtype)
    return pooled, new_hist


def ssd_scan(x, dt, a, b_in, c_in, s0):
    bsz, L, H, P = x.shape
    G, N = b_in.shape[2], b_in.shape[3]
    R = H // G
    chunk = SSD_CHUNK if L % SSD_CHUNK == 0 else L
    nc = L // chunk
    xc = x.astype(jnp.float32).reshape(bsz, nc, chunk, G, R, P)
    dtc = dt.reshape(bsz, nc, chunk, G, R)
    bc = b_in.astype(jnp.float32).reshape(bsz, nc, chunk, G, N)
    cc = c_in.astype(jnp.float32).reshape(bsz, nc, chunk, G, N)
    a_cum = jnp.cumsum(dtc * a.reshape(G, R), axis=2)
    seg = a_cum[:, :, :, None] - a_cum[:, :, None, :]
    causal = jnp.tril(jnp.ones((chunk, chunk), dtype=bool))[None, None, :, :, None, None]
    decay = jnp.exp(jnp.where(causal, seg, -jnp.inf))
    cb = jnp.einsum('bclgn,bcsgn->bclsg', cc, bc)
    scores = cb[..., None] * decay * dtc[:, :, None]
    y_diag = jnp.einsum('bclsgr,bcsgrp->bclgrp', scores, xc)
    decay_to_end = jnp.exp(a_cum[:, :, -1:] - a_cum)
    chunk_states = jnp.einsum('bclgn,bclgr,bclgrp->bcgrpn', bc, decay_to_end * dtc, xc)
    chunk_decay = jnp.exp(a_cum[:, :, -1])

    def step(s, inp):
        dec, st = inp
        return dec[..., None, None] * s + st, s

    s_init = s0.astype(jnp.float32).reshape(bsz, G, R, P, N)
    s_final, s_ins = lax.scan(step, s_init,
                              (jnp.moveaxis(chunk_decay, 1, 0), jnp.moveaxis(chunk_states, 1, 0)))
    s_ins = jnp.moveaxis(s_ins, 0, 1)
    y_off = jnp.einsum('bclgn,bcgrpn,bclgr->bclgrp', cc, s_ins, jnp.exp(a_cum))
    y = (y_diag + y_off).reshape(bsz, L, H, P)
    return y, s_final.reshape(bsz, H, P, N)


def hybrid_layer(x, pool_hist, conv_hist, ssm_state, start_pos, norm_g, w_in, conv_w, conv_b,
                 dt_bias, a_log, d_skip, ssm_norm_g, pool_w, pool_scale, w_out):
    bsz, L, _ = x.shape
    h = rmsnorm(x, norm_g)
    proj = h @ w_in
    o1 = D_POOL
    o2 = 2 * D_POOL
    o3 = o2 + D_SSM
    o4 = o3 + D_CONV
    u, gate, z, xbc, dt_raw = jnp.split(proj, [o1, o2, o3, o4], axis=-1)

    pooled, new_pool = pool_mix(u, pool_hist, start_pos)
    mixed = jnp.einsum('blgc,gcd->blgd', pooled, pool_w.astype(jnp.float32)).reshape(bsz, L, D_POOL)
    out_a = (mixed * pool_scale.astype(jnp.float32) * jax.nn.silu(gate.astype(jnp.float32))).astype(x.dtype)

    ext = jnp.concatenate([conv_hist.astype(xbc.dtype), xbc], axis=1)
    conv = conv_b + sum(ext[:, k:k + L] * conv_w[k] for k in range(CONV_WIDTH))
    new_conv = ext[:, -(CONV_WIDTH - 1):].astype(conv_hist.dtype)
    xbc_c = jax.nn.silu(conv)
    xs, bs, cs = jnp.split(xbc_c, [D_SSM, D_SSM + SSM_GROUPS * D_STATE], axis=-1)
    dt = jax.nn.softplus(dt_raw.astype(jnp.float32) + dt_bias.astype(jnp.float32))
    a = -jnp.exp(a_log.astype(jnp.float32))
    xh = xs.reshape(bsz, L, SSM_HEADS, SSM_HEAD_DIM)
    y, new_ssm = ssd_scan(xh, dt, a,
                          bs.reshape(bsz, L, SSM_GROUPS, D_STATE),
                          cs.reshape(bsz, L, SSM_GROUPS, D_STATE), ssm_state)
    y = y + d_skip.astype(jnp.float32)[:, None] * xh.astype(jnp.float32)
    yz = y.reshape(bsz, L, D_SSM) * jax.nn.silu(z.astype(jnp.float32))
    yz = yz.reshape(bsz, L, SSM_GROUPS, D_SSM // SSM_GROUPS)
    yz = yz * lax.rsqrt(jnp.mean(yz * yz, axis=-1, keepdims=True) + EPS)
    out_b = (yz.reshape(bsz, L, D_SSM) * ssm_norm_g.astype(jnp.float32)).astype(x.dtype)

    out = jnp.concatenate([out_a, out_b], axis=-1) @ w_out
    return x + out, new_pool, new_conv, new_ssm.astype(ssm_state.dtype)


def setup_inputs(seed: int = 0) -> dict:
    key = jax.random.key(seed)
    ks = jax.random.split(key, 20)
    f32 = jnp.float32
    x_prompt = jax.random.normal(ks[0], (BATCH, SEQ, D_MODEL), f32)
    x_sample = jax.random.normal(ks[1], (DEC_BATCH, DEC_SEQ, D_MODEL), f32)
    state_pool = jax.random.normal(ks[2], (DEPTH, DEC_BATCH, POOL_HIST, D_POOL), f32)
    state_conv = jax.random.normal(ks[3], (DEPTH, DEC_BATCH, CONV_WIDTH - 1, D_CONV), f32)
    state_ssm = 0.5 * jax.random.normal(ks[4], (DEPTH, DEC_BATCH, SSM_HEADS, SSM_HEAD_DIM, D_STATE), f32)
    norm_g = 1.0 + 0.02 * jax.random.normal(ks[5], (DEPTH, D_MODEL), f32)
    w_in = jax.random.normal(ks[6], (DEPTH, D_MODEL, D_IN_PROJ), f32) * D_MODEL ** -0.5
    conv_w = jax.random.normal(ks[7], (DEPTH, CONV_WIDTH, D_CONV), f32) * CONV_WIDTH ** -0.5
    conv_b = 0.01 * jax.random.normal(ks[8], (DEPTH, D_CONV), f32)
    dt0 = jnp.exp(jax.random.uniform(ks[9], (DEPTH, SSM_HEADS), f32)
                  * (jnp.log(0.1) - jnp.log(0.001)) + jnp.log(0.001))
    dt_bias = dt0 + jnp.log(-jnp.expm1(-dt0))
    a_log = jnp.log(jax.random.uniform(ks[10], (DEPTH, SSM_HEADS), f32, 1.0, 16.0))
    d_skip = 1.0 + 0.02 * jax.random.normal(ks[11], (DEPTH, SSM_HEADS), f32)
    ssm_norm_g = 1.0 + 0.02 * jax.random.normal(ks[12], (DEPTH, D_SSM), f32)
    pool_w = jax.random.normal(ks[13], (DEPTH, len(POOL_WINDOWS), POOL_GROUP, POOL_GROUP), f32) * POOL_GROUP ** -0.5
    pool_scale = 1.0 + 0.02 * jax.random.normal(ks[14], (DEPTH, D_POOL), f32)
    w_out = jax.random.normal(ks[15], (DEPTH, D_MIX, D_MODEL), f32) * D_MIX ** -0.5
    final_g = 1.0 + 0.02 * jax.random.normal(ks[16], (D_MODEL,), f32)
    return {"x_prompt": x_prompt, "x_sample": x_sample, "state_pool": state_pool,
            "state_conv": state_conv, "state_ssm": state_ssm, "norm_g": norm_g, "w_in": w_in,
            "conv_w": conv_w, "conv_b": conv_b, "dt_bias": dt_bias, "a_log": a_log,
            "d_skip": d_skip, "ssm_norm_g": ssm_norm_g, "pool_w": pool_w,
            "pool_scale": pool_scale, "w_out": w_out, "final_g": final_g}


def reference(x_prompt, x_sample, state_pool, state_conv, state_ssm, norm_g, w_in, conv_w, conv_b,
              dt_bias, a_log, d_skip, ssm_norm_g, pool_w, pool_scale, w_out, final_g):
    bp = x_prompt.shape[0]
    hp = x_prompt
    hs = x_sample
    pool_p, conv_p, ssm_p = [], [], []
    pool_s, conv_s, ssm_s = [], [], []
    for layer in range(DEPTH):
        params = (norm_g[layer], w_in[layer], conv_w[layer], conv_b[layer], dt_bias[layer],
                  a_log[layer], d_skip[layer], ssm_norm_g[layer], pool_w[layer],
                  pool_scale[layer], w_out[layer])
        zp_pool = jnp.zeros((bp, POOL_HIST, D_POOL), state_pool.dtype)
        zp_conv = jnp.zeros((bp, CONV_WIDTH - 1, D_CONV), state_conv.dtype)
        zp_ssm = jnp.zeros((bp, SSM_HEADS, SSM_HEAD_DIM, D_STATE), state_ssm.dtype)
        hp, npool, nconv, nssm = hybrid_layer(hp, zp_pool, zp_conv, zp_ssm, 0, *params)
        pool_p.append(npool)
        conv_p.append(nconv)
        ssm_p.append(nssm)
        hs, npool, nconv, nssm = hybrid_layer(hs, state_pool[layer], state_conv[layer],
                                              state_ssm[layer], PAST_LEN, *params)
        pool_s.append(npool)
        conv_s.append(nconv)
        ssm_s.append(nssm)
    y_prompt = rmsnorm(hp, final_g)
    y_sample = rmsnorm(hs, final_g)
    return (y_prompt, y_sample,
            jnp.stack(pool_p, 0), jnp.stack(conv_p, 0), jnp.stack(ssm_p, 0),
            jnp.stack(pool_s, 0), jnp.stack(conv_s, 0), jnp.stack(ssm_s, 0))
```

```cpp
#include <hip/hip_runtime.h>
#include <cstdio>
#include <cstdint>
namespace pg8 {
#define PG8_LAS __attribute__((address_space(3)))
typedef unsigned short bf16_t;
typedef short bf16x8 __attribute__((ext_vector_type(8)));
typedef float f32x4 __attribute__((ext_vector_type(4)));
typedef unsigned u32x4 __attribute__((ext_vector_type(4)));
constexpr int BM = 256, BK = 64, HALF = 128, HTB = HALF * BK * 2  , STAGE_BYTES = 8 * HTB, NXCD = 8, WGM = 8;

__host__ __device__ __forceinline__ int lds_byte(int r, int c) { const int st = (r >> 4) * 2 + (c >> 5), rr = r & 15, cc = c & 31, ob = rr * 64 + cc * 2; return st * 1024 + (ob ^ (((ob >> 9) & 1) << 5)); }
__host__ __device__ __forceinline__ void stage_rc(int b, int& R, int& C) { const int st = b / 1024, sb = b % 1024, swz = sb ^ (((sb >> 9) & 1) << 5); R = (st >> 1) * 16 + swz / 64; C = (st & 1) * 32 + (swz % 64) / 2; }
__host__ __device__ __forceinline__ int perm32(int rho) { const int n = rho >> 4, i = rho & 15; return 8 * (i >> 2) + 4 * n + (i & 3); }

struct Unit { int pm, pn; };
struct Gemm { const bf16_t* A; const bf16_t* Bt; int M, N, K; };

struct StaticOrder {
    int nM, nN, nwg, G, c;
    __host__ __device__ void init(int M, int N, int G_, int c_) { nM = M / BM; nN = N / BM; nwg = nM * nN; G = G_; c = c_; }
    __host__ __device__ bool next(int i, Unit& u) const {
        const long L = (long)i * G + c; if (L >= nwg) return false;
        int wgid = (int)L; { const int q = nwg / NXCD, r = nwg % NXCD, xcd = wgid % NXCD, off = wgid / NXCD; wgid = (xcd < r ? xcd * (q + 1) : r * (q + 1) + (xcd - r) * q) + off; }
        const int nig = WGM * nN, gid = wgid / nig, fm = gid * WGM, gsz = (nM - fm) < WGM ? (nM - fm) : WGM;
        u.pm = fm + ((wgid % nig) % gsz); u.pn = (wgid % nig) / gsz; return true;
    }
    __device__ __forceinline__ void a_ready(const Unit&) const {}
    __device__ __forceinline__ void done(const Unit&) const {}
};

__device__ __forceinline__ unsigned cvt_pk_bf16(float lo, float hi) { unsigned r; asm volatile("v_cvt_pk_bf16_f32 %0, %1, %2" : "=v"(r) : "v"(lo), "v"(hi)); return r; }

struct EpiProj {
    static constexpr bool PERM = true, AFTER_DRAIN = false;
    bf16_t* P; float* dtraw;
    __device__ __forceinline__ void operator()(const f32x4 (&acc)[2][2][4][2], const Unit& u, int wr, int wc, int fr, int fq) const {
        const int row0 = u.pm * BM + wr * 64 + fr;
        if (u.pn < 40) {
            const int col0 = u.pn * BM + wc * 32 + 8 * fq;
#pragma unroll
            for (int ai = 0; ai < 2; ++ai)
#pragma unroll
                for (int m = 0; m < 4; ++m) { bf16_t* rowp = P + (size_t)(row0 + ai * HALF + m * 16) * 10240 + col0;
#pragma unroll
                    for (int bj = 0; bj < 2; ++bj) { const f32x4 v0 = acc[ai][bj][m][0], v1 = acc[ai][bj][m][1];
                        u32x4 w; w.x = cvt_pk_bf16(v0[0], v0[1]); w.y = cvt_pk_bf16(v0[2], v0[3]); w.z = cvt_pk_bf16(v1[0], v1[1]); w.w = cvt_pk_bf16(v1[2], v1[3]);
                        *(u32x4*)(rowp + bj * HALF) = w; } }
        } else if (wc < 2) {
#pragma unroll
            for (int ai = 0; ai < 2; ++ai)
#pragma unroll
                for (int m = 0; m < 4; ++m) { float* rp = dtraw + (size_t)(row0 + ai * HALF + m * 16) * 64 + wc * 32 + 8 * fq;
                    *(f32x4*)rp = acc[ai][0][m][0]; *(f32x4*)(rp + 4) = acc[ai][0][m][1]; }
        }
    }
};
struct EpiOut {
    static constexpr bool PERM = false, AFTER_DRAIN = false;
    const float* xp; const float* xs; float* out;
    __device__ __forceinline__ void operator()(const f32x4 (&acc)[2][2][4][2], const Unit& u, int wr, int wc, int fr, int fq) const {
        const int row0 = u.pm * BM + wr * 64 + fr, col0 = u.pn * BM + wc * 32 + 4 * fq;
        const float* xb = (u.pm < 32) ? xp : xs - (size_t)8192 * 2048;
#pragma unroll
        for (int ai = 0; ai < 2; ++ai)
#pragma unroll
            for (int m = 0; m < 4; ++m) { const size_t ro = (size_t)(row0 + ai * HALF + m * 16) * 2048 + col0;
#pragma unroll
                for (int bj = 0; bj < 2; ++bj)
#pragma unroll
                    for (int n = 0; n < 2; ++n) { const f32x4 xv = *(const f32x4*)(xb + ro + bj * HALF + n * 16);
                        *(f32x4*)(out + ro + bj * HALF + n * 16) = xv + acc[ai][bj][m][n]; } }
    }
};

template <class Epi, class Sched, bool ALIGN_EPI = false, bool SP2 = false>
__device__ __forceinline__ void gemm_phase(PG8_LAS unsigned char* lds, const Gemm g, const Sched& S, const Epi& E) {
    const int tid = threadIdx.x, wid = __builtin_amdgcn_readfirstlane(tid >> 6), lane = tid & 63, wr = wid >> 2, wc = wid & 3, fr = lane & 15, fq = lane >> 4;
    const int K = g.K, nt = K / BK;
    unsigned voffA[2], voffB[2];
#pragma unroll
    for (int i = 0; i < 2; ++i) { int R, C; stage_rc(tid * 16 + i * 8192, R, C); const int Rb = Epi::PERM ? ((R & ~31) + perm32(R & 31)) : R;
        voffA[i] = (unsigned)(R * K + C) * 2u; voffB[i] = (unsigned)(Rb * K + C) * 2u; }
    const size_t kstep = (size_t)(BK * 2);
    const size_t hstep = (size_t)HALF * K * 2;
    const size_t tstep = 2 * hstep;
    const unsigned ldsw = (unsigned)wid * 1024u;
    const int aoff = lds_byte(wr * 64 + fr, fq * 8), boff = lds_byte(wc * 32 + fr, fq * 8);
#define PG8_SA(b, h) (((b) * 2 + (h)) * HTB)
#define PG8_SB(b, h) ((4 + (b) * 2 + (h)) * HTB)
#define PG8_STAGE(bufoff, gbase, voff) do { _Pragma("unroll") for (int _i = 0; _i < 2; ++_i) \
        __builtin_amdgcn_global_load_lds((const unsigned*)((const char*)(gbase) + (voff)[_i]), (PG8_LAS unsigned*)(lds + (bufoff) + ldsw + _i * 8192), 16, 0, 0); } while (0)
#define PG8_LDA(dst, b, h) do { _Pragma("unroll") for (int m = 0; m < 4; ++m) _Pragma("unroll") for (int k = 0; k < 2; ++k) dst[m][k] = *(const PG8_LAS bf16x8*)(lds + PG8_SA(b, h) + aoff + m * 2048 + k * 1024); } while (0)
#define PG8_LDB(dst, b, h) do { _Pragma("unroll") for (int n = 0; n < 2; ++n) _Pragma("unroll") for (int k = 0; k < 2; ++k) dst[n][k] = *(const PG8_LAS bf16x8*)(lds + PG8_SB(b, h) + boff + n * 2048 + k * 1024); } while (0)
#define PG8_MMA(ai, bj, At, Bt) do { __builtin_amdgcn_s_setprio(1); _Pragma("unroll") for (int m = 0; m < 4; ++m) _Pragma("unroll") for (int n = 0; n < 2; ++n) _Pragma("unroll") for (int k = 0; k < 2; ++k) \
        acc[ai][bj][m][n] = __builtin_amdgcn_mfma_f32_16x16x32_bf16(Bt[n][k], At[m][k], acc[ai][bj][m][n], 0, 0, 0); __builtin_amdgcn_s_setprio(0); } while (0)
#define PG8_WAIT_V(n) asm volatile("s_waitcnt vmcnt(" #n ")" ::: "memory")
#define PG8_WAIT_L(n) asm volatile("s_waitcnt lgkmcnt(" #n ")" ::: "memory")
#define PG8_BAR __builtin_amdgcn_s_barrier()
#define PG8_SCHED __builtin_amdgcn_sched_barrier(0)
    Unit cur, nxt; int ui = 0;
    if (!S.next(0, cur)) return;
    f32x4 acc[2][2][4][2];
#pragma unroll
    for (int a = 0; a < 2; ++a)
#pragma unroll
        for (int b = 0; b < 2; ++b)
#pragma unroll
            for (int m = 0; m < 4; ++m)
#pragma unroll
                for (int n = 0; n < 2; ++n) acc[a][b][m][n] = (f32x4){0.f, 0.f, 0.f, 0.f};
    bf16x8 At[4][2], B0[2][2], B1[2][2];
    const char* cA = (const char*)g.A + (size_t)cur.pm * tstep; const char* cB = (const char*)g.Bt + (size_t)cur.pn * tstep;
    S.a_ready(cur);
    if constexpr (SP2) {
        PG8_STAGE(PG8_SB(0, 0), cB, voffB); PG8_STAGE(PG8_SB(0, 1), cB + hstep, voffB); PG8_STAGE(PG8_SA(0, 0), cA, voffA); PG8_STAGE(PG8_SA(0, 1), cA + hstep, voffA);
        if (wr == 1) PG8_BAR;
        PG8_WAIT_V(2); PG8_BAR;
        PG8_STAGE(PG8_SB(1, 0), cB + kstep, voffB); PG8_STAGE(PG8_SA(1, 0), cA + kstep, voffA); PG8_STAGE(PG8_SB(1, 1), cB + hstep + kstep, voffB);
        PG8_WAIT_V(6); PG8_BAR;
    } else {
        PG8_STAGE(PG8_SB(0, 0), cB, voffB); PG8_STAGE(PG8_SA(0, 0), cA, voffA); PG8_STAGE(PG8_SB(0, 1), cB + hstep, voffB); PG8_STAGE(PG8_SA(0, 1), cA + hstep, voffA);
        if (wr == 1) PG8_BAR;
        PG8_WAIT_V(4); PG8_BAR;
        PG8_STAGE(PG8_SB(1, 0), cB + kstep, voffB); PG8_STAGE(PG8_SA(1, 0), cA + kstep, voffA); PG8_STAGE(PG8_SB(1, 1), cB + hstep + kstep, voffB);
        PG8_WAIT_V(6); PG8_BAR;
    }
    for (;;) {
        const bool has_next = S.next(ui + 1, nxt);
        const char* nA = has_next ? (const char*)g.A + (size_t)nxt.pm * tstep : cA; const char* nB = has_next ? (const char*)g.Bt + (size_t)nxt.pn * tstep : cB;
        for (int t = 0; t < nt; t += 2) {
            const bool last = (t == nt - 2);
            const char* a1 = cA + (size_t)(t + 1) * kstep;
            const char* a2 = last ? nA : cA + (size_t)(t + 2) * kstep; const char* b2 = last ? nB : cB + (size_t)(t + 2) * kstep;
            const char* a3 = a2 + kstep; const char* b3 = b2 + kstep;
            if (last && has_next) S.a_ready(nxt);
            if constexpr (SP2) {
            PG8_LDB(B0, 0, 0); PG8_LDB(B1, 0, 1); PG8_SCHED; PG8_LDA(At, 0, 0); PG8_STAGE(PG8_SA(1, 1), a1 + hstep, voffA);
            PG8_WAIT_V(8); PG8_WAIT_L(0); PG8_BAR; PG8_MMA(0, 0, At, B0); PG8_MMA(0, 1, At, B1); PG8_BAR; PG8_SCHED;
            PG8_LDA(At, 0, 1); PG8_STAGE(PG8_SB(0, 0), b2, voffB); PG8_STAGE(PG8_SB(0, 1), b2 + hstep, voffB); PG8_STAGE(PG8_SA(0, 0), a2, voffA);
            PG8_WAIT_V(8); PG8_WAIT_L(0); PG8_BAR; PG8_MMA(1, 0, At, B0); PG8_MMA(1, 1, At, B1); PG8_BAR; PG8_SCHED;
            PG8_LDB(B0, 1, 0); PG8_LDB(B1, 1, 1); PG8_SCHED; PG8_LDA(At, 1, 0); PG8_STAGE(PG8_SA(0, 1), a2 + hstep, voffA);
            PG8_WAIT_V(8); PG8_WAIT_L(0); PG8_BAR; PG8_MMA(0, 0, At, B0); PG8_MMA(0, 1, At, B1); PG8_BAR; PG8_SCHED;
            PG8_LDA(At, 1, 1); PG8_STAGE(PG8_SB(1, 0), b3, voffB); PG8_STAGE(PG8_SB(1, 1), b3 + hstep, voffB); PG8_STAGE(PG8_SA(1, 0), a3, voffA);
            PG8_WAIT_V(8); PG8_WAIT_L(0); PG8_BAR; PG8_MMA(1, 0, At, B0); PG8_MMA(1, 1, At, B1); PG8_BAR; PG8_SCHED;
            } else {
            PG8_LDB(B0, 0, 0); PG8_SCHED; PG8_LDA(At, 0, 0); PG8_STAGE(PG8_SA(1, 1), a1 + hstep, voffA);
            PG8_WAIT_L(8); PG8_BAR; PG8_WAIT_L(0); PG8_MMA(0, 0, At, B0); PG8_BAR; PG8_SCHED;
            PG8_LDB(B1, 0, 1); PG8_STAGE(PG8_SB(0, 0), b2, voffB);
            PG8_BAR; PG8_WAIT_L(0); PG8_MMA(0, 1, At, B1); PG8_BAR;
            PG8_LDA(At, 0, 1); PG8_STAGE(PG8_SA(0, 0), a2, voffA);
            PG8_BAR; PG8_WAIT_L(0); PG8_MMA(1, 0, At, B0); PG8_BAR; PG8_SCHED;
            PG8_STAGE(PG8_SB(0, 1), b2 + hstep, voffB);
            PG8_WAIT_V(6); PG8_BAR; PG8_MMA(1, 1, At, B1); PG8_BAR;
            PG8_LDB(B0, 1, 0); PG8_SCHED; PG8_LDA(At, 1, 0); PG8_STAGE(PG8_SA(0, 1), a2 + hstep, voffA);
            PG8_WAIT_L(8); PG8_BAR; PG8_WAIT_L(0); PG8_MMA(0, 0, At, B0); PG8_BAR; PG8_SCHED;
            PG8_LDB(B1, 1, 1); PG8_STAGE(PG8_SB(1, 0), b3, voffB);
            PG8_BAR; PG8_WAIT_L(0); PG8_MMA(0, 1, At, B1); PG8_BAR;
            PG8_LDA(At, 1, 1); PG8_STAGE(PG8_SA(1, 0), a3, voffA);
            PG8_BAR; PG8_WAIT_L(0); PG8_MMA(1, 0, At, B0); PG8_BAR; PG8_SCHED;
            PG8_STAGE(PG8_SB(1, 1), b3 + hstep, voffB);
            PG8_WAIT_V(6); PG8_BAR; PG8_MMA(1, 1, At, B1); PG8_BAR;
            }
        }
        if constexpr (ALIGN_EPI) { if (wr == 0) PG8_BAR; }
        if constexpr (!Epi::AFTER_DRAIN) { E(acc, cur, wr, wc, fr, fq); S.done(cur); }
        if (!has_next) break;
#pragma unroll
        for (int a = 0; a < 2; ++a)
#pragma unroll
            for (int b = 0; b < 2; ++b)
#pragma unroll
                for (int m = 0; m < 4; ++m)
#pragma unroll
                    for (int n = 0; n < 2; ++n) acc[a][b][m][n] = (f32x4){0.f, 0.f, 0.f, 0.f};
        cur = nxt; cA = nA; cB = nB; ++ui;
        if constexpr (ALIGN_EPI) { if (wr == 1) PG8_BAR; }
    }
    PG8_WAIT_V(0);
    if constexpr (!ALIGN_EPI) { if (wr == 0) PG8_BAR; }
    PG8_BAR;
    if constexpr (Epi::AFTER_DRAIN) { E.fused(acc, cur, wr, wc, fr, fq, lds, wid, lane); S.done(cur); }
#undef PG8_SA
#undef PG8_SB
#undef PG8_STAGE
#undef PG8_LDA
#undef PG8_LDB
#undef PG8_MMA
#undef PG8_WAIT_V
#undef PG8_WAIT_L
#undef PG8_BAR
#undef PG8_SCHED
}

}

constexpr int DMODEL = 2048, NPR = 8192  , NSM = 512  , MROWS = NPR + NSM;
constexpr int DPOOL = 1024, DSSM = 3072, DCONV = 5120, NHEAD = 48, HDIM = 64, NGRP = 8, DSTATE = 128, DMIX = 4096;
constexpr int NPROJ = 10288, PLD = 10240  , NPROJ_PAD = 10496  ;
constexpr int C_GATE = 1024, C_Z = 2048, C_XBC = 5120;
constexpr float EPS = 1e-5f;
constexpr size_t O_Y = 0, O_POOL_P = 17825792, O_CONV_P = 17887232, O_SSM_P = 17948672, O_POOL_S = 19521536, O_CONV_S = 21487616, O_SSM_S = 23453696;
constexpr size_t MiB = 1u << 20;
constexpr size_t WS_CTL = 0, CTL_ZERO_BYTES = 1 * MiB;
constexpr size_t WS_XN = 2 * MiB;
constexpr size_t WS_WINT = 36 * MiB;
constexpr size_t WS_WOUTT = 78 * MiB;
constexpr size_t WS_PROJ = 96 * MiB;
constexpr size_t WS_DTRAW = 268 * MiB;
constexpr size_t WS_MIX = 272 * MiB;
constexpr size_t WS_YBUF = 344 * MiB;
constexpr size_t WS_END = 448 * MiB;
constexpr int CW_BAR = 4096;
constexpr int NWAVES = 8, NTHR = 512;
constexpr int RING_BYTES = 131072, LDSCTL_OFF = RING_BYTES, MISC_OFF = LDSCTL_OFF + 320, LDS_BYTES = 147456;

#define GAS __attribute__((address_space(1)))
#define LAS __attribute__((address_space(3)))
typedef unsigned short bf16;
typedef unsigned v4u __attribute__((ext_vector_type(4)));
typedef float f32x4 __attribute__((ext_vector_type(4)));
#define LDS_WAIT() asm volatile("s_waitcnt lgkmcnt(0)" ::: "memory")
#define VM_WAIT() asm volatile("s_waitcnt vmcnt(0)" ::: "memory")
__device__ __forceinline__ unsigned f2bf(float f) { unsigned u = __builtin_bit_cast(unsigned, f); return (u + 0x7fffu + ((u >> 16) & 1u)) >> 16; }
__device__ __forceinline__ unsigned pk2(float lo, float hi) { return f2bf(lo) | (f2bf(hi) << 16); }
__device__ __forceinline__ float bf2f(bf16 v) { return __builtin_bit_cast(float, (unsigned)v << 16); }
__device__ __forceinline__ float silu_f(float x) { return x / (1.f + __expf(-x)); }
__device__ __forceinline__ float softplus_f(float x) { return fmaxf(x, 0.f) + log1pf(__expf(-fabsf(x))); }
__device__ __forceinline__ float wave_sum(float v) {
#pragma unroll
    for (int o = 1; o < 64; o <<= 1) v += __shfl_xor(v, o);
    return v;
}

#define XB_TMO      128
#define XB_XCNT(j)  (256  + 64 * (j))
#define XB_XSUB(j)  (1280 + 64 * (j))
#define XB_XGEN(j)  (2304 + 64 * (j))
#define XB_TOP      3328
#define XB_TOPGEN   3392
#define XCD_BAR_WORDS 3456
#define XB_SPIN_CAP (1u << 18)

__device__ __forceinline__ unsigned xb_ld(unsigned* p)              { return __hip_atomic_load(p, __ATOMIC_RELAXED, __HIP_MEMORY_SCOPE_AGENT); }
__device__ __forceinline__ unsigned xb_add(unsigned* p, unsigned v) { return __hip_atomic_fetch_add(p, v, __ATOMIC_RELAXED, __HIP_MEMORY_SCOPE_AGENT); }
__device__ __forceinline__ unsigned xb_xcc_id() { return (unsigned)__builtin_amdgcn_s_getreg((3 << 11) | 20) & 0xFu; }
#define XB_SPIN(cond, bar) do { unsigned _sp = 0; while (cond) { __builtin_amdgcn_s_sleep(1); \
    if ((++_sp & 255u) == 0u) { if (xb_ld(&(bar)[XB_TMO])) break; if (_sp > XB_SPIN_CAP) { atomicAdd(&(bar)[XB_TMO], 1u); break; } } } } while (0)

struct XcdBarrier {
    unsigned* bar; unsigned x;
    volatile LAS unsigned* st;
};

__device__ __forceinline__ XcdBarrier xcd_barrier_post(unsigned* bar, volatile LAS unsigned* st) {
    XcdBarrier b; b.bar = bar; b.x = xb_xcc_id(); b.st = st;
    if (threadIdx.x == 0) (void)xb_add(&bar[XB_XCNT(b.x)], 1u);
    return b;
}
__device__ __forceinline__ void xcd_barrier_complete(unsigned* bar, unsigned x, unsigned& nloc, unsigned& nx) {
    const unsigned G = gridDim.x * gridDim.y * gridDim.z;
    unsigned sum, cnt, mine, sp = 0u;
    for (;;) {
        sum = 0u; cnt = 0u; mine = 0u;
#pragma unroll
        for (unsigned j = 0; j < 16; ++j) { const unsigned c = xb_ld(&bar[XB_XCNT(j)]); sum += c; cnt += (c > 0u) ? 1u : 0u; mine = (j == x) ? c : mine; }
        if (sum == G) break;
        __builtin_amdgcn_s_sleep(1);
        if ((++sp & 255u) == 0u) { if (xb_ld(&bar[XB_TMO])) break; if (sp > XB_SPIN_CAP) { atomicAdd(&bar[XB_TMO], 1u); break; } }
    }
    nloc = mine > 0u ? mine : 1u; nx = cnt > 0u ? cnt : 1u;
}

__device__ __forceinline__ void xcd_barrier(const XcdBarrier& b) {
    asm volatile("s_waitcnt vmcnt(0)" ::: "memory");
    __syncthreads();
    if (threadIdx.x == 0) {
        unsigned* bar = b.bar;
        __builtin_amdgcn_s_waitcnt(0);
        unsigned nloc = b.st[0], nx = b.st[1];
        if (nloc == 0u) { xcd_barrier_complete(bar, b.x, nloc, nx); b.st[0] = nloc; b.st[1] = nx; }
        const unsigned old = xb_add(&bar[XB_XSUB(b.x)], 1u);
        const unsigned gen = old / nloc;
        if (old + 1u == (gen + 1u) * nloc) {
            __builtin_amdgcn_fence(__ATOMIC_RELEASE, "agent");
            asm volatile("s_waitcnt vmcnt(0)" ::: "memory");
            const unsigned og = xb_add(&bar[XB_TOP], 1u);
            const unsigned tg = og / nx;
            if (og + 1u == (tg + 1u) * nx) xb_add(&bar[XB_TOPGEN], 1u);
            else XB_SPIN(xb_ld(&bar[XB_TOPGEN]) == tg, bar);
            __builtin_amdgcn_fence(__ATOMIC_ACQUIRE, "agent");
            xb_add(&bar[XB_XGEN(b.x)], 1u);
            asm volatile("s_waitcnt vmcnt(0)" ::: "memory");
        } else {
            XB_SPIN(xb_ld(&bar[XB_XGEN(b.x)]) == gen, bar);
            __builtin_amdgcn_fence(__ATOMIC_ACQUIRE, "agent");
            asm volatile("s_waitcnt vmcnt(0)" ::: "memory");
        }
    }
    __syncthreads();
}


struct Frame {
    LAS unsigned char* lds;
    int tid, lane, wave, G, bid;
    const float *x_prompt, *x_sample, *state_pool, *state_conv, *state_ssm, *norm_g, *w_in, *conv_w, *conv_b, *dt_bias, *a_log, *d_skip, *ssm_norm_g, *pool_w, *pool_scale, *w_out, *final_g;
    float* out;
    bf16 *XN, *WinT, *WoutT, *PROJ, *MIX; float *DTRAW, *YBUF;
};

__device__ __forceinline__ void p0_transpose_item(const float* W, int K, int N, bf16* WT, LAS float* scr, int item, int lane) {
    const int nblk = (N + 31) / 32, kb = item / nblk, nb = item % nblk, k0 = 64 * kb, n0 = 32 * nb;
    const bool ok = (n0 + (lane & 31)) < N;
#pragma unroll 8
    for (int i = 0; i < 32; ++i) { const int kk = 2 * i + (lane >> 5); scr[kk * 33 + (lane & 31)] = ok ? W[(size_t)(k0 + kk) * N + n0 + (lane & 31)] : 0.f; }
    LDS_WAIT(); asm volatile("" ::: "memory");
    const int c = lane & 7;
#pragma unroll
    for (int j = 0; j < 4; ++j) { const int n = (lane >> 3) + 8 * j; const LAS float* s = scr + (8 * c) * 33 + n;
        v4u o; o.x = pk2(s[0 * 33], s[1 * 33]); o.y = pk2(s[2 * 33], s[3 * 33]); o.z = pk2(s[4 * 33], s[5 * 33]); o.w = pk2(s[6 * 33], s[7 * 33]);
        *(GAS v4u*)(WT + (size_t)(n0 + n) * K + k0 + 8 * c) = o; }
    LDS_WAIT(); asm volatile("" ::: "memory");
}
__device__ __forceinline__ void p0_prologue(Frame& F) {
    LAS float* scr = (LAS float*)(F.lds + F.wave * 16384);
    const int gw = F.bid * NWAVES + F.wave, NGW = F.G * NWAVES;
    constexpr int I_IN = (DMODEL / 64) * ((NPROJ + 31) / 32), I_OUT = (DMIX / 64) * (DMODEL / 32);
    for (int it = gw; it < I_IN + I_OUT; it += NGW) {
        if (it < I_IN) p0_transpose_item(F.w_in, DMODEL, NPROJ, F.WinT, scr, it, F.lane);
        else p0_transpose_item(F.w_out, DMIX, DMODEL, F.WoutT, scr, it - I_IN, F.lane);
    }
    { const size_t z0 = (size_t)10304 * DMODEL * 2, z1 = (size_t)NPROJ_PAD * DMODEL * 2; GAS v4u* zp = (GAS v4u*)((unsigned char*)F.WinT + z0);
      const size_t nz = (z1 - z0) / 16; for (size_t i = (size_t)F.bid * NTHR + F.tid; i < nz; i += (size_t)F.G * NTHR) zp[i] = (v4u){0u, 0u, 0u, 0u}; }
    for (int m = gw; m < MROWS; m += NGW) {
        const float* xrow = (m < NPR) ? F.x_prompt + (size_t)m * DMODEL : F.x_sample + (size_t)(m - NPR) * DMODEL;
        const GAS f32x4* xr = (const GAS f32x4*)xrow + F.lane; const GAS f32x4* gr = (const GAS f32x4*)F.norm_g + F.lane;
        f32x4 v[8]; float s = 0.f;
#pragma unroll
        for (int j = 0; j < 8; ++j) { v[j] = xr[64 * j]; s += (v[j].x * v[j].x + v[j].y * v[j].y) + (v[j].z * v[j].z + v[j].w * v[j].w); }
        const float r = 1.f / sqrtf(wave_sum(s) * (1.f / DMODEL) + EPS);
        GAS unsigned long long* o8 = (GAS unsigned long long*)(F.XN + (size_t)m * DMODEL) + F.lane;
#pragma unroll
        for (int j = 0; j < 8; ++j) { const f32x4 g = gr[64 * j]; o8[64 * j] = (unsigned long long)pk2(v[j].x * r * g.x, v[j].y * r * g.y) | ((unsigned long long)pk2(v[j].z * r * g.z, v[j].w * r * g.w) << 32); }
    }
}

__device__ __forceinline__ void pool_unit(Frame& F, int tile, int gi) {
    LAS float* pooled = (LAS float*)F.lds;
    const int w = 2 << gi, m0 = tile * 32, c = F.tid & 255, th = F.tid >> 8, ch = gi * 256 + c;
    for (int i = 0; i < 16; ++i) {
        const int t = th * 16 + i, m = m0 + t; const bool prompt = m < NPR;
        int b, tq, cnt; if (prompt) { b = m >> 11; tq = m & 2047; cnt = min(w, tq + 1); } else { const int ms = m - NPR; b = ms >> 2; tq = ms & 3; cnt = w; }
        float sum = 0.f;
        for (int j = 0; j < w; ++j) { const int tt = tq - j; float v;
            if (tt >= 0) v = bf2f(F.PROJ[(size_t)(m - j) * PLD + ch]); else v = prompt ? 0.f : F.state_pool[(size_t)(b * 15 + 15 + tt) * DPOOL + ch];
            sum += v; }
        const float u0 = bf2f(F.PROJ[(size_t)m * PLD + ch]);
        pooled[t * 256 + c] = sum / (float)cnt - u0;
    }
    __syncthreads();
    float acc[16];
#pragma unroll
    for (int i = 0; i < 16; ++i) acc[i] = 0.f;
    const float* W = F.pool_w + (size_t)gi * 65536 + c;
    for (int c4 = 0; c4 < 64; ++c4) {
        const float w0 = W[(size_t)(4 * c4 + 0) * 256], w1 = W[(size_t)(4 * c4 + 1) * 256], w2 = W[(size_t)(4 * c4 + 2) * 256], w3 = W[(size_t)(4 * c4 + 3) * 256];
#pragma unroll
        for (int i = 0; i < 16; ++i) { const f32x4 p4 = *(const LAS f32x4*)(pooled + (th * 16 + i) * 256 + 4 * c4); acc[i] += (p4.x * w0 + p4.y * w1) + (p4.z * w2 + p4.w * w3); }
    }
    const float sc = F.pool_scale[ch];
#pragma unroll
    for (int i = 0; i < 16; ++i) { const int m = m0 + th * 16 + i; const float gate = bf2f(F.PROJ[(size_t)m * PLD + C_GATE + ch]);
        F.MIX[(size_t)m * DMIX + ch] = (bf16)f2bf(acc[i] * sc * silu_f(gate)); }
    __syncthreads();
}

__device__ __forceinline__ void ssd_unit(Frame& F, int seq, int h) {
    const bool prompt = seq < 4; const int L = prompt ? 2048 : 4, sb = seq - 4, row0 = prompt ? seq * 2048 : NPR + sb * 4, g = h / 6;
    const int p = F.tid >> 3, nq = F.tid & 7;
    LAS float* T = (LAS float*)F.lds;
    LAS float* dts = T + 32 * 320; LAS float* dec = dts + 32;
    float S[16];
    if (prompt) {
#pragma unroll
        for (int j = 0; j < 16; ++j) S[j] = 0.f;
    } else { const f32x4* sp = (const f32x4*)(F.state_ssm + ((size_t)(sb * NHEAD + h) * HDIM + p) * DSTATE + nq * 16);
#pragma unroll
        for (int q = 0; q < 4; ++q) { const f32x4 v = sp[q]; S[4 * q] = v.x; S[4 * q + 1] = v.y; S[4 * q + 2] = v.z; S[4 * q + 3] = v.w; } }
    const float a = -__expf(F.a_log[h]), dtb = F.dt_bias[h], dsk = F.d_skip[h];
    for (int t0 = 0; t0 < L; t0 += 32) {
        const int nt = min(32, L - t0);
        __syncthreads();
        for (int e = F.tid; e < nt * 320; e += NTHR) {
            const int t = e / 320, c = e - t * 320;
            const int xch = c < 64 ? h * 64 + c : (c < 192 ? 3072 + g * 128 + (c - 64) : 4096 + g * 128 + (c - 192));
            float acc = F.conv_b[xch];
#pragma unroll
            for (int k = 0; k < 4; ++k) { const int tt = t0 + t + k - 3; float v;
                if (tt >= 0) v = bf2f(F.PROJ[(size_t)(row0 + tt) * PLD + C_XBC + xch]); else v = prompt ? 0.f : F.state_conv[(size_t)(sb * 3 + 3 + tt) * DCONV + xch];
                acc += v * F.conv_w[k * DCONV + xch]; }
            T[e] = silu_f(acc);
        }
        for (int t = F.tid; t < nt; t += NTHR) { const float dt = softplus_f(F.DTRAW[(size_t)(row0 + t0 + t) * 64 + h] + dtb); dts[t] = dt; dec[t] = __expf(dt * a); }
        __syncthreads();
        for (int t = 0; t < nt; ++t) {
            const LAS float* r = T + t * 320;
            const float x = r[p], d = dec[t], dtx = dts[t] * x; float acc = 0.f;
#pragma unroll
            for (int q = 0; q < 4; ++q) { const f32x4 bv = *(const LAS f32x4*)(r + 64 + nq * 16 + 4 * q), cv = *(const LAS f32x4*)(r + 192 + nq * 16 + 4 * q);
                S[4 * q] = d * S[4 * q] + dtx * bv.x; S[4 * q + 1] = d * S[4 * q + 1] + dtx * bv.y; S[4 * q + 2] = d * S[4 * q + 2] + dtx * bv.z; S[4 * q + 3] = d * S[4 * q + 3] + dtx * bv.w;
                acc += (cv.x * S[4 * q] + cv.y * S[4 * q + 1]) + (cv.z * S[4 * q + 2] + cv.w * S[4 * q + 3]); }
            acc += __shfl_xor(acc, 1); acc += __shfl_xor(acc, 2); acc += __shfl_xor(acc, 4);
            if (nq == 0) F.YBUF[(size_t)(row0 + t0 + t) * DSSM + h * 64 + p] = acc + dsk * x;
        }
    }
    float* so = F.out + (prompt ? O_SSM_P + ((size_t)(seq * NHEAD + h) * HDIM + p) * DSTATE : O_SSM_S + ((size_t)(sb * NHEAD + h) * HDIM + p) * DSTATE) + nq * 16;
#pragma unroll
    for (int q = 0; q < 4; ++q) *(f32x4*)(so + 4 * q) = (f32x4){S[4 * q], S[4 * q + 1], S[4 * q + 2], S[4 * q + 3]};
    __syncthreads();
}

__device__ __forceinline__ void p2_copies(Frame& F) {
    const size_t gt = (size_t)F.bid * NTHR + F.tid, GT = (size_t)F.G * NTHR;
    for (size_t i = gt; i < (size_t)4 * 15 * DPOOL; i += GT) { const int ch = i % DPOOL, r = (i / DPOOL) % 15, b = i / (DPOOL * 15);
        F.out[O_POOL_P + i] = bf2f(F.PROJ[(size_t)(b * 2048 + 2033 + r) * PLD + ch]); }
    for (size_t i = gt; i < (size_t)4 * 3 * DCONV; i += GT) { const int ch = i % DCONV, r = (i / DCONV) % 3, b = i / (DCONV * 3);
        F.out[O_CONV_P + i] = bf2f(F.PROJ[(size_t)(b * 2048 + 2045 + r) * PLD + C_XBC + ch]); }
    for (size_t i = gt; i < (size_t)128 * 15 * DPOOL; i += GT) { const int ch = i % DPOOL, r = (i / DPOOL) % 15, b = i / (DPOOL * 15);
        F.out[O_POOL_S + i] = r < 11 ? F.state_pool[(size_t)(b * 15 + r + 4) * DPOOL + ch] : bf2f(F.PROJ[(size_t)(NPR + b * 4 + r - 11) * PLD + ch]); }
    for (size_t i = gt; i < (size_t)128 * 3 * DCONV; i += GT) { const int ch = i % DCONV, r = (i / DCONV) % 3, b = i / (DCONV * 3);
        F.out[O_CONV_S + i] = bf2f(F.PROJ[(size_t)(NPR + b * 4 + 1 + r) * PLD + C_XBC + ch]); }
}

__device__ __forceinline__ void p3_gate_norm(Frame& F) {
    const int gw = F.bid * NWAVES + F.wave, NGW = F.G * NWAVES;
    for (int task = gw; task < MROWS * NGRP; task += NGW) {
        const int m = task >> 3, g = task & 7; float v[6]; float ss = 0.f;
#pragma unroll
        for (int k = 0; k < 6; ++k) { const int idx = g * 384 + F.lane + 64 * k; const float y = F.YBUF[(size_t)m * DSSM + idx], z = bf2f(F.PROJ[(size_t)m * PLD + C_Z + idx]);
            v[k] = y * silu_f(z); ss += v[k] * v[k]; }
        const float r = 1.f / sqrtf(wave_sum(ss) * (1.f / 384.f) + EPS);
#pragma unroll
        for (int k = 0; k < 6; ++k) { const int idx = g * 384 + F.lane + 64 * k; F.MIX[(size_t)m * DMIX + DPOOL + idx] = (bf16)f2bf(v[k] * r * F.ssm_norm_g[idx]); }
    }
}
__device__ __forceinline__ void p5_final_norm(Frame& F) {
    const int gw = F.bid * NWAVES + F.wave, NGW = F.G * NWAVES;
    for (int m = gw; m < MROWS; m += NGW) {
        GAS f32x4* yr = (GAS f32x4*)(F.out + O_Y + (size_t)m * DMODEL) + F.lane; const GAS f32x4* gr = (const GAS f32x4*)F.final_g + F.lane;
        f32x4 v[8]; float s = 0.f;
#pragma unroll
        for (int j = 0; j < 8; ++j) { v[j] = yr[64 * j]; s += (v[j].x * v[j].x + v[j].y * v[j].y) + (v[j].z * v[j].z + v[j].w * v[j].w); }
        const float r = 1.f / sqrtf(wave_sum(s) * (1.f / DMODEL) + EPS);
#pragma unroll
        for (int j = 0; j < 8; ++j) { const f32x4 g = gr[64 * j]; yr[64 * j] = (f32x4){v[j].x * r * g.x, v[j].y * r * g.y, v[j].z * r * g.z, v[j].w * r * g.w}; }
    }
}

struct Args { const float* in[17]; float* out; unsigned char* ws; int ph_lo, ph_hi; };
constexpr int N_PHASES = 6;
__global__ void __launch_bounds__(NTHR, 2) fwd(Args args) {
    extern __shared__ __attribute__((aligned(16))) unsigned char lds_raw[];
    Frame F;
    F.lds = (LAS unsigned char*)lds_raw;
    F.tid = threadIdx.x; F.lane = F.tid & 63; F.wave = __builtin_amdgcn_readfirstlane(F.tid >> 6); F.G = gridDim.x; F.bid = blockIdx.x;
    unsigned char* ws = args.ws;
    F.x_prompt = args.in[0]; F.x_sample = args.in[1]; F.state_pool = args.in[2]; F.state_conv = args.in[3]; F.state_ssm = args.in[4]; F.norm_g = args.in[5]; F.w_in = args.in[6];
    F.conv_w = args.in[7]; F.conv_b = args.in[8]; F.dt_bias = args.in[9]; F.a_log = args.in[10]; F.d_skip = args.in[11]; F.ssm_norm_g = args.in[12]; F.pool_w = args.in[13];
    F.pool_scale = args.in[14]; F.w_out = args.in[15]; F.final_g = args.in[16]; F.out = args.out;
    F.XN = (bf16*)(ws + WS_XN); F.WinT = (bf16*)(ws + WS_WINT); F.WoutT = (bf16*)(ws + WS_WOUTT); F.PROJ = (bf16*)(ws + WS_PROJ); F.MIX = (bf16*)(ws + WS_MIX);
    F.DTRAW = (float*)(ws + WS_DTRAW); F.YBUF = (float*)(ws + WS_YBUF);
    for (int u = F.tid; u < (LDS_BYTES - LDSCTL_OFF) / 4; u += NTHR) ((LAS unsigned*)(F.lds + LDSCTL_OFF))[u] = 0u;
    __syncthreads();
    const int lo = args.ph_lo, hi = args.ph_hi;
    XcdBarrier bar; bar.bar = (unsigned*)(ws + WS_CTL) + CW_BAR; bar.x = 0; bar.st = nullptr;
    if (hi - lo > 1) bar = xcd_barrier_post((unsigned*)(ws + WS_CTL) + CW_BAR, (volatile LAS unsigned*)(F.lds + MISC_OFF) + 8);
#define IN(k) (lo <= (k) && (k) < hi)
#define BOTH(k) (IN(k) && IN((k) + 1))
    if (IN(0)) { p0_prologue(F); if (BOTH(0)) xcd_barrier(bar); }
    if (IN(1)) {
        pg8::Gemm g{F.XN, F.WinT, MROWS, NPROJ_PAD, DMODEL}; pg8::StaticOrder S; S.init(MROWS, NPROJ_PAD, F.G, F.bid);
        pg8::EpiProj E{F.PROJ, F.DTRAW};
        pg8::gemm_phase<pg8::EpiProj, pg8::StaticOrder, true, true>(F.lds, g, S, E);
        if (BOTH(1)) xcd_barrier(bar);
    }
    if (IN(2)) {
        if (F.bid < 192) ssd_unit(F, F.bid / 48, F.bid % 48);
        constexpr int NPOOL = (MROWS / 32) * 4, NSS = 128 * 48;
        for (int i = F.bid; i < NPOOL + NSS; i += F.G) {
            if (i < NPOOL) pool_unit(F, i >> 2, i & 3); else { const int j = i - NPOOL; ssd_unit(F, 4 + j / 48, j % 48); }
        }
        p2_copies(F);
        if (BOTH(2)) xcd_barrier(bar);
    }
    if (IN(3)) { p3_gate_norm(F); if (BOTH(3)) xcd_barrier(bar); }
    if (IN(4)) {
        pg8::Gemm g{F.MIX, F.WoutT, MROWS, DMODEL, DMIX}; pg8::StaticOrder S; S.init(MROWS, DMODEL, F.G, F.bid);
        pg8::EpiOut E{F.x_prompt, F.x_sample, F.out};
        pg8::gemm_phase<pg8::EpiOut, pg8::StaticOrder, true, true>(F.lds, g, S, E);
        if (BOTH(4)) xcd_barrier(bar);
    }
    if (IN(5)) { p5_final_norm(F); }
#undef IN
#undef BOTH
}

#ifndef N_LAUNCHES
#define N_LAUNCHES 6
#endif
extern "C" void kernel_launch(void* const* d_in, const int* in_sizes, int n_in, void* d_out, int out_size, void* d_ws, size_t ws_size, hipStream_t stream) {
    static int grid = 0;
    if (grid == 0) {
        if (n_in != 17 || out_size != 73785344 || ws_size < WS_END) { fprintf(stderr, "kernel_launch: unexpected shapes: n_in %d out %d ws %zu\n", n_in, out_size, ws_size); grid = -1; return; }
        int dev = 0, cus = 0, per_cu = 0;
        if (hipGetDevice(&dev) != hipSuccess || hipDeviceGetAttribute(&cus, hipDeviceAttributeMultiprocessorCount, dev) != hipSuccess) { fprintf(stderr, "kernel_launch: device query failed\n"); grid = -1; return; }
        if (hipFuncSetAttribute((const void*)fwd, hipFuncAttributeMaxDynamicSharedMemorySize, LDS_BYTES) != hipSuccess) { fprintf(stderr, "kernel_launch: hipFuncSetAttribute failed\n"); grid = -1; return; }
        if (hipOccupancyMaxActiveBlocksPerMultiprocessor(&per_cu, (const void*)fwd, NTHR, LDS_BYTES) != hipSuccess || per_cu < 1) { fprintf(stderr, "kernel_launch: occupancy query says %d blocks per CU\n", per_cu); }
        (void)hipGetLastError();
        grid = cus;
    }
    if (grid < 0) return;
    (void)hipMemsetAsync((char*)d_ws + WS_CTL, 0, CTL_ZERO_BYTES, stream);
    Args a{};
    for (int i = 0; i < 17; ++i) a.in[i] = (const float*)d_in[i];
    a.out = (float*)d_out; a.ws = (unsigned char*)d_ws;
    if (N_LAUNCHES == 1) {
        a.ph_lo = 0; a.ph_hi = N_PHASES;
        void* kargs[] = {&a};
        hipError_t e = hipLaunchCooperativeKernel((const void*)fwd, dim3(grid), dim3(NTHR), kargs, LDS_BYTES, stream);
        if (e != hipSuccess) fprintf(stderr, "kernel_launch: cooperative launch failed: %s\n", hipGetErrorString(e));
    } else {
        for (int li = 0; li < N_PHASES; ++li) { a.ph_lo = li; a.ph_hi = li + 1; hipLaunchKernelGGL(fwd, dim3(grid), dim3(NTHR), LDS_BYTES, stream, a); }
    }
}
```

```cpp
#include <hip/hip_runtime.h>
#include <cstdio>
#include <cstdint>
namespace pg8 {
#define PG8_LAS __attribute__((address_space(3)))
typedef unsigned short bf16_t;
typedef short bf16x8 __attribute__((ext_vector_type(8)));
typedef float f32x4 __attribute__((ext_vector_type(4)));
typedef unsigned u32x4 __attribute__((ext_vector_type(4)));
constexpr int BM = 256, BK = 64, HALF = 128, HTB = HALF * BK * 2  , STAGE_BYTES = 8 * HTB, NXCD = 8, WGM = 8;

__host__ __device__ __forceinline__ int lds_byte(int r, int c) { const int st = (r >> 4) * 2 + (c >> 5), rr = r & 15, cc = c & 31, ob = rr * 64 + cc * 2; return st * 1024 + (ob ^ (((ob >> 9) & 1) << 5)); }
__host__ __device__ __forceinline__ void stage_rc(int b, int& R, int& C) { const int st = b / 1024, sb = b % 1024, swz = sb ^ (((sb >> 9) & 1) << 5); R = (st >> 1) * 16 + swz / 64; C = (st & 1) * 32 + (swz % 64) / 2; }
__host__ __device__ __forceinline__ int perm32(int rho) { const int n = rho >> 4, i = rho & 15; return 8 * (i >> 2) + 4 * n + (i & 3); }

struct Unit { int pm, pn; };
struct Gemm { const bf16_t* A; const bf16_t* Bt; int M, N, K; };

struct StaticOrder {
    int nM, nN, nwg, G, c;
    __host__ __device__ void init(int M, int N, int G_, int c_) { nM = M / BM; nN = N / BM; nwg = nM * nN; G = G_; c = c_; }
    __host__ __device__ bool next(int i, Unit& u) const {
        const long L = (long)i * G + c; if (L >= nwg) return false;
        int wgid = (int)L; { const int q = nwg / NXCD, r = nwg % NXCD, xcd = wgid % NXCD, off = wgid / NXCD; wgid = (xcd < r ? xcd * (q + 1) : r * (q + 1) + (xcd - r) * q) + off; }
        const int nig = WGM * nN, gid = wgid / nig, fm = gid * WGM, gsz = (nM - fm) < WGM ? (nM - fm) : WGM;
        u.pm = fm + ((wgid % nig) % gsz); u.pn = (wgid % nig) / gsz; return true;
    }
    __device__ __forceinline__ void a_ready(const Unit&) const {}
    __device__ __forceinline__ void done(const Unit&) const {}
};

__device__ __forceinline__ unsigned cvt_pk_bf16(float lo, float hi) { unsigned r; asm volatile("v_cvt_pk_bf16_f32 %0, %1, %2" : "=v"(r) : "v"(lo), "v"(hi)); return r; }

struct EpiProj {
    static constexpr bool PERM = true, AFTER_DRAIN = false;
    bf16_t* P; float* dtraw;
    __device__ __forceinline__ void operator()(const f32x4 (&acc)[2][2][4][2], const Unit& u, int wr, int wc, int fr, int fq) const {
        const int row0 = u.pm * BM + wr * 64 + fr;
        if (u.pn < 40) {
            const int col0 = u.pn * BM + wc * 32 + 8 * fq;
#pragma unroll
            for (int ai = 0; ai < 2; ++ai)
#pragma unroll
                for (int m = 0; m < 4; ++m) { bf16_t* rowp = P + (size_t)(row0 + ai * HALF + m * 16) * 10240 + col0;
#pragma unroll
                    for (int bj = 0; bj < 2; ++bj) { const f32x4 v0 = acc[ai][bj][m][0], v1 = acc[ai][bj][m][1];
                        u32x4 w; w.x = cvt_pk_bf16(v0[0], v0[1]); w.y = cvt_pk_bf16(v0[2], v0[3]); w.z = cvt_pk_bf16(v1[0], v1[1]); w.w = cvt_pk_bf16(v1[2], v1[3]);
                        *(u32x4*)(rowp + bj * HALF) = w; } }
        } else if (wc < 2) {
#pragma unroll
            for (int ai = 0; ai < 2; ++ai)
#pragma unroll
                for (int m = 0; m < 4; ++m) { float* rp = dtraw + (size_t)(row0 + ai * HALF + m * 16) * 64 + wc * 32 + 8 * fq;
                    *(f32x4*)rp = acc[ai][0][m][0]; *(f32x4*)(rp + 4) = acc[ai][0][m][1]; }
        }
    }
};
struct EpiOut {
    static constexpr bool PERM = false, AFTER_DRAIN = false;
    const float* xp; const float* xs; float* out;
    __device__ __forceinline__ void operator()(const f32x4 (&acc)[2][2][4][2], const Unit& u, int wr, int wc, int fr, int fq) const {
        const int row0 = u.pm * BM + wr * 64 + fr, col0 = u.pn * BM + wc * 32 + 4 * fq;
        const float* xb = (u.pm < 32) ? xp : xs - (size_t)8192 * 2048;
#pragma unroll
        for (int ai = 0; ai < 2; ++ai)
#pragma unroll
            for (int m = 0; m < 4; ++m) { const size_t ro = (size_t)(row0 + ai * HALF + m * 16) * 2048 + col0;
#pragma unroll
                for (int bj = 0; bj < 2; ++bj)
#pragma unroll
                    for (int n = 0; n < 2; ++n) { const f32x4 xv = *(const f32x4*)(xb + ro + bj * HALF + n * 16);
                        *(f32x4*)(out + ro + bj * HALF + n * 16) = xv + acc[ai][bj][m][n]; } }
    }
};

template <class Epi, class Sched, bool ALIGN_EPI = false, bool SP2 = false>
__device__ __forceinline__ void gemm_phase(PG8_LAS unsigned char* lds, const Gemm g, const Sched& S, const Epi& E) {
    const int tid = threadIdx.x, wid = __builtin_amdgcn_readfirstlane(tid >> 6), lane = tid & 63, wr = wid >> 2, wc = wid & 3, fr = lane & 15, fq = lane >> 4;
    const int K = g.K, nt = K / BK;
    unsigned voffA[2], voffB[2];
#pragma unroll
    for (int i = 0; i < 2; ++i) { int R, C; stage_rc(tid * 16 + i * 8192, R, C); const int Rb = Epi::PERM ? ((R & ~31) + perm32(R & 31)) : R;
        voffA[i] = (unsigned)(R * K + C) * 2u; voffB[i] = (unsigned)(Rb * K + C) * 2u; }
    const size_t kstep = (size_t)(BK * 2);
    const size_t hstep = (size_t)HALF * K * 2;
    const size_t tstep = 2 * hstep;
    const unsigned ldsw = (unsigned)wid * 1024u;
    const int aoff = lds_byte(wr * 64 + fr, fq * 8), boff = lds_byte(wc * 32 + fr, fq * 8);
#define PG8_SA(b, h) (((b) * 2 + (h)) * HTB)
#define PG8_SB(b, h) ((4 + (b) * 2 + (h)) * HTB)
#define PG8_STAGE(bufoff, gbase, voff) do { _Pragma("unroll") for (int _i = 0; _i < 2; ++_i) \
        __builtin_amdgcn_global_load_lds((const unsigned*)((const char*)(gbase) + (voff)[_i]), (PG8_LAS unsigned*)(lds + (bufoff) + ldsw + _i * 8192), 16, 0, 0); } while (0)
#define PG8_LDA(dst, b, h) do { _Pragma("unroll") for (int m = 0; m < 4; ++m) _Pragma("unroll") for (int k = 0; k < 2; ++k) dst[m][k] = *(const PG8_LAS bf16x8*)(lds + PG8_SA(b, h) + aoff + m * 2048 + k * 1024); } while (0)
#define PG8_LDB(dst, b, h) do { _Pragma("unroll") for (int n = 0; n < 2; ++n) _Pragma("unroll") for (int k = 0; k < 2; ++k) dst[n][k] = *(const PG8_LAS bf16x8*)(lds + PG8_SB(b, h) + boff + n * 2048 + k * 1024); } while (0)
#define PG8_MMA(ai, bj, At, Bt) do { __builtin_amdgcn_s_setprio(1); _Pragma("unroll") for (int m = 0; m < 4; ++m) _Pragma("unroll") for (int n = 0; n < 2; ++n) _Pragma("unroll") for (int k = 0; k < 2; ++k) \
        acc[ai][bj][m][n] = __builtin_amdgcn_mfma_f32_16x16x32_bf16(Bt[n][k], At[m][k], acc[ai][bj][m][n], 0, 0, 0); __builtin_amdgcn_s_setprio(0); } while (0)
#define PG8_WAIT_V(n) asm volatile("s_waitcnt vmcnt(" #n ")" ::: "memory")
#define PG8_WAIT_L(n) asm volatile("s_waitcnt lgkmcnt(" #n ")" ::: "memory")
#define PG8_BAR __builtin_amdgcn_s_barrier()
#define PG8_SCHED __builtin_amdgcn_sched_barrier(0)
    Unit cur, nxt; int ui = 0;
    if (!S.next(0, cur)) return;
    f32x4 acc[2][2][4][2];
#pragma unroll
    for (int a = 0; a < 2; ++a)
#pragma unroll
        for (int b = 0; b < 2; ++b)
#pragma unroll
            for (int m = 0; m < 4; ++m)
#pragma unroll
                for (int n = 0; n < 2; ++n) acc[a][b][m][n] = (f32x4){0.f, 0.f, 0.f, 0.f};
    bf16x8 At[4][2], B0[2][2], B1[2][2];
    const char* cA = (const char*)g.A + (size_t)cur.pm * tstep; const char* cB = (const char*)g.Bt + (size_t)cur.pn * tstep;
    S.a_ready(cur);
    if constexpr (SP2) {
        PG8_STAGE(PG8_SB(0, 0), cB, voffB); PG8_STAGE(PG8_SB(0, 1), cB + hstep, voffB); PG8_STAGE(PG8_SA(0, 0), cA, voffA); PG8_STAGE(PG8_SA(0, 1), cA + hstep, voffA);
        if (wr == 1) PG8_BAR;
        PG8_WAIT_V(2); PG8_BAR;
        PG8_STAGE(PG8_SB(1, 0), cB + kstep, voffB); PG8_STAGE(PG8_SA(1, 0), cA + kstep, voffA); PG8_STAGE(PG8_SB(1, 1), cB + hstep + kstep, voffB);
        PG8_WAIT_V(6); PG8_BAR;
    } else {
        PG8_STAGE(PG8_SB(0, 0), cB, voffB); PG8_STAGE(PG8_SA(0, 0), cA, voffA); PG8_STAGE(PG8_SB(0, 1), cB + hstep, voffB); PG8_STAGE(PG8_SA(0, 1), cA + hstep, voffA);
        if (wr == 1) PG8_BAR;
        PG8_WAIT_V(4); PG8_BAR;
        PG8_STAGE(PG8_SB(1, 0), cB + kstep, voffB); PG8_STAGE(PG8_SA(1, 0), cA + kstep, voffA); PG8_STAGE(PG8_SB(1, 1), cB + hstep + kstep, voffB);
        PG8_WAIT_V(6); PG8_BAR;
    }
    for (;;) {
        const bool has_next = S.next(ui + 1, nxt);
        const char* nA = has_next ? (const char*)g.A + (size_t)nxt.pm * tstep : cA; const char* nB = has_next ? (const char*)g.Bt + (size_t)nxt.pn * tstep : cB;
        for (int t = 0; t < nt; t += 2) {
            const bool last = (t == nt - 2);
            const char* a1 = cA + (size_t)(t + 1) * kstep;
            const char* a2 = last ? nA : cA + (size_t)(t + 2) * kstep; const char* b2 = last ? nB : cB + (size_t)(t + 2) * kstep;
            const char* a3 = a2 + kstep; const char* b3 = b2 + kstep;
            if (last && has_next) S.a_ready(nxt);
            if constexpr (SP2) {
            PG8_LDB(B0, 0, 0); PG8_LDB(B1, 0, 1); PG8_SCHED; PG8_LDA(At, 0, 0); PG8_STAGE(PG8_SA(1, 1), a1 + hstep, voffA);
            PG8_WAIT_V(8); PG8_WAIT_L(0); PG8_BAR; PG8_MMA(0, 0, At, B0); PG8_MMA(0, 1, At, B1); PG8_BAR; PG8_SCHED;
            PG8_LDA(At, 0, 1); PG8_STAGE(PG8_SB(0, 0), b2, voffB); PG8_STAGE(PG8_SB(0, 1), b2 + hstep, voffB); PG8_STAGE(PG8_SA(0, 0), a2, voffA);
            PG8_WAIT_V(8); PG8_WAIT_L(0); PG8_BAR; PG8_MMA(1, 0, At, B0); PG8_MMA(1, 1, At, B1); PG8_BAR; PG8_SCHED;
            PG8_LDB(B0, 1, 0); PG8_LDB(B1, 1, 1); PG8_SCHED; PG8_LDA(At, 1, 0); PG8_STAGE(PG8_SA(0, 1), a2 + hstep, voffA);
            PG8_WAIT_V(8); PG8_WAIT_L(0); PG8_BAR; PG8_MMA(0, 0, At, B0); PG8_MMA(0, 1, At, B1); PG8_BAR; PG8_SCHED;
            PG8_LDA(At, 1, 1); PG8_STAGE(PG8_SB(1, 0), b3, voffB); PG8_STAGE(PG8_SB(1, 1), b3 + hstep, voffB); PG8_STAGE(PG8_SA(1, 0), a3, voffA);
            PG8_WAIT_V(8); PG8_WAIT_L(0); PG8_BAR; PG8_MMA(1, 0, At, B0); PG8_MMA(1, 1, At, B1); PG8_BAR; PG8_SCHED;
            } else {
            PG8_LDB(B0, 0, 0); PG8_SCHED; PG8_LDA(At, 0, 0); PG8_STAGE(PG8_SA(1, 1), a1 + hstep, voffA);
            PG8_WAIT_L(8); PG8_BAR; PG8_WAIT_L(0); PG8_MMA(0, 0, At, B0); PG8_BAR; PG8_SCHED;
            PG8_LDB(B1, 0, 1); PG8_STAGE(PG8_SB(0, 0), b2, voffB);
            PG8_BAR; PG8_WAIT_L(0); PG8_MMA(0, 1, At, B1); PG8_BAR;
            PG8_LDA(At, 0, 1); PG8_STAGE(PG8_SA(0, 0), a2, voffA);
            PG8_BAR; PG8_WAIT_L(0); PG8_MMA(1, 0, At, B0); PG8_BAR; PG8_SCHED;
            PG8_STAGE(PG8_SB(0, 1), b2 + hstep, voffB);
            PG8_WAIT_V(6); PG8_BAR; PG8_MMA(1, 1, At, B1); PG8_BAR;
            PG8_LDB(B0, 1, 0); PG8_SCHED; PG8_LDA(At, 1, 0); PG8_STAGE(PG8_SA(0, 1), a2 + hstep, voffA);
            PG8_WAIT_L(8); PG8_BAR; PG8_WAIT_L(0); PG8_MMA(0, 0, At, B0); PG8_BAR; PG8_SCHED;
            PG8_LDB(B1, 1, 1); PG8_STAGE(PG8_SB(1, 0), b3, voffB);
            PG8_BAR; PG8_WAIT_L(0); PG8_MMA(0, 1, At, B1); PG8_BAR;
            PG8_LDA(At, 1, 1); PG8_STAGE(PG8_SA(1, 0), a3, voffA);
            PG8_BAR; PG8_WAIT_L(0); PG8_MMA(1, 0, At, B0); PG8_BAR; PG8_SCHED;
            PG8_STAGE(PG8_SB(1, 1), b3 + hstep, voffB);
            PG8_WAIT_V(6); PG8_BAR; PG8_MMA(1, 1, At, B1); PG8_BAR;
            }
        }
        if constexpr (ALIGN_EPI) { if (wr == 0) PG8_BAR; }
        if constexpr (!Epi::AFTER_DRAIN) { E(acc, cur, wr, wc, fr, fq); S.done(cur); }
        if (!has_next) break;
#pragma unroll
        for (int a = 0; a < 2; ++a)
#pragma unroll
            for (int b = 0; b < 2; ++b)
#pragma unroll
                for (int m = 0; m < 4; ++m)
#pragma unroll
                    for (int n = 0; n < 2; ++n) acc[a][b][m][n] = (f32x4){0.f, 0.f, 0.f, 0.f};
        cur = nxt; cA = nA; cB = nB; ++ui;
        if constexpr (ALIGN_EPI) { if (wr == 1) PG8_BAR; }
    }
    PG8_WAIT_V(0);
    if constexpr (!ALIGN_EPI) { if (wr == 0) PG8_BAR; }
    PG8_BAR;
    if constexpr (Epi::AFTER_DRAIN) { E.fused(acc, cur, wr, wc, fr, fq, lds, wid, lane); S.done(cur); }
#undef PG8_SA
#undef PG8_SB
#undef PG8_STAGE
#undef PG8_LDA
#undef PG8_LDB
#undef PG8_MMA
#undef PG8_WAIT_V
#undef PG8_WAIT_L
#undef PG8_BAR
#undef PG8_SCHED
}

}

constexpr int DMODEL = 2048, NPR = 8192  , NSM = 512  , MROWS = NPR + NSM;
constexpr int DPOOL = 1024, DSSM = 3072, DCONV = 5120, NHEAD = 48, HDIM = 64, NGRP = 8, DSTATE = 128, DMIX = 4096;
constexpr int NPROJ = 10288, PLD = 10240  , NPROJ_PAD = 10496  ;
constexpr int C_GATE = 1024, C_Z = 2048, C_XBC = 5120;
constexpr float EPS = 1e-5f;
constexpr size_t O_Y = 0, O_POOL_P = 17825792, O_CONV_P = 17887232, O_SSM_P = 17948672, O_POOL_S = 19521536, O_CONV_S = 21487616, O_SSM_S = 23453696;
constexpr size_t MiB = 1u << 20;
constexpr size_t WS_CTL = 0, CTL_ZERO_BYTES = 1 * MiB;
constexpr size_t WS_XN = 2 * MiB;
constexpr size_t WS_WINT = 36 * MiB;
constexpr size_t WS_WOUTT = 78 * MiB;
constexpr size_t WS_PROJ = 96 * MiB;
constexpr size_t WS_DTRAW = 268 * MiB;
constexpr size_t WS_MIX = 272 * MiB;
constexpr size_t WS_YBUF = 344 * MiB;
constexpr size_t WS_END = 448 * MiB;
constexpr int CW_BAR = 4096;
constexpr int NWAVES = 8, NTHR = 512;
constexpr int RING_BYTES = 131072, LDSCTL_OFF = RING_BYTES, MISC_OFF = LDSCTL_OFF + 320, LDS_BYTES = 147456;

#define GAS __attribute__((address_space(1)))
#define LAS __attribute__((address_space(3)))
typedef unsigned short bf16;
typedef unsigned v4u __attribute__((ext_vector_type(4)));
typedef float f32x4 __attribute__((ext_vector_type(4)));
#define LDS_WAIT() asm volatile("s_waitcnt lgkmcnt(0)" ::: "memory")
#define VM_WAIT() asm volatile("s_waitcnt vmcnt(0)" ::: "memory")
__device__ __forceinline__ unsigned f2bf(float f) { unsigned u = __builtin_bit_cast(unsigned, f); return (u + 0x7fffu + ((u >> 16) & 1u)) >> 16; }
__device__ __forceinline__ unsigned pk2(float lo, float hi) { return f2bf(lo) | (f2bf(hi) << 16); }
__device__ __forceinline__ float bf2f(bf16 v) { return __builtin_bit_cast(float, (unsigned)v << 16); }
__device__ __forceinline__ float silu_f(float x) { return x / (1.f + __expf(-x)); }
__device__ __forceinline__ float softplus_f(float x) { return fmaxf(x, 0.f) + log1pf(__expf(-fabsf(x))); }
__device__ __forceinline__ float wave_sum(float v) {
#pragma unroll
    for (int o = 1; o < 64; o <<= 1) v += __shfl_xor(v, o);
    return v;
}

#define XB_TMO      128
#define XB_XCNT(j)  (256  + 64 * (j))
#define XB_XSUB(j)  (1280 + 64 * (j))
#define XB_XGEN(j)  (2304 + 64 * (j))
#define XB_TOP      3328
#define XB_TOPGEN   3392
#define XCD_BAR_WORDS 3456
#define XB_SPIN_CAP (1u << 18)

__device__ __forceinline__ unsigned xb_ld(unsigned* p)              { return __hip_atomic_load(p, __ATOMIC_RELAXED, __HIP_MEMORY_SCOPE_AGENT); }
__device__ __forceinline__ unsigned xb_add(unsigned* p, unsigned v) { return __hip_atomic_fetch_add(p, v, __ATOMIC_RELAXED, __HIP_MEMORY_SCOPE_AGENT); }
__device__ __forceinline__ unsigned xb_xcc_id() { return (unsigned)__builtin_amdgcn_s_getreg((3 << 11) | 20) & 0xFu; }
#define XB_SPIN(cond, bar) do { unsigned _sp = 0; while (cond) { __builtin_amdgcn_s_sleep(1); \
    if ((++_sp & 255u) == 0u) { if (xb_ld(&(bar)[XB_TMO])) break; if (_sp > XB_SPIN_CAP) { atomicAdd(&(bar)[XB_TMO], 1u); break; } } } } while (0)

struct XcdBarrier {
    unsigned* bar; unsigned x;
    volatile LAS unsigned* st;
};

__device__ __forceinline__ XcdBarrier xcd_barrier_post(unsigned* bar, volatile LAS unsigned* st) {
    XcdBarrier b; b.bar = bar; b.x = xb_xcc_id(); b.st = st;
    if (threadIdx.x == 0) (void)xb_add(&bar[XB_XCNT(b.x)], 1u);
    return b;
}
__device__ __forceinline__ void xcd_barrier_complete(unsigned* bar, unsigned x, unsigned& nloc, unsigned& nx) {
    const unsigned G = gridDim.x * gridDim.y * gridDim.z;
    unsigned sum, cnt, mine, sp = 0u;
    for (;;) {
        sum = 0u; cnt = 0u; mine = 0u;
#pragma unroll
        for (unsigned j = 0; j < 16; ++j) { const unsigned c = xb_ld(&bar[XB_XCNT(j)]); sum += c; cnt += (c > 0u) ? 1u : 0u; mine = (j == x) ? c : mine; }
        if (sum == G) break;
        __builtin_amdgcn_s_sleep(1);
        if ((++sp & 255u) == 0u) { if (xb_ld(&bar[XB_TMO])) break; if (sp > XB_SPIN_CAP) { atomicAdd(&bar[XB_TMO], 1u); break; } }
    }
    nloc = mine > 0u ? mine : 1u; nx = cnt > 0u ? cnt : 1u;
}

__device__ __forceinline__ void xcd_barrier(const XcdBarrier& b) {
    asm volatile("s_waitcnt vmcnt(0)" ::: "memory");
    __syncthreads();
    if (threadIdx.x == 0) {
        unsigned* bar = b.bar;
        __builtin_amdgcn_s_waitcnt(0);
        unsigned nloc = b.st[0], nx = b.st[1];
        if (nloc == 0u) { xcd_barrier_complete(bar, b.x, nloc, nx); b.st[0] = nloc; b.st[1] = nx; }
        const unsigned old = xb_add(&bar[XB_XSUB(b.x)], 1u);
        const unsigned gen = old / nloc;
        if (old + 1u == (gen + 1u) * nloc) {
            __builtin_amdgcn_fence(__ATOMIC_RELEASE, "agent");
            asm volatile("s_waitcnt vmcnt(0)" ::: "memory");
            const unsigned og = xb_add(&bar[XB_TOP], 1u);
            const unsigned tg = og / nx;
            if (og + 1u == (tg + 1u) * nx) xb_add(&bar[XB_TOPGEN], 1u);
            else XB_SPIN(xb_ld(&bar[XB_TOPGEN]) == tg, bar);
            __builtin_amdgcn_fence(__ATOMIC_ACQUIRE, "agent");
            xb_add(&bar[XB_XGEN(b.x)], 1u);
            asm volatile("s_waitcnt vmcnt(0)" ::: "memory");
        } else {
            XB_SPIN(xb_ld(&bar[XB_XGEN(b.x)]) == gen, bar);
            __builtin_amdgcn_fence(__ATOMIC_ACQUIRE, "agent");
            asm volatile("s_waitcnt vmcnt(0)" ::: "memory");
        }
    }
    __syncthreads();
}


struct Frame {
    LAS unsigned char* lds;
    int tid, lane, wave, G, bid;
    const float *x_prompt, *x_sample, *state_pool, *state_conv, *state_ssm, *norm_g, *w_in, *conv_w, *conv_b, *dt_bias, *a_log, *d_skip, *ssm_norm_g, *pool_w, *pool_scale, *w_out, *final_g;
    float* out;
    bf16 *XN, *WinT, *WoutT, *PROJ, *MIX; float *DTRAW, *YBUF;
};

__device__ __forceinline__ void p0_transpose_item(const float* W, int K, int N, bf16* WT, LAS float* scr, int item, int lane) {
    const int nblk = (N + 31) / 32, kb = item / nblk, nb = item % nblk, k0 = 64 * kb, n0 = 32 * nb;
    const bool ok = (n0 + (lane & 31)) < N;
#pragma unroll 8
    for (int i = 0; i < 32; ++i) { const int kk = 2 * i + (lane >> 5); scr[kk * 33 + (lane & 31)] = ok ? W[(size_t)(k0 + kk) * N + n0 + (lane & 31)] : 0.f; }
    LDS_WAIT(); asm volatile("" ::: "memory");
    const int c = lane & 7;
#pragma unroll
    for (int j = 0; j < 4; ++j) { const int n = (lane >> 3) + 8 * j; const LAS float* s = scr + (8 * c) * 33 + n;
        v4u o; o.x = pk2(s[0 * 33], s[1 * 33]); o.y = pk2(s[2 * 33], s[3 * 33]); o.z = pk2(s[4 * 33], s[5 * 33]); o.w = pk2(s[6 * 33], s[7 * 33]);
        *(GAS v4u*)(WT + (size_t)(n0 + n) * K + k0 + 8 * c) = o; }
    LDS_WAIT(); asm volatile("" ::: "memory");
}
__device__ __forceinline__ void p0_prologue(Frame& F) {
    LAS float* scr = (LAS float*)(F.lds + F.wave * 16384);
    const int gw = F.bid * NWAVES + F.wave, NGW = F.G * NWAVES;
    constexpr int I_IN = (DMODEL / 64) * ((NPROJ + 31) / 32), I_OUT = (DMIX / 64) * (DMODEL / 32);
    for (int it = gw; it < I_IN + I_OUT; it += NGW) {
        if (it < I_IN) p0_transpose_item(F.w_in, DMODEL, NPROJ, F.WinT, scr, it, F.lane);
        else p0_transpose_item(F.w_out, DMIX, DMODEL, F.WoutT, scr, it - I_IN, F.lane);
    }
    { const size_t z0 = (size_t)10304 * DMODEL * 2, z1 = (size_t)NPROJ_PAD * DMODEL * 2; GAS v4u* zp = (GAS v4u*)((unsigned char*)F.WinT + z0);
      const size_t nz = (z1 - z0) / 16; for (size_t i = (size_t)F.bid * NTHR + F.tid; i < nz; i += (size_t)F.G * NTHR) zp[i] = (v4u){0u, 0u, 0u, 0u}; }
    for (int m = gw; m < MROWS; m += NGW) {
        const float* xrow = (m < NPR) ? F.x_prompt + (size_t)m * DMODEL : F.x_sample + (size_t)(m - NPR) * DMODEL;
        const GAS f32x4* xr = (const GAS f32x4*)xrow + F.lane; const GAS f32x4* gr = (const GAS f32x4*)F.norm_g + F.lane;
        f32x4 v[8]; float s = 0.f;
#pragma unroll
        for (int j = 0; j < 8; ++j) { v[j] = xr[64 * j]; s += (v[j].x * v[j].x + v[j].y * v[j].y) + (v[j].z * v[j].z + v[j].w * v[j].w); }
        const float r = 1.f / sqrtf(wave_sum(s) * (1.f / DMODEL) + EPS);
        GAS unsigned long long* o8 = (GAS unsigned long long*)(F.XN + (size_t)m * DMODEL) + F.lane;
#pragma unroll
        for (int j = 0; j < 8; ++j) { const f32x4 g = gr[64 * j]; o8[64 * j] = (unsigned long long)pk2(v[j].x * r * g.x, v[j].y * r * g.y) | ((unsigned long long)pk2(v[j].z * r * g.z, v[j].w * r * g.w) << 32); }
    }
}

__device__ __forceinline__ void pool_unit(Frame& F, int tile, int gi) {
    LAS float* pooled = (LAS float*)F.lds;
    const int w = 2 << gi, m0 = tile * 32, c = F.tid & 255, th = F.tid >> 8, ch = gi * 256 + c;
    for (int i = 0; i < 16; ++i) {
        const int t = th * 16 + i, m = m0 + t; const bool prompt = m < NPR;
        int b, tq, cnt; if (prompt) { b = m >> 11; tq = m & 2047; cnt = min(w, tq + 1); } else { const int ms = m - NPR; b = ms >> 2; tq = ms & 3; cnt = w; }
        float sum = 0.f;
        for (int j = 0; j < w; ++j) { const int tt = tq - j; float v;
            if (tt >= 0) v = bf2f(F.PROJ[(size_t)(m - j) * PLD + ch]); else v = prompt ? 0.f : F.state_pool[(size_t)(b * 15 + 15 + tt) * DPOOL + ch];
            sum += v; }
        const float u0 = bf2f(F.PROJ[(size_t)m * PLD + ch]);
        pooled[t * 256 + c] = sum / (float)cnt - u0;
    }
    __syncthreads();
    float acc[16];
#pragma unroll
    for (int i = 0; i < 16; ++i) acc[i] = 0.f;
    const float* W = F.pool_w + (size_t)gi * 65536 + c;
    for (int c4 = 0; c4 < 64; ++c4) {
        const float w0 = W[(size_t)(4 * c4 + 0) * 256], w1 = W[(size_t)(4 * c4 + 1) * 256], w2 = W[(size_t)(4 * c4 + 2) * 256], w3 = W[(size_t)(4 * c4 + 3) * 256];
#pragma unroll
        for (int i = 0; i < 16; ++i) { const f32x4 p4 = *(const LAS f32x4*)(pooled + (th * 16 + i) * 256 + 4 * c4); acc[i] += (p4.x * w0 + p4.y * w1) + (p4.z * w2 + p4.w * w3); }
    }
    const float sc = F.pool_scale[ch];
#pragma unroll
    for (int i = 0; i < 16; ++i) { const int m = m0 + th * 16 + i; const float gate = bf2f(F.PROJ[(size_t)m * PLD + C_GATE + ch]);
        F.MIX[(size_t)m * DMIX + ch] = (bf16)f2bf(acc[i] * sc * silu_f(gate)); }
    __syncthreads();
}

__device__ __forceinline__ void ssd_unit(Frame& F, int seq, int h) {
    const bool prompt = seq < 4; const int L = prompt ? 2048 : 4, sb = seq - 4, row0 = prompt ? seq * 2048 : NPR + sb * 4, g = h / 6;
    const int p = F.tid >> 3, nq = F.tid & 7;
    LAS float* T = (LAS float*)F.lds;
    LAS float* dts = T + 32 * 320; LAS float* dec = dts + 32;
    float S[16];
    if (prompt) {
#pragma unroll
        for (int j = 0; j < 16; ++j) S[j] = 0.f;
    } else { const f32x4* sp = (const f32x4*)(F.state_ssm + ((size_t)(sb * NHEAD + h) * HDIM + p) * DSTATE + nq * 16);
#pragma unroll
        for (int q = 0; q < 4; ++q) { const f32x4 v = sp[q]; S[4 * q] = v.x; S[4 * q + 1] = v.y; S[4 * q + 2] = v.z; S[4 * q + 3] = v.w; } }
    const float a = -__expf(F.a_log[h]), dtb = F.dt_bias[h], dsk = F.d_skip[h];
    for (int t0 = 0; t0 < L; t0 += 32) {
        const int nt = min(32, L - t0);
        __syncthreads();
        for (int e = F.tid; e < nt * 320; e += NTHR) {
            const int t = e / 320, c = e - t * 320;
            const int xch = c < 64 ? h * 64 + c : (c < 192 ? 3072 + g * 128 + (c - 64) : 4096 + g * 128 + (c - 192));
            float acc = F.conv_b[xch];
#pragma unroll
            for (int k = 0; k < 4; ++k) { const int tt = t0 + t + k - 3; float v;
                if (tt >= 0) v = bf2f(F.PROJ[(size_t)(row0 + tt) * PLD + C_XBC + xch]); else v = prompt ? 0.f : F.state_conv[(size_t)(sb * 3 + 3 + tt) * DCONV + xch];
                acc += v * F.conv_w[k * DCONV + xch]; }
            T[e] = silu_f(acc);
        }
        for (int t = F.tid; t < nt; t += NTHR) { const float dt = softplus_f(F.DTRAW[(size_t)(row0 + t0 + t) * 64 + h] + dtb); dts[t] = dt; dec[t] = __expf(dt * a); }
        __syncthreads();
        for (int t = 0; t < nt; ++t) {
            const LAS float* r = T + t * 320;
            const float x = r[p], d = dec[t], dtx = dts[t] * x; float acc = 0.f;
#pragma unroll
            for (int q = 0; q < 4; ++q) { const f32x4 bv = *(const LAS f32x4*)(r + 64 + nq * 16 + 4 * q), cv = *(const LAS f32x4*)(r + 192 + nq * 16 + 4 * q);
                S[4 * q] = d * S[4 * q] + dtx * bv.x; S[4 * q + 1] = d * S[4 * q + 1] + dtx * bv.y; S[4 * q + 2] = d * S[4 * q + 2] + dtx * bv.z; S[4 * q + 3] = d * S[4 * q + 3] + dtx * bv.w;
                acc += (cv.x * S[4 * q] + cv.y * S[4 * q + 1]) + (cv.z * S[4 * q + 2] + cv.w * S[4 * q + 3]); }
            acc += __shfl_xor(acc, 1); acc += __shfl_xor(acc, 2); acc += __shfl_xor(acc, 4);
            if (nq == 0) F.YBUF[(size_t)(row0 + t0 + t) * DSSM + h * 64 + p] = acc + dsk * x;
        }
    }
    float* so = F.out + (prompt ? O_SSM_P + ((size_t)(seq * NHEAD + h) * HDIM + p) * DSTATE : O_SSM_S + ((size_t)(sb * NHEAD + h) * HDIM + p) * DSTATE) + nq * 16;
#pragma unroll
    for (int q = 0; q < 4; ++q) *(f32x4*)(so + 4 * q) = (f32x4){S[4 * q], S[4 * q + 1], S[4 * q + 2], S[4 * q + 3]};
    __syncthreads();
}

__device__ __forceinline__ void p2_copies(Frame& F) {
    const size_t gt = (size_t)F.bid * NTHR + F.tid, GT = (size_t)F.G * NTHR;
    for (size_t i = gt; i < (size_t)4 * 15 * DPOOL; i += GT) { const int ch = i % DPOOL, r = (i / DPOOL) % 15, b = i / (DPOOL * 15);
        F.out[O_POOL_P + i] = bf2f(F.PROJ[(size_t)(b * 2048 + 2033 + r) * PLD + ch]); }
    for (size_t i = gt; i < (size_t)4 * 3 * DCONV; i += GT) { const int ch = i % DCONV, r = (i / DCONV) % 3, b = i / (DCONV * 3);
        F.out[O_CONV_P + i] = bf2f(F.PROJ[(size_t)(b * 2048 + 2045 + r) * PLD + C_XBC + ch]); }
    for (size_t i = gt; i < (size_t)128 * 15 * DPOOL; i += GT) { const int ch = i % DPOOL, r = (i / DPOOL) % 15, b = i / (DPOOL * 15);
        F.out[O_POOL_S + i] = r < 11 ? F.state_pool[(size_t)(b * 15 + r + 4) * DPOOL + ch] : bf2f(F.PROJ[(size_t)(NPR + b * 4 + r - 11) * PLD + ch]); }
    for (size_t i = gt; i < (size_t)128 * 3 * DCONV; i += GT) { const int ch = i % DCONV, r = (i / DCONV) % 3, b = i / (DCONV * 3);
        F.out[O_CONV_S + i] = bf2f(F.PROJ[(size_t)(NPR + b * 4 + 1 + r) * PLD + C_XBC + ch]); }
}

__device__ __forceinline__ void p3_gate_norm(Frame& F) {
    const int gw = F.bid * NWAVES + F.wave, NGW = F.G * NWAVES;
    for (int task = gw; task < MROWS * NGRP; task += NGW) {
        const int m = task >> 3, g = task & 7; float v[6]; float ss = 0.f;
#pragma unroll
        for (int k = 0; k < 6; ++k) { const int idx = g * 384 + F.lane + 64 * k; const float y = F.YBUF[(size_t)m * DSSM + idx], z = bf2f(F.PROJ[(size_t)m * PLD + C_Z + idx]);
            v[k] = y * silu_f(z); ss += v[k] * v[k]; }
        const float r = 1.f / sqrtf(wave_sum(ss) * (1.f / 384.f) + EPS);
#pragma unroll
        for (int k = 0; k < 6; ++k) { const int idx = g * 384 + F.lane + 64 * k; F.MIX[(size_t)m * DMIX + DPOOL + idx] = (bf16)f2bf(v[k] * r * F.ssm_norm_g[idx]); }
    }
}
__device__ __forceinline__ void p5_final_norm(Frame& F) {
    const int gw = F.bid * NWAVES + F.wave, NGW = F.G * NWAVES;
    for (int m = gw; m < MROWS; m += NGW) {
        GAS f32x4* yr = (GAS f32x4*)(F.out + O_Y + (size_t)m * DMODEL) + F.lane; const GAS f32x4* gr = (const GAS f32x4*)F.final_g + F.lane;
        f32x4 v[8]; float s = 0.f;
#pragma unroll
        for (int j = 0; j < 8; ++j) { v[j] = yr[64 * j]; s += (v[j].x * v[j].x + v[j].y * v[j].y) + (v[j].z * v[j].z + v[j].w * v[j].w); }
        const float r = 1.f / sqrtf(wave_sum(s) * (1.f / DMODEL) + EPS);
#pragma unroll
        for (int j = 0; j < 8; ++j) { const f32x4 g = gr[64 * j]; yr[64 * j] = (f32x4){v[j].x * r * g.x, v[j].y * r * g.y, v[j].z * r * g.z, v[j].w * r * g.w}; }
    }
}

struct Args { const float* in[17]; float* out; unsigned char* ws; int ph_lo, ph_hi; };
constexpr int N_PHASES = 6;
__global__ void __launch_bounds__(NTHR, 2) fwd(Args args) {
    extern __shared__ __attribute__((aligned(16))) unsigned char lds_raw[];
    Frame F;
    F.lds = (LAS unsigned char*)lds_raw;
    F.tid = threadIdx.x; F.lane = F.tid & 63; F.wave = __builtin_amdgcn_readfirstlane(F.tid >> 6); F.G = gridDim.x; F.bid = blockIdx.x;
    unsigned char* ws = args.ws;
    F.x_prompt = args.in[0]; F.x_sample = args.in[1]; F.state_pool = args.in[2]; F.state_conv = args.in[3]; F.state_ssm = args.in[4]; F.norm_g = args.in[5]; F.w_in = args.in[6];
    F.conv_w = args.in[7]; F.conv_b = args.in[8]; F.dt_bias = args.in[9]; F.a_log = args.in[10]; F.d_skip = args.in[11]; F.ssm_norm_g = args.in[12]; F.pool_w = args.in[13];
    F.pool_scale = args.in[14]; F.w_out = args.in[15]; F.final_g = args.in[16]; F.out = args.out;
    F.XN = (bf16*)(ws + WS_XN); F.WinT = (bf16*)(ws + WS_WINT); F.WoutT = (bf16*)(ws + WS_WOUTT); F.PROJ = (bf16*)(ws + WS_PROJ); F.MIX = (bf16*)(ws + WS_MIX);
    F.DTRAW = (float*)(ws + WS_DTRAW); F.YBUF = (float*)(ws + WS_YBUF);
    for (int u = F.tid; u < (LDS_BYTES - LDSCTL_OFF) / 4; u += NTHR) ((LAS unsigned*)(F.lds + LDSCTL_OFF))[u] = 0u;
    __syncthreads();
    const int lo = args.ph_lo, hi = args.ph_hi;
    XcdBarrier bar; bar.bar = (unsigned*)(ws + WS_CTL) + CW_BAR; bar.x = 0; bar.st = nullptr;
    if (hi - lo > 1) bar = xcd_barrier_post((unsigned*)(ws + WS_CTL) + CW_BAR, (volatile LAS unsigned*)(F.lds + MISC_OFF) + 8);
#define IN(k) (lo <= (k) && (k) < hi)
#define BOTH(k) (IN(k) && IN((k) + 1))
    if (IN(0)) { p0_prologue(F); if (BOTH(0)) xcd_barrier(bar); }
    if (IN(1)) {
        pg8::Gemm g{F.XN, F.WinT, MROWS, NPROJ_PAD, DMODEL}; pg8::StaticOrder S; S.init(MROWS, NPROJ_PAD, F.G, F.bid);
        pg8::EpiProj E{F.PROJ, F.DTRAW};
        pg8::gemm_phase<pg8::EpiProj, pg8::StaticOrder, true, true>(F.lds, g, S, E);
        if (BOTH(1)) xcd_barrier(bar);
    }
    if (IN(2)) {
        if (F.bid < 192) ssd_unit(F, F.bid / 48, F.bid % 48);
        constexpr int NPOOL = (MROWS / 32) * 4, NSS = 128 * 48;
        for (int i = F.bid; i < NPOOL + NSS; i += F.G) {
            if (i < NPOOL) pool_unit(F, i >> 2, i & 3); else { const int j = i - NPOOL; ssd_unit(F, 4 + j / 48, j % 48); }
        }
        p2_copies(F);
        if (BOTH(2)) xcd_barrier(bar);
    }
    if (IN(3)) { p3_gate_norm(F); if (BOTH(3)) xcd_barrier(bar); }
    if (IN(4)) {
        pg8::Gemm g{F.MIX, F.WoutT, MROWS, DMODEL, DMIX}; pg8::StaticOrder S; S.init(MROWS, DMODEL, F.G, F.bid);
        pg8::EpiOut E{F.x_prompt, F.x_sample, F.out};
        pg8::gemm_phase<pg8::EpiOut, pg8::StaticOrder, true, true>(F.lds, g, S, E);
        if (BOTH(4)) xcd_barrier(bar);
    }
    if (IN(5)) { p5_final_norm(F); }
#undef IN
#undef BOTH
}

#ifndef N_LAUNCHES
#define N_LAUNCHES 1
#endif
extern "C" void kernel_launch(void* const* d_in, const int* in_sizes, int n_in, void* d_out, int out_size, void* d_ws, size_t ws_size, hipStream_t stream) {
    static int grid = 0;
    if (grid == 0) {
        if (n_in != 17 || out_size != 73785344 || ws_size < WS_END) { fprintf(stderr, "kernel_launch: unexpected shapes: n_in %d out %d ws %zu\n", n_in, out_size, ws_size); grid = -1; return; }
        int dev = 0, cus = 0, per_cu = 0;
        if (hipGetDevice(&dev) != hipSuccess || hipDeviceGetAttribute(&cus, hipDeviceAttributeMultiprocessorCount, dev) != hipSuccess) { fprintf(stderr, "kernel_launch: device query failed\n"); grid = -1; return; }
        if (hipFuncSetAttribute((const void*)fwd, hipFuncAttributeMaxDynamicSharedMemorySize, LDS_BYTES) != hipSuccess) { fprintf(stderr, "kernel_launch: hipFuncSetAttribute failed\n"); grid = -1; return; }
        if (hipOccupancyMaxActiveBlocksPerMultiprocessor(&per_cu, (const void*)fwd, NTHR, LDS_BYTES) != hipSuccess || per_cu < 1) { fprintf(stderr, "kernel_launch: occupancy query says %d blocks per CU\n", per_cu); }
        (void)hipGetLastError();
        grid = cus;
    }
    if (grid < 0) return;
    (void)hipMemsetAsync((char*)d_ws + WS_CTL, 0, CTL_ZERO_BYTES, stream);
    Args a{};
    for (int i = 0; i < 17; ++i) a.in[i] = (const float*)d_in[i];
    a.out = (float*)d_out; a.ws = (unsigned char*)d_ws;
    if (N_LAUNCHES == 1) {
        a.ph_lo = 0; a.ph_hi = N_PHASES;
        void* kargs[] = {&a};
        hipError_t e = hipLaunchCooperativeKernel((const void*)fwd, dim3(grid), dim3(NTHR), kargs, LDS_BYTES, stream);
        if (e != hipSuccess) fprintf(stderr, "kernel_launch: cooperative launch failed: %s\n", hipGetErrorString(e));
    } else {
        for (int li = 0; li < N_PHASES; ++li) { a.ph_lo = li; a.ph_hi = li + 1; hipLaunchKernelGGL(fwd, dim3(grid), dim3(NTHR), LDS_BYTES, stream, a); }
    }
}
```

```cpp
#include <hip/hip_runtime.h>
#include <cstdio>
#include <cstdint>
namespace pg8 {
#define PG8_LAS __attribute__((address_space(3)))
typedef unsigned short bf16_t;
typedef short bf16x8 __attribute__((ext_vector_type(8)));
typedef float f32x4 __attribute__((ext_vector_type(4)));
typedef unsigned u32x4 __attribute__((ext_vector_type(4)));
constexpr int BM = 256, BK = 64, HALF = 128, HTB = HALF * BK * 2  , STAGE_BYTES = 8 * HTB, NXCD = 8, WGM = 8;

__host__ __device__ __forceinline__ int lds_byte(int r, int c) { const int st = (r >> 4) * 2 + (c >> 5), rr = r & 15, cc = c & 31, ob = rr * 64 + cc * 2; return st * 1024 + (ob ^ (((ob >> 9) & 1) << 5)); }
__host__ __device__ __forceinline__ void stage_rc(int b, int& R, int& C) { const int st = b / 1024, sb = b % 1024, swz = sb ^ (((sb >> 9) & 1) << 5); R = (st >> 1) * 16 + swz / 64; C = (st & 1) * 32 + (swz % 64) / 2; }
__host__ __device__ __forceinline__ int perm32(int rho) { const int n = rho >> 4, i = rho & 15; return 8 * (i >> 2) + 4 * n + (i & 3); }

struct Unit { int pm, pn; };
struct Gemm { const bf16_t* A; const bf16_t* Bt; int M, N, K; };

struct StaticOrder {
    int nM, nN, nwg, G, c;
    __host__ __device__ void init(int M, int N, int G_, int c_) { nM = M / BM; nN = N / BM; nwg = nM * nN; G = G_; c = c_; }
    __host__ __device__ bool next(int i, Unit& u) const {
        const long L = (long)i * G + c; if (L >= nwg) return false;
        int wgid = (int)L; { const int q = nwg / NXCD, r = nwg % NXCD, xcd = wgid % NXCD, off = wgid / NXCD; wgid = (xcd < r ? xcd * (q + 1) : r * (q + 1) + (xcd - r) * q) + off; }
        const int nig = WGM * nN, gid = wgid / nig, fm = gid * WGM, gsz = (nM - fm) < WGM ? (nM - fm) : WGM;
        u.pm = fm + ((wgid % nig) % gsz); u.pn = (wgid % nig) / gsz; return true;
    }
    __device__ __forceinline__ void a_ready(const Unit&) const {}
    __device__ __forceinline__ void done(const Unit&) const {}
};

__device__ __forceinline__ unsigned cvt_pk_bf16(float lo, float hi) { unsigned r; asm volatile("v_cvt_pk_bf16_f32 %0, %1, %2" : "=v"(r) : "v"(lo), "v"(hi)); return r; }

struct EpiProj {
    static constexpr bool PERM = true, AFTER_DRAIN = false;
    bf16_t* P; float* dtraw;
    __device__ __forceinline__ void operator()(const f32x4 (&acc)[2][2][4][2], const Unit& u, int wr, int wc, int fr, int fq) const {
        const int row0 = u.pm * BM + wr * 64 + fr;
        if (u.pn < 40) {
            const int col0 = u.pn * BM + wc * 32 + 8 * fq;
#pragma unroll
            for (int ai = 0; ai < 2; ++ai)
#pragma unroll
                for (int m = 0; m < 4; ++m) { bf16_t* rowp = P + (size_t)(row0 + ai * HALF + m * 16) * 10240 + col0;
#pragma unroll
                    for (int bj = 0; bj < 2; ++bj) { const f32x4 v0 = acc[ai][bj][m][0], v1 = acc[ai][bj][m][1];
                        u32x4 w; w.x = cvt_pk_bf16(v0[0], v0[1]); w.y = cvt_pk_bf16(v0[2], v0[3]); w.z = cvt_pk_bf16(v1[0], v1[1]); w.w = cvt_pk_bf16(v1[2], v1[3]);
                        *(u32x4*)(rowp + bj * HALF) = w; } }
        } else if (wc < 2) {
#pragma unroll
            for (int ai = 0; ai < 2; ++ai)
#pragma unroll
                for (int m = 0; m < 4; ++m) { float* rp = dtraw + (size_t)(row0 + ai * HALF + m * 16) * 64 + wc * 32 + 8 * fq;
                    *(f32x4*)rp = acc[ai][0][m][0]; *(f32x4*)(rp + 4) = acc[ai][0][m][1]; }
        }
    }
};
struct EpiOut {
    static constexpr bool PERM = false, AFTER_DRAIN = false;
    const float* xp; const float* xs; float* out;
    __device__ __forceinline__ void operator()(const f32x4 (&acc)[2][2][4][2], const Unit& u, int wr, int wc, int fr, int fq) const {
        const int row0 = u.pm * BM + wr * 64 + fr, col0 = u.pn * BM + wc * 32 + 4 * fq;
        const float* xb = (u.pm < 32) ? xp : xs - (size_t)8192 * 2048;
#pragma unroll
        for (int ai = 0; ai < 2; ++ai)
#pragma unroll
            for (int m = 0; m < 4; ++m) { const size_t ro = (size_t)(row0 + ai * HALF + m * 16) * 2048 + col0;
#pragma unroll
                for (int bj = 0; bj < 2; ++bj)
#pragma unroll
                    for (int n = 0; n < 2; ++n) { const f32x4 xv = *(const f32x4*)(xb + ro + bj * HALF + n * 16);
                        *(f32x4*)(out + ro + bj * HALF + n * 16) = xv + acc[ai][bj][m][n]; } }
    }
};

template <class Epi, class Sched, bool ALIGN_EPI = false, bool SP2 = false>
__device__ __forceinline__ void gemm_phase(PG8_LAS unsigned char* lds, const Gemm g, const Sched& S, const Epi& E) {
    const int tid = threadIdx.x, wid = __builtin_amdgcn_readfirstlane(tid >> 6), lane = tid & 63, wr = wid >> 2, wc = wid & 3, fr = lane & 15, fq = lane >> 4;
    const int K = g.K, nt = K / BK;
    unsigned voffA[2], voffB[2];
#pragma unroll
    for (int i = 0; i < 2; ++i) { int R, C; stage_rc(tid * 16 + i * 8192, R, C); const int Rb = Epi::PERM ? ((R & ~31) + perm32(R & 31)) : R;
        voffA[i] = (unsigned)(R * K + C) * 2u; voffB[i] = (unsigned)(Rb * K + C) * 2u; }
    const size_t kstep = (size_t)(BK * 2);
    const size_t hstep = (size_t)HALF * K * 2;
    const size_t tstep = 2 * hstep;
    const unsigned ldsw = (unsigned)wid * 1024u;
    const int aoff = lds_byte(wr * 64 + fr, fq * 8), boff = lds_byte(wc * 32 + fr, fq * 8);
#define PG8_SA(b, h) (((b) * 2 + (h)) * HTB)
#define PG8_SB(b, h) ((4 + (b) * 2 + (h)) * HTB)
#define PG8_STAGE(bufoff, gbase, voff) do { _Pragma("unroll") for (int _i = 0; _i < 2; ++_i) \
        __builtin_amdgcn_global_load_lds((const unsigned*)((const char*)(gbase) + (voff)[_i]), (PG8_LAS unsigned*)(lds + (bufoff) + ldsw + _i * 8192), 16, 0, 0); } while (0)
#define PG8_LDA(dst, b, h) do { _Pragma("unroll") for (int m = 0; m < 4; ++m) _Pragma("unroll") for (int k = 0; k < 2; ++k) dst[m][k] = *(const PG8_LAS bf16x8*)(lds + PG8_SA(b, h) + aoff + m * 2048 + k * 1024); } while (0)
#define PG8_LDB(dst, b, h) do { _Pragma("unroll") for (int n = 0; n < 2; ++n) _Pragma("unroll") for (int k = 0; k < 2; ++k) dst[n][k] = *(const PG8_LAS bf16x8*)(lds + PG8_SB(b, h) + boff + n * 2048 + k * 1024); } while (0)
#define PG8_MMA(ai, bj, At, Bt) do { __builtin_amdgcn_s_setprio(1); _Pragma("unroll") for (int m = 0; m < 4; ++m) _Pragma("unroll") for (int n = 0; n < 2; ++n) _Pragma("unroll") for (int k = 0; k < 2; ++k) \
        acc[ai][bj][m][n] = __builtin_amdgcn_mfma_f32_16x16x32_bf16(Bt[n][k], At[m][k], acc[ai][bj][m][n], 0, 0, 0); __builtin_amdgcn_s_setprio(0); } while (0)
#define PG8_WAIT_V(n) asm volatile("s_waitcnt vmcnt(" #n ")" ::: "memory")
#define PG8_WAIT_L(n) asm volatile("s_waitcnt lgkmcnt(" #n ")" ::: "memory")
#define PG8_BAR __builtin_amdgcn_s_barrier()
#define PG8_SCHED __builtin_amdgcn_sched_barrier(0)
    Unit cur, nxt; int ui = 0;
    if (!S.next(0, cur)) return;
    f32x4 acc[2][2][4][2];
#pragma unroll
    for (int a = 0; a < 2; ++a)
#pragma unroll
        for (int b = 0; b < 2; ++b)
#pragma unroll
            for (int m = 0; m < 4; ++m)
#pragma unroll
                for (int n = 0; n < 2; ++n) acc[a][b][m][n] = (f32x4){0.f, 0.f, 0.f, 0.f};
    bf16x8 At[4][2], B0[2][2], B1[2][2];
    const char* cA = (const char*)g.A + (size_t)cur.pm * tstep; const char* cB = (const char*)g.Bt + (size_t)cur.pn * tstep;
    S.a_ready(cur);
    if constexpr (SP2) {
        PG8_STAGE(PG8_SB(0, 0), cB, voffB); PG8_STAGE(PG8_SB(0, 1), cB + hstep, voffB); PG8_STAGE(PG8_SA(0, 0), cA, voffA); PG8_STAGE(PG8_SA(0, 1), cA + hstep, voffA);
        if (wr == 1) PG8_BAR;
        PG8_WAIT_V(2); PG8_BAR;
        PG8_STAGE(PG8_SB(1, 0), cB + kstep, voffB); PG8_STAGE(PG8_SA(1, 0), cA + kstep, voffA); PG8_STAGE(PG8_SB(1, 1), cB + hstep + kstep, voffB);
        PG8_WAIT_V(6); PG8_BAR;
    } else {
        PG8_STAGE(PG8_SB(0, 0), cB, voffB); PG8_STAGE(PG8_SA(0, 0), cA, voffA); PG8_STAGE(PG8_SB(0, 1), cB + hstep, voffB); PG8_STAGE(PG8_SA(0, 1), cA + hstep, voffA);
        if (wr == 1) PG8_BAR;
        PG8_WAIT_V(4); PG8_BAR;
        PG8_STAGE(PG8_SB(1, 0), cB + kstep, voffB); PG8_STAGE(PG8_SA(1, 0), cA + kstep, voffA); PG8_STAGE(PG8_SB(1, 1), cB + hstep + kstep, voffB);
        PG8_WAIT_V(6); PG8_BAR;
    }
    for (;;) {
        const bool has_next = S.next(ui + 1, nxt);
        const char* nA = has_next ? (const char*)g.A + (size_t)nxt.pm * tstep : cA; const char* nB = has_next ? (const char*)g.Bt + (size_t)nxt.pn * tstep : cB;
        for (int t = 0; t < nt; t += 2) {
            const bool last = (t == nt - 2);
            const char* a1 = cA + (size_t)(t + 1) * kstep;
            const char* a2 = last ? nA : cA + (size_t)(t + 2) * kstep; const char* b2 = last ? nB : cB + (size_t)(t + 2) * kstep;
            const char* a3 = a2 + kstep; const char* b3 = b2 + kstep;
            if (last && has_next) S.a_ready(nxt);
            if constexpr (SP2) {
            PG8_LDB(B0, 0, 0); PG8_LDB(B1, 0, 1); PG8_SCHED; PG8_LDA(At, 0, 0); PG8_STAGE(PG8_SA(1, 1), a1 + hstep, voffA);
            PG8_WAIT_V(8); PG8_WAIT_L(0); PG8_BAR; PG8_MMA(0, 0, At, B0); PG8_MMA(0, 1, At, B1); PG8_BAR; PG8_SCHED;
            PG8_LDA(At, 0, 1); PG8_STAGE(PG8_SB(0, 0), b2, voffB); PG8_STAGE(PG8_SB(0, 1), b2 + hstep, voffB); PG8_STAGE(PG8_SA(0, 0), a2, voffA);
            PG8_WAIT_V(8); PG8_WAIT_L(0); PG8_BAR; PG8_MMA(1, 0, At, B0); PG8_MMA(1, 1, At, B1); PG8_BAR; PG8_SCHED;
            PG8_LDB(B0, 1, 0); PG8_LDB(B1, 1, 1); PG8_SCHED; PG8_LDA(At, 1, 0); PG8_STAGE(PG8_SA(0, 1), a2 + hstep, voffA);
            PG8_WAIT_V(8); PG8_WAIT_L(0); PG8_BAR; PG8_MMA(0, 0, At, B0); PG8_MMA(0, 1, At, B1); PG8_BAR; PG8_SCHED;
            PG8_LDA(At, 1, 1); PG8_STAGE(PG8_SB(1, 0), b3, voffB); PG8_STAGE(PG8_SB(1, 1), b3 + hstep, voffB); PG8_STAGE(PG8_SA(1, 0), a3, voffA);
            PG8_WAIT_V(8); PG8_WAIT_L(0); PG8_BAR; PG8_MMA(1, 0, At, B0); PG8_MMA(1, 1, At, B1); PG8_BAR; PG8_SCHED;
            } else {
            PG8_LDB(B0, 0, 0); PG8_SCHED; PG8_LDA(At, 0, 0); PG8_STAGE(PG8_SA(1, 1), a1 + hstep, voffA);
            PG8_WAIT_L(8); PG8_BAR; PG8_WAIT_L(0); PG8_MMA(0, 0, At, B0); PG8_BAR; PG8_SCHED;
            PG8_LDB(B1, 0, 1); PG8_STAGE(PG8_SB(0, 0), b2, voffB);
            PG8_BAR; PG8_WAIT_L(0); PG8_MMA(0, 1, At, B1); PG8_BAR;
            PG8_LDA(At, 0, 1); PG8_STAGE(PG8_SA(0, 0), a2, voffA);
            PG8_BAR; PG8_WAIT_L(0); PG8_MMA(1, 0, At, B0); PG8_BAR; PG8_SCHED;
            PG8_STAGE(PG8_SB(0, 1), b2 + hstep, voffB);
            PG8_WAIT_V(6); PG8_BAR; PG8_MMA(1, 1, At, B1); PG8_BAR;
            PG8_LDB(B0, 1, 0); PG8_SCHED; PG8_LDA(At, 1, 0); PG8_STAGE(PG8_SA(0, 1), a2 + hstep, voffA);
            PG8_WAIT_L(8); PG8_BAR; PG8_WAIT_L(0); PG8_MMA(0, 0, At, B0); PG8_BAR; PG8_SCHED;
            PG8_LDB(B1, 1, 1); PG8_STAGE(PG8_SB(1, 0), b3, voffB);
            PG8_BAR; PG8_WAIT_L(0); PG8_MMA(0, 1, At, B1); PG8_BAR;
            PG8_LDA(At, 1, 1); PG8_STAGE(PG8_SA(1, 0), a3, voffA);
            PG8_BAR; PG8_WAIT_L(0); PG8_MMA(1, 0, At, B0); PG8_BAR; PG8_SCHED;
            PG8_STAGE(PG8_SB(1, 1), b3 + hstep, voffB);
            PG8_WAIT_V(6); PG8_BAR; PG8_MMA(1, 1, At, B1); PG8_BAR;
            }
        }
        if constexpr (ALIGN_EPI) { if (wr == 0) PG8_BAR; }
        if constexpr (!Epi::AFTER_DRAIN) { E(acc, cur, wr, wc, fr, fq); S.done(cur); }
        if (!has_next) break;
#pragma unroll
        for (int a = 0; a < 2; ++a)
#pragma unroll
            for (int b = 0; b < 2; ++b)
#pragma unroll
                for (int m = 0; m < 4; ++m)
#pragma unroll
                    for (int n = 0; n < 2; ++n) acc[a][b][m][n] = (f32x4){0.f, 0.f, 0.f, 0.f};
        cur = nxt; cA = nA; cB = nB; ++ui;
        if constexpr (ALIGN_EPI) { if (wr == 1) PG8_BAR; }
    }
    PG8_WAIT_V(0);
    if constexpr (!ALIGN_EPI) { if (wr == 0) PG8_BAR; }
    PG8_BAR;
    if constexpr (Epi::AFTER_DRAIN) { E.fused(acc, cur, wr, wc, fr, fq, lds, wid, lane); S.done(cur); }
#undef PG8_SA
#undef PG8_SB
#undef PG8_STAGE
#undef PG8_LDA
#undef PG8_LDB
#undef PG8_MMA
#undef PG8_WAIT_V
#undef PG8_WAIT_L
#undef PG8_BAR
#undef PG8_SCHED
}

}

constexpr int DMODEL = 2048, NPR = 8192  , NSM = 512  , MROWS = NPR + NSM;
constexpr int DPOOL = 1024, DSSM = 3072, DCONV = 5120, NHEAD = 48, HDIM = 64, NGRP = 8, DSTATE = 128, DMIX = 4096;
constexpr int NPROJ = 10288, PLD = 10240  , NPROJ_PAD = 10496  ;
constexpr int C_GATE = 1024, C_Z = 2048, C_XBC = 5120;
constexpr float EPS = 1e-5f;
constexpr size_t O_Y = 0, O_POOL_P = 17825792, O_CONV_P = 17887232, O_SSM_P = 17948672, O_POOL_S = 19521536, O_CONV_S = 21487616, O_SSM_S = 23453696;
constexpr size_t MiB = 1u << 20;
constexpr size_t WS_CTL = 0, CTL_ZERO_BYTES = 1 * MiB;
constexpr size_t WS_XN = 2 * MiB;
constexpr size_t WS_WINT = 36 * MiB;
constexpr size_t WS_WOUTT = 78 * MiB;
constexpr size_t WS_PROJ = 96 * MiB;
constexpr size_t WS_DTRAW = 268 * MiB;
constexpr size_t WS_MIX = 272 * MiB;
constexpr size_t WS_YBUF = 344 * MiB;
constexpr size_t WS_ST = 448 * MiB;
constexpr size_t WS_SIN = 544 * MiB;
constexpr size_t WS_CHDEC = 592 * MiB;
constexpr size_t WS_END = 593 * MiB;
constexpr int CW_BAR = 4096;
constexpr int NWAVES = 8, NTHR = 512;
constexpr int RING_BYTES = 131072, LDSCTL_OFF = RING_BYTES, MISC_OFF = LDSCTL_OFF + 320, LDS_BYTES = 147456;

#define GAS __attribute__((address_space(1)))
#define LAS __attribute__((address_space(3)))
typedef unsigned short bf16;
typedef unsigned v4u __attribute__((ext_vector_type(4)));
typedef float f32x4 __attribute__((ext_vector_type(4)));
#define LDS_WAIT() asm volatile("s_waitcnt lgkmcnt(0)" ::: "memory")
#define VM_WAIT() asm volatile("s_waitcnt vmcnt(0)" ::: "memory")
__device__ __forceinline__ unsigned f2bf(float f) { unsigned u = __builtin_bit_cast(unsigned, f); return (u + 0x7fffu + ((u >> 16) & 1u)) >> 16; }
__device__ __forceinline__ unsigned pk2(float lo, float hi) { return f2bf(lo) | (f2bf(hi) << 16); }
__device__ __forceinline__ float bf2f(bf16 v) { return __builtin_bit_cast(float, (unsigned)v << 16); }
__device__ __forceinline__ float silu_f(float x) { return x / (1.f + __expf(-x)); }
__device__ __forceinline__ float softplus_f(float x) { return fmaxf(x, 0.f) + log1pf(__expf(-fabsf(x))); }
__device__ __forceinline__ float wave_sum(float v) {
#pragma unroll
    for (int o = 1; o < 64; o <<= 1) v += __shfl_xor(v, o);
    return v;
}

#define XB_TMO      128
#define XB_XCNT(j)  (256  + 64 * (j))
#define XB_XSUB(j)  (1280 + 64 * (j))
#define XB_XGEN(j)  (2304 + 64 * (j))
#define XB_TOP      3328
#define XB_TOPGEN   3392
#define XCD_BAR_WORDS 3456
#define XB_SPIN_CAP (1u << 18)

__device__ __forceinline__ unsigned xb_ld(unsigned* p)              { return __hip_atomic_load(p, __ATOMIC_RELAXED, __HIP_MEMORY_SCOPE_AGENT); }
__device__ __forceinline__ unsigned xb_add(unsigned* p, unsigned v) { return __hip_atomic_fetch_add(p, v, __ATOMIC_RELAXED, __HIP_MEMORY_SCOPE_AGENT); }
__device__ __forceinline__ unsigned xb_xcc_id() { return (unsigned)__builtin_amdgcn_s_getreg((3 << 11) | 20) & 0xFu; }
#define XB_SPIN(cond, bar) do { unsigned _sp = 0; while (cond) { __builtin_amdgcn_s_sleep(1); \
    if ((++_sp & 255u) == 0u) { if (xb_ld(&(bar)[XB_TMO])) break; if (_sp > XB_SPIN_CAP) { atomicAdd(&(bar)[XB_TMO], 1u); break; } } } } while (0)

struct XcdBarrier {
    unsigned* bar; unsigned x;
    volatile LAS unsigned* st;
};

__device__ __forceinline__ XcdBarrier xcd_barrier_post(unsigned* bar, volatile LAS unsigned* st) {
    XcdBarrier b; b.bar = bar; b.x = xb_xcc_id(); b.st = st;
    if (threadIdx.x == 0) (void)xb_add(&bar[XB_XCNT(b.x)], 1u);
    return b;
}
__device__ __forceinline__ void xcd_barrier_complete(unsigned* bar, unsigned x, unsigned& nloc, unsigned& nx) {
    const unsigned G = gridDim.x * gridDim.y * gridDim.z;
    unsigned sum, cnt, mine, sp = 0u;
    for (;;) {
        sum = 0u; cnt = 0u; mine = 0u;
#pragma unroll
        for (unsigned j = 0; j < 16; ++j) { const unsigned c = xb_ld(&bar[XB_XCNT(j)]); sum += c; cnt += (c > 0u) ? 1u : 0u; mine = (j == x) ? c : mine; }
        if (sum == G) break;
        __builtin_amdgcn_s_sleep(1);
        if ((++sp & 255u) == 0u) { if (xb_ld(&bar[XB_TMO])) break; if (sp > XB_SPIN_CAP) { atomicAdd(&bar[XB_TMO], 1u); break; } }
    }
    nloc = mine > 0u ? mine : 1u; nx = cnt > 0u ? cnt : 1u;
}

__device__ __forceinline__ void xcd_barrier(const XcdBarrier& b) {
    asm volatile("s_waitcnt vmcnt(0)" ::: "memory");
    __syncthreads();
    if (threadIdx.x == 0) {
        unsigned* bar = b.bar;
        __builtin_amdgcn_s_waitcnt(0);
        unsigned nloc = b.st[0], nx = b.st[1];
        if (nloc == 0u) { xcd_barrier_complete(bar, b.x, nloc, nx); b.st[0] = nloc; b.st[1] = nx; }
        const unsigned old = xb_add(&bar[XB_XSUB(b.x)], 1u);
        const unsigned gen = old / nloc;
        if (old + 1u == (gen + 1u) * nloc) {
            __builtin_amdgcn_fence(__ATOMIC_RELEASE, "agent");
            asm volatile("s_waitcnt vmcnt(0)" ::: "memory");
            const unsigned og = xb_add(&bar[XB_TOP], 1u);
            const unsigned tg = og / nx;
            if (og + 1u == (tg + 1u) * nx) xb_add(&bar[XB_TOPGEN], 1u);
            else XB_SPIN(xb_ld(&bar[XB_TOPGEN]) == tg, bar);
            __builtin_amdgcn_fence(__ATOMIC_ACQUIRE, "agent");
            xb_add(&bar[XB_XGEN(b.x)], 1u);
            asm volatile("s_waitcnt vmcnt(0)" ::: "memory");
        } else {
            XB_SPIN(xb_ld(&bar[XB_XGEN(b.x)]) == gen, bar);
            __builtin_amdgcn_fence(__ATOMIC_ACQUIRE, "agent");
            asm volatile("s_waitcnt vmcnt(0)" ::: "memory");
        }
    }
    __syncthreads();
}


struct Frame {
    LAS unsigned char* lds;
    int tid, lane, wave, G, bid;
    const float *x_prompt, *x_sample, *state_pool, *state_conv, *state_ssm, *norm_g, *w_in, *conv_w, *conv_b, *dt_bias, *a_log, *d_skip, *ssm_norm_g, *pool_w, *pool_scale, *w_out, *final_g;
    float* out;
    bf16 *XN, *WinT, *WoutT, *PROJ, *MIX, *SIN; float *DTRAW, *YBUF, *ST, *CHDEC;
};

__device__ __forceinline__ void p0_transpose_item(const float* W, int K, int N, bf16* WT, LAS float* scr, int item, int lane) {
    const int nblk = (N + 31) / 32, kb = item / nblk, nb = item % nblk, k0 = 64 * kb, n0 = 32 * nb;
    const bool ok = (n0 + (lane & 31)) < N;
#pragma unroll 8
    for (int i = 0; i < 32; ++i) { const int kk = 2 * i + (lane >> 5); scr[kk * 33 + (lane & 31)] = ok ? W[(size_t)(k0 + kk) * N + n0 + (lane & 31)] : 0.f; }
    LDS_WAIT(); asm volatile("" ::: "memory");
    const int c = lane & 7;
#pragma unroll
    for (int j = 0; j < 4; ++j) { const int n = (lane >> 3) + 8 * j; const LAS float* s = scr + (8 * c) * 33 + n;
        v4u o; o.x = pk2(s[0 * 33], s[1 * 33]); o.y = pk2(s[2 * 33], s[3 * 33]); o.z = pk2(s[4 * 33], s[5 * 33]); o.w = pk2(s[6 * 33], s[7 * 33]);
        *(GAS v4u*)(WT + (size_t)(n0 + n) * K + k0 + 8 * c) = o; }
    LDS_WAIT(); asm volatile("" ::: "memory");
}
__device__ __forceinline__ void p0_prologue(Frame& F) {
    LAS float* scr = (LAS float*)(F.lds + F.wave * 16384);
    const int gw = F.bid * NWAVES + F.wave, NGW = F.G * NWAVES;
    constexpr int I_IN = (DMODEL / 64) * ((NPROJ + 31) / 32), I_OUT = (DMIX / 64) * (DMODEL / 32);
    for (int it = gw; it < I_IN + I_OUT; it += NGW) {
        if (it < I_IN) p0_transpose_item(F.w_in, DMODEL, NPROJ, F.WinT, scr, it, F.lane);
        else p0_transpose_item(F.w_out, DMIX, DMODEL, F.WoutT, scr, it - I_IN, F.lane);
    }
    { const size_t z0 = (size_t)10304 * DMODEL * 2, z1 = (size_t)NPROJ_PAD * DMODEL * 2; GAS v4u* zp = (GAS v4u*)((unsigned char*)F.WinT + z0);
      const size_t nz = (z1 - z0) / 16; for (size_t i = (size_t)F.bid * NTHR + F.tid; i < nz; i += (size_t)F.G * NTHR) zp[i] = (v4u){0u, 0u, 0u, 0u}; }
    for (int m = gw; m < MROWS; m += NGW) {
        const float* xrow = (m < NPR) ? F.x_prompt + (size_t)m * DMODEL : F.x_sample + (size_t)(m - NPR) * DMODEL;
        const GAS f32x4* xr = (const GAS f32x4*)xrow + F.lane; const GAS f32x4* gr = (const GAS f32x4*)F.norm_g + F.lane;
        f32x4 v[8]; float s = 0.f;
#pragma unroll
        for (int j = 0; j < 8; ++j) { v[j] = xr[64 * j]; s += (v[j].x * v[j].x + v[j].y * v[j].y) + (v[j].z * v[j].z + v[j].w * v[j].w); }
        const float r = 1.f / sqrtf(wave_sum(s) * (1.f / DMODEL) + EPS);
        GAS unsigned long long* o8 = (GAS unsigned long long*)(F.XN + (size_t)m * DMODEL) + F.lane;
#pragma unroll
        for (int j = 0; j < 8; ++j) { const f32x4 g = gr[64 * j]; o8[64 * j] = (unsigned long long)pk2(v[j].x * r * g.x, v[j].y * r * g.y) | ((unsigned long long)pk2(v[j].z * r * g.z, v[j].w * r * g.w) << 32); }
    }
}

__device__ __forceinline__ void pool_unit(Frame& F, int tile, int gi) {
    LAS float* pooled = (LAS float*)F.lds;
    const int w = 2 << gi, m0 = tile * 32, c = F.tid & 255, th = F.tid >> 8, ch = gi * 256 + c;
    for (int i = 0; i < 16; ++i) {
        const int t = th * 16 + i, m = m0 + t; const bool prompt = m < NPR;
        int b, tq, cnt; if (prompt) { b = m >> 11; tq = m & 2047; cnt = min(w, tq + 1); } else { const int ms = m - NPR; b = ms >> 2; tq = ms & 3; cnt = w; }
        float sum = 0.f;
        for (int j = 0; j < w; ++j) { const int tt = tq - j; float v;
            if (tt >= 0) v = bf2f(F.PROJ[(size_t)(m - j) * PLD + ch]); else v = prompt ? 0.f : F.state_pool[(size_t)(b * 15 + 15 + tt) * DPOOL + ch];
            sum += v; }
        const float u0 = bf2f(F.PROJ[(size_t)m * PLD + ch]);
        pooled[t * 256 + c] = sum / (float)cnt - u0;
    }
    __syncthreads();
    float acc[16];
#pragma unroll
    for (int i = 0; i < 16; ++i) acc[i] = 0.f;
    const float* W = F.pool_w + (size_t)gi * 65536 + c;
    for (int c4 = 0; c4 < 64; ++c4) {
        const float w0 = W[(size_t)(4 * c4 + 0) * 256], w1 = W[(size_t)(4 * c4 + 1) * 256], w2 = W[(size_t)(4 * c4 + 2) * 256], w3 = W[(size_t)(4 * c4 + 3) * 256];
#pragma unroll
        for (int i = 0; i < 16; ++i) { const f32x4 p4 = *(const LAS f32x4*)(pooled + (th * 16 + i) * 256 + 4 * c4); acc[i] += (p4.x * w0 + p4.y * w1) + (p4.z * w2 + p4.w * w3); }
    }
    const float sc = F.pool_scale[ch];
#pragma unroll
    for (int i = 0; i < 16; ++i) { const int m = m0 + th * 16 + i; const float gate = bf2f(F.PROJ[(size_t)m * PLD + C_GATE + ch]);
        F.MIX[(size_t)m * DMIX + ch] = (bf16)f2bf(acc[i] * sc * silu_f(gate)); }
    __syncthreads();
}

__device__ __forceinline__ void ssd_unit(Frame& F, int seq, int h) {
    const bool prompt = seq < 4; const int L = prompt ? 2048 : 4, sb = seq - 4, row0 = prompt ? seq * 2048 : NPR + sb * 4, g = h / 6;
    const int p = F.tid >> 3, nq = F.tid & 7;
    LAS float* T = (LAS float*)F.lds;
    LAS float* dts = T + 32 * 320; LAS float* dec = dts + 32;
    float S[16];
    if (prompt) {
#pragma unroll
        for (int j = 0; j < 16; ++j) S[j] = 0.f;
    } else { const f32x4* sp = (const f32x4*)(F.state_ssm + ((size_t)(sb * NHEAD + h) * HDIM + p) * DSTATE + nq * 16);
#pragma unroll
        for (int q = 0; q < 4; ++q) { const f32x4 v = sp[q]; S[4 * q] = v.x; S[4 * q + 1] = v.y; S[4 * q + 2] = v.z; S[4 * q + 3] = v.w; } }
    const float a = -__expf(F.a_log[h]), dtb = F.dt_bias[h], dsk = F.d_skip[h];
    for (int t0 = 0; t0 < L; t0 += 32) {
        const int nt = min(32, L - t0);
        __syncthreads();
        for (int e = F.tid; e < nt * 320; e += NTHR) {
            const int t = e / 320, c = e - t * 320;
            const int xch = c < 64 ? h * 64 + c : (c < 192 ? 3072 + g * 128 + (c - 64) : 4096 + g * 128 + (c - 192));
            float acc = F.conv_b[xch];
#pragma unroll
            for (int k = 0; k < 4; ++k) { const int tt = t0 + t + k - 3; float v;
                if (tt >= 0) v = bf2f(F.PROJ[(size_t)(row0 + tt) * PLD + C_XBC + xch]); else v = prompt ? 0.f : F.state_conv[(size_t)(sb * 3 + 3 + tt) * DCONV + xch];
                acc += v * F.conv_w[k * DCONV + xch]; }
            T[e] = silu_f(acc);
        }
        for (int t = F.tid; t < nt; t += NTHR) { const float dt = softplus_f(F.DTRAW[(size_t)(row0 + t0 + t) * 64 + h] + dtb); dts[t] = dt; dec[t] = __expf(dt * a); }
        __syncthreads();
        for (int t = 0; t < nt; ++t) {
            const LAS float* r = T + t * 320;
            const float x = r[p], d = dec[t], dtx = dts[t] * x; float acc = 0.f;
#pragma unroll
            for (int q = 0; q < 4; ++q) { const f32x4 bv = *(const LAS f32x4*)(r + 64 + nq * 16 + 4 * q), cv = *(const LAS f32x4*)(r + 192 + nq * 16 + 4 * q);
                S[4 * q] = d * S[4 * q] + dtx * bv.x; S[4 * q + 1] = d * S[4 * q + 1] + dtx * bv.y; S[4 * q + 2] = d * S[4 * q + 2] + dtx * bv.z; S[4 * q + 3] = d * S[4 * q + 3] + dtx * bv.w;
                acc += (cv.x * S[4 * q] + cv.y * S[4 * q + 1]) + (cv.z * S[4 * q + 2] + cv.w * S[4 * q + 3]); }
            acc += __shfl_xor(acc, 1); acc += __shfl_xor(acc, 2); acc += __shfl_xor(acc, 4);
            if (nq == 0) F.YBUF[(size_t)(row0 + t0 + t) * DSSM + h * 64 + p] = acc + dsk * x;
        }
    }
    float* so = F.out + (prompt ? O_SSM_P + ((size_t)(seq * NHEAD + h) * HDIM + p) * DSTATE : O_SSM_S + ((size_t)(sb * NHEAD + h) * HDIM + p) * DSTATE) + nq * 16;
#pragma unroll
    for (int q = 0; q < 4; ++q) *(f32x4*)(so + 4 * q) = (f32x4){S[4 * q], S[4 * q + 1], S[4 * q + 2], S[4 * q + 3]};
    __syncthreads();
}


typedef short s16x8 __attribute__((ext_vector_type(8)));
typedef float f32x16 __attribute__((ext_vector_type(16)));
typedef unsigned u32x2 __attribute__((ext_vector_type(2)));
typedef float f32x2 __attribute__((ext_vector_type(2)));
constexpr int PT = 272;
__device__ __forceinline__ unsigned cvtpk(float lo, float hi) { return pg8::cvt_pk_bf16(lo, hi); }
__device__ __forceinline__ float bflo(unsigned w) { return __builtin_bit_cast(float, w << 16); }
__device__ __forceinline__ float bfhi(unsigned w) { return __builtin_bit_cast(float, w & 0xffff0000u); }
__device__ __forceinline__ f32x16 mfma32(s16x8 a, s16x8 b, f32x16 c) { return __builtin_amdgcn_mfma_f32_32x32x16_bf16(a, b, c, 0, 0, 0); }
__device__ __forceinline__ s16x8 ldfrag(const LAS unsigned char* img, int row, int ks, int hh) { return *(const LAS s16x8*)(img + row * PT + ks * 32 + hh * 16); }
__device__ __forceinline__ void conv8x2(const Frame& F, int seq_row0, int t0, int xch, float (&o0)[8], float (&o1)[8]) {
    unsigned raw[11];
    const bf16* base = F.PROJ + (size_t)seq_row0 * PLD + C_XBC + xch;
#pragma unroll
    for (int i = 0; i < 11; ++i) { const int t = t0 - 3 + i; raw[i] = (t >= 0) ? *(const unsigned*)(base + (size_t)t * PLD) : 0u; }
    f32x2 w[4];
#pragma unroll
    for (int k = 0; k < 4; ++k) w[k] = *(const f32x2*)(F.conv_w + k * DCONV + xch);
    const f32x2 bb = *(const f32x2*)(F.conv_b + xch);
#pragma unroll
    for (int o = 0; o < 8; ++o) { float a0 = bb.x, a1 = bb.y;
#pragma unroll
        for (int k = 0; k < 4; ++k) { a0 += bflo(raw[o + k]) * w[k].x; a1 += bfhi(raw[o + k]) * w[k].y; }
        o0[o] = silu_f(a0); o1[o] = silu_f(a1); }
}
__device__ __forceinline__ v4u pack8(const float (&o)[8]) { v4u r; r.x = cvtpk(o[0], o[1]); r.y = cvtpk(o[2], o[3]); r.z = cvtpk(o[4], o[5]); r.w = cvtpk(o[6], o[7]); return r; }
__device__ __forceinline__ void chunk_dt(const Frame& F, int row0, int g, LAS float* dtl, LAS float* Ac) {
    if (F.wave < 6) {
        const int h = 6 * g + F.wave; const float a = -__expf(F.a_log[h]), bias = F.dt_bias[h]; const int l0 = 2 * F.lane;
        const float d0 = softplus_f(F.DTRAW[(size_t)(row0 + l0) * 64 + h] + bias), d1 = softplus_f(F.DTRAW[(size_t)(row0 + l0 + 1) * 64 + h] + bias);
        const float e0 = d0 * a, e1 = d1 * a; float s = e0 + e1;
#pragma unroll
        for (int o = 1; o < 64; o <<= 1) { const float u = __shfl_up(s, o); if (F.lane >= o) s += u; }
        dtl[F.wave * 128 + l0] = d0; dtl[F.wave * 128 + l0 + 1] = d1; Ac[F.wave * 128 + l0] = s - e1; Ac[F.wave * 128 + l0 + 1] = s;
    }
}
__device__ __forceinline__ void p2a_unit(Frame& F, int b, int c, int g) {
    LAS unsigned char* XwT = F.lds;
    LAS unsigned char* BT = F.lds + 52224;
    LAS float* dtl = (LAS float*)(F.lds + 87040); LAS float* Ac = (LAS float*)(F.lds + 90112);
    const int seq_row0 = b * 2048, tok0 = c * 128, row0 = seq_row0 + tok0, hh = F.lane >> 5, l31 = F.lane & 31;
    __syncthreads();
    chunk_dt(F, row0, g, dtl, Ac);
    for (int it = F.tid; it < 1024; it += NTHR) { const int cp = it & 63, to = it >> 6; float o0[8], o1[8];
        conv8x2(F, seq_row0, tok0 + 8 * to, 3072 + g * 128 + 2 * cp, o0, o1);
        *(LAS v4u*)(BT + (2 * cp) * PT + to * 16) = pack8(o0); *(LAS v4u*)(BT + (2 * cp + 1) * PT + to * 16) = pack8(o1); }
    __syncthreads();
    if (F.tid < 6) F.CHDEC[(size_t)(b * 16 + c) * NHEAD + 6 * g + F.tid] = __expf(Ac[F.tid * 128 + 127]);
    for (int half = 0; half < 2; ++half) {
        if (half) __syncthreads();
        for (int it = F.tid; it < 1536; it += NTHR) { const int cp = it % 96, to = it / 96, ch = 2 * cp, rl = ch >> 6, p = ch & 63, r = 3 * half + rl; float o0[8], o1[8];
            conv8x2(F, seq_row0, tok0 + 8 * to, (6 * g + r) * 64 + p, o0, o1);
            const float aend = Ac[r * 128 + 127];
#pragma unroll
            for (int o = 0; o < 8; ++o) { const float wl = __expf(aend - Ac[r * 128 + 8 * to + o]) * dtl[r * 128 + 8 * to + o]; o0[o] *= wl; o1[o] *= wl; }
            *(LAS v4u*)(XwT + (rl * 64 + p) * PT + to * 16) = pack8(o0); *(LAS v4u*)(XwT + (rl * 64 + p + 1) * PT + to * 16) = pack8(o1); }
        __syncthreads();
        const int pi = F.wave >> 2, ni = F.wave & 3;
        for (int rl = 0; rl < 3; ++rl) {
            f32x16 acc;
#pragma unroll
            for (int i = 0; i < 16; ++i) acc[i] = 0.f;
#pragma unroll
            for (int ks = 0; ks < 8; ++ks) acc = mfma32(ldfrag(XwT, rl * 64 + 32 * pi + l31, ks, hh), ldfrag(BT, 32 * ni + l31, ks, hh), acc);
            const int h = 6 * g + 3 * half + rl;
            float* so = F.ST + ((size_t)((b * 16 + c) * NHEAD + h) * HDIM) * DSTATE + 32 * ni + l31;
#pragma unroll
            for (int i = 0; i < 16; ++i) { const int p = 32 * pi + (i & 3) + 8 * (i >> 2) + 4 * hh; so[(size_t)p * DSTATE] = acc[i]; }
        }
    }
}
__device__ __forceinline__ void p2b_scan(Frame& F) {
    const int gt = F.bid * NTHR + F.tid, GT = F.G * NTHR;
    for (int i = gt; i < 4 * NHEAD * 2048; i += GT) {
        const int b = i / (NHEAD * 2048), rem = i - b * (NHEAD * 2048), h = rem >> 11, e = rem & 2047;
        f32x4 st[16];
#pragma unroll
        for (int c = 0; c < 16; ++c) st[c] = *((const f32x4*)F.ST + ((size_t)((b * 16 + c) * NHEAD + h) * 2048 + e));
        f32x4 s = (f32x4){0.f, 0.f, 0.f, 0.f};
#pragma unroll
        for (int c = 0; c < 16; ++c) {
            u32x2 pk; pk.x = cvtpk(s.x, s.y); pk.y = cvtpk(s.z, s.w);
            *((u32x2*)F.SIN + ((size_t)((b * 16 + c) * NHEAD + h) * 2048 + e)) = pk;
            const float d = F.CHDEC[(size_t)(b * 16 + c) * NHEAD + h];
            s = s * d + st[c];
        }
        *((f32x4*)(F.out + O_SSM_P) + ((size_t)(b * NHEAD + h) * 2048 + e)) = s;
    }
}
__device__ __forceinline__ void p2c_unit(Frame& F, int b, int c, int g) {
    LAS unsigned char* Cn = F.lds;
    LAS unsigned char* Bn = F.lds + 34816;
    LAS unsigned char* XT = F.lds + 69632;
    LAS unsigned char* Sin = F.lds + 87040;
    LAS float* dtl = (LAS float*)(F.lds + 104448); LAS float* Ac = (LAS float*)(F.lds + 107520);
    LAS float* part = (LAS float*)(F.lds + 69632);
    LAS float* rs = (LAS float*)(F.lds + 110592);
    const int seq_row0 = b * 2048, tok0 = c * 128, row0 = seq_row0 + tok0, hh = F.lane >> 5, l31 = F.lane & 31;
    const int li = F.wave >> 1, sh = F.wave & 1, pj = F.wave & 1;
    __syncthreads();
    chunk_dt(F, row0, g, dtl, Ac);
    for (int it = F.tid; it < 2048; it += NTHR) { const int isC = it >> 10, cp = it & 63, to = (it >> 6) & 15; float o0[8], o1[8];
        conv8x2(F, seq_row0, tok0 + 8 * to, 3072 + isC * 1024 + g * 128 + 2 * cp, o0, o1);
        LAS unsigned char* img = (isC ? Cn : Bn) + (8 * to) * PT + cp * 4;
#pragma unroll
        for (int o = 0; o < 8; ++o) *(LAS unsigned*)(img + o * PT) = cvtpk(o0[o], o1[o]); }
    __syncthreads();
    f32x16 gt0, gt1;
#pragma unroll
    for (int i = 0; i < 16; ++i) { gt0[i] = 0.f; gt1[i] = 0.f; }
    if (2 * sh <= li) {
#pragma unroll
        for (int ks = 0; ks < 8; ++ks) gt0 = mfma32(ldfrag(Bn, 64 * sh + l31, ks, hh), ldfrag(Cn, 32 * li + l31, ks, hh), gt0);
    }
    if (2 * sh + 1 <= li) {
#pragma unroll
        for (int ks = 0; ks < 8; ++ks) gt1 = mfma32(ldfrag(Bn, 64 * sh + 32 + l31, ks, hh), ldfrag(Cn, 32 * li + l31, ks, hh), gt1);
    }
    float ss[16];
#pragma unroll
    for (int i = 0; i < 16; ++i) ss[i] = 0.f;
    for (int r = 0; r < 6; ++r) {
        const int h = 6 * g + r;
        __syncthreads();
        { const int cp = F.tid & 31, to = F.tid >> 5; float o0[8], o1[8];
          conv8x2(F, seq_row0, tok0 + 8 * to, h * 64 + 2 * cp, o0, o1);
          *(LAS v4u*)(XT + (2 * cp) * PT + to * 16) = pack8(o0); *(LAS v4u*)(XT + (2 * cp + 1) * PT + to * 16) = pack8(o1); }
        { const bf16* sg = F.SIN + ((size_t)((b * 16 + c) * NHEAD + h) * HDIM) * DSTATE;
#pragma unroll
          for (int j = 0; j < 2; ++j) { const int idx = F.tid + NTHR * j, p = idx >> 4, seg = idx & 15; *(LAS v4u*)(Sin + p * PT + seg * 16) = *(const v4u*)(sg + p * DSTATE + seg * 8); } }
        { const int l = 32 * li + l31; const float Al = Ac[r * 128 + l];
#pragma unroll
          for (int tsel = 0; tsel < 2; ++tsel) { const int si = 2 * sh + tsel;
            if (si <= li) {
#pragma unroll
                for (int q = 0; q < 4; ++q) { const int s0 = 32 * si + 8 * q + 4 * hh;
                    const f32x4 As4 = *(const LAS f32x4*)(Ac + r * 128 + s0), dt4 = *(const LAS f32x4*)(dtl + r * 128 + s0); float v[4];
#pragma unroll
                    for (int j = 0; j < 4; ++j) { const float gv = tsel ? gt1[4 * q + j] : gt0[4 * q + j]; const float e = __expf(fminf(Al - As4[j], 0.f)); v[j] = (s0 + j <= l) ? gv * e * dt4[j] : 0.f; }
                    u32x2 pk; pk.x = cvtpk(v[0], v[1]); pk.y = cvtpk(v[2], v[3]);
                    *(LAS u32x2*)(Bn + l * PT + s0 * 2) = pk; } } } }
        __syncthreads();
        f32x16 acc;
#pragma unroll
        for (int i = 0; i < 16; ++i) acc[i] = 0.f;
#pragma unroll
        for (int ks = 0; ks < 8; ++ks) acc = mfma32(ldfrag(Cn, 32 * li + l31, ks, hh), ldfrag(Sin, 32 * pj + l31, ks, hh), acc);
#pragma unroll
        for (int q = 0; q < 4; ++q) { const f32x4 A4 = *(const LAS f32x4*)(Ac + r * 128 + 32 * li + 8 * q + 4 * hh);
#pragma unroll
            for (int j = 0; j < 4; ++j) acc[4 * q + j] *= __expf(A4[j]); }
        for (int ks = 0; ks < 2 * (li + 1); ++ks) acc = mfma32(ldfrag(Bn, 32 * li + l31, ks, hh), ldfrag(XT, 32 * pj + l31, ks, hh), acc);
        const float dsk = F.d_skip[h]; const int pcol = h * 64 + 32 * pj + l31;
#pragma unroll
        for (int q = 0; q < 4; ++q) { const int l0 = 32 * li + 8 * q + 4 * hh; const u32x2 x4 = *(const LAS u32x2*)(XT + (32 * pj + l31) * PT + l0 * 2);
            const float xv[4] = {bflo(x4.x), bfhi(x4.x), bflo(x4.y), bfhi(x4.y)};
#pragma unroll
            for (int j = 0; j < 4; ++j) { const size_t row = (size_t)(row0 + l0 + j); const float z = bf2f(F.PROJ[row * PLD + C_Z + pcol]);
                const float yz = (acc[4 * q + j] + dsk * xv[j]) * silu_f(z); ss[4 * q + j] += yz * yz; F.MIX[row * DMIX + DPOOL + pcol] = (bf16)f2bf(yz); } }
    }
    VM_WAIT(); __syncthreads();
#pragma unroll
    for (int i = 0; i < 16; ++i) { const int l = 32 * li + (i & 3) + 8 * (i >> 2) + 4 * hh; part[l * 64 + 32 * pj + l31] = ss[i]; }
    __syncthreads();
    if (F.tid < 128) { float s = 0.f;
#pragma unroll
        for (int j = 0; j < 16; ++j) { const f32x4 v = *(const LAS f32x4*)(part + F.tid * 64 + 4 * j); s += (v.x + v.y) + (v.z + v.w); }
        rs[F.tid] = 1.f / sqrtf(s * (1.f / 384.f) + EPS); }
    __syncthreads();
    for (int it = F.tid; it < 128 * 48; it += NTHR) { const int l = it / 48, k8 = it - l * 48; const float rv = rs[l];
        bf16* mp = F.MIX + (size_t)(row0 + l) * DMIX + DPOOL + g * 384 + 8 * k8; const v4u raw = *(const v4u*)mp;
        const f32x4 g0 = *(const f32x4*)(F.ssm_norm_g + g * 384 + 8 * k8), g1 = *(const f32x4*)(F.ssm_norm_g + g * 384 + 8 * k8 + 4);
        v4u o; o.x = cvtpk(bflo(raw.x) * rv * g0.x, bfhi(raw.x) * rv * g0.y); o.y = cvtpk(bflo(raw.y) * rv * g0.z, bfhi(raw.y) * rv * g0.w);
        o.z = cvtpk(bflo(raw.z) * rv * g1.x, bfhi(raw.z) * rv * g1.y); o.w = cvtpk(bflo(raw.w) * rv * g1.z, bfhi(raw.w) * rv * g1.w);
        *(v4u*)mp = o; }
}

__device__ __forceinline__ void p2_copies(Frame& F) {
    const size_t gt = (size_t)F.bid * NTHR + F.tid, GT = (size_t)F.G * NTHR;
    for (size_t i = gt; i < (size_t)4 * 15 * DPOOL; i += GT) { const int ch = i % DPOOL, r = (i / DPOOL) % 15, b = i / (DPOOL * 15);
        F.out[O_POOL_P + i] = bf2f(F.PROJ[(size_t)(b * 2048 + 2033 + r) * PLD + ch]); }
    for (size_t i = gt; i < (size_t)4 * 3 * DCONV; i += GT) { const int ch = i % DCONV, r = (i / DCONV) % 3, b = i / (DCONV * 3);
        F.out[O_CONV_P + i] = bf2f(F.PROJ[(size_t)(b * 2048 + 2045 + r) * PLD + C_XBC + ch]); }
    for (size_t i = gt; i < (size_t)128 * 15 * DPOOL; i += GT) { const int ch = i % DPOOL, r = (i / DPOOL) % 15, b = i / (DPOOL * 15);
        F.out[O_POOL_S + i] = r < 11 ? F.state_pool[(size_t)(b * 15 + r + 4) * DPOOL + ch] : bf2f(F.PROJ[(size_t)(NPR + b * 4 + r - 11) * PLD + ch]); }
    for (size_t i = gt; i < (size_t)128 * 3 * DCONV; i += GT) { const int ch = i % DCONV, r = (i / DCONV) % 3, b = i / (DCONV * 3);
        F.out[O_CONV_S + i] = bf2f(F.PROJ[(size_t)(NPR + b * 4 + 1 + r) * PLD + C_XBC + ch]); }
}

__device__ __forceinline__ void p3_gate_norm(Frame& F) {
    const int gw = F.bid * NWAVES + F.wave, NGW = F.G * NWAVES;
    for (int task = gw; task < NSM * NGRP; task += NGW) {
        const int m = NPR + (task >> 3), g = task & 7; float v[6]; float ss = 0.f;
#pragma unroll
        for (int k = 0; k < 6; ++k) { const int idx = g * 384 + F.lane + 64 * k; const float y = F.YBUF[(size_t)m * DSSM + idx], z = bf2f(F.PROJ[(size_t)m * PLD + C_Z + idx]);
            v[k] = y * silu_f(z); ss += v[k] * v[k]; }
        const float r = 1.f / sqrtf(wave_sum(ss) * (1.f / 384.f) + EPS);
#pragma unroll
        for (int k = 0; k < 6; ++k) { const int idx = g * 384 + F.lane + 64 * k; F.MIX[(size_t)m * DMIX + DPOOL + idx] = (bf16)f2bf(v[k] * r * F.ssm_norm_g[idx]); }
    }
}
__device__ __forceinline__ void p5_final_norm(Frame& F) {
    const int gw = F.bid * NWAVES + F.wave, NGW = F.G * NWAVES;
    for (int m = gw; m < MROWS; m += NGW) {
        GAS f32x4* yr = (GAS f32x4*)(F.out + O_Y + (size_t)m * DMODEL) + F.lane; const GAS f32x4* gr = (const GAS f32x4*)F.final_g + F.lane;
        f32x4 v[8]; float s = 0.f;
#pragma unroll
        for (int j = 0; j < 8; ++j) { v[j] = yr[64 * j]; s += (v[j].x * v[j].x + v[j].y * v[j].y) + (v[j].z * v[j].z + v[j].w * v[j].w); }
        const float r = 1.f / sqrtf(wave_sum(s) * (1.f / DMODEL) + EPS);
#pragma unroll
        for (int j = 0; j < 8; ++j) { const f32x4 g = gr[64 * j]; yr[64 * j] = (f32x4){v[j].x * r * g.x, v[j].y * r * g.y, v[j].z * r * g.z, v[j].w * r * g.w}; }
    }
}

struct Args { const float* in[17]; float* out; unsigned char* ws; int ph_lo, ph_hi; };
constexpr int N_PHASES = 7;
__global__ void __launch_bounds__(NTHR, 2) fwd(Args args) {
    extern __shared__ __attribute__((aligned(16))) unsigned char lds_raw[];
    Frame F;
    F.lds = (LAS unsigned char*)lds_raw;
    F.tid = threadIdx.x; F.lane = F.tid & 63; F.wave = __builtin_amdgcn_readfirstlane(F.tid >> 6); F.G = gridDim.x; F.bid = blockIdx.x;
    unsigned char* ws = args.ws;
    F.x_prompt = args.in[0]; F.x_sample = args.in[1]; F.state_pool = args.in[2]; F.state_conv = args.in[3]; F.state_ssm = args.in[4]; F.norm_g = args.in[5]; F.w_in = args.in[6];
    F.conv_w = args.in[7]; F.conv_b = args.in[8]; F.dt_bias = args.in[9]; F.a_log = args.in[10]; F.d_skip = args.in[11]; F.ssm_norm_g = args.in[12]; F.pool_w = args.in[13];
    F.pool_scale = args.in[14]; F.w_out = args.in[15]; F.final_g = args.in[16]; F.out = args.out;
    F.XN = (bf16*)(ws + WS_XN); F.WinT = (bf16*)(ws + WS_WINT); F.WoutT = (bf16*)(ws + WS_WOUTT); F.PROJ = (bf16*)(ws + WS_PROJ); F.MIX = (bf16*)(ws + WS_MIX);
    F.DTRAW = (float*)(ws + WS_DTRAW); F.YBUF = (float*)(ws + WS_YBUF); F.ST = (float*)(ws + WS_ST); F.SIN = (bf16*)(ws + WS_SIN); F.CHDEC = (float*)(ws + WS_CHDEC);
    for (int u = F.tid; u < (LDS_BYTES - LDSCTL_OFF) / 4; u += NTHR) ((LAS unsigned*)(F.lds + LDSCTL_OFF))[u] = 0u;
    __syncthreads();
    const int lo = args.ph_lo, hi = args.ph_hi;
    XcdBarrier bar; bar.bar = (unsigned*)(ws + WS_CTL) + CW_BAR; bar.x = 0; bar.st = nullptr;
    if (hi - lo > 1) bar = xcd_barrier_post((unsigned*)(ws + WS_CTL) + CW_BAR, (volatile LAS unsigned*)(F.lds + MISC_OFF) + 8);
#define IN(k) (lo <= (k) && (k) < hi)
#define BOTH(k) (IN(k) && IN((k) + 1))
    if (IN(0)) { p0_prologue(F); if (BOTH(0)) xcd_barrier(bar); }
    if (IN(1)) {
        pg8::Gemm g{F.XN, F.WinT, MROWS, NPROJ_PAD, DMODEL}; pg8::StaticOrder S; S.init(MROWS, NPROJ_PAD, F.G, F.bid);
        pg8::EpiProj E{F.PROJ, F.DTRAW};
        pg8::gemm_phase<pg8::EpiProj, pg8::StaticOrder, true, true>(F.lds, g, S, E);
        if (BOTH(1)) xcd_barrier(bar);
    }
    if (IN(2)) {
        for (int u = F.bid; u < 512; u += F.G) p2a_unit(F, u >> 7, (u >> 3) & 15, u & 7);
        constexpr int NPOOL = (MROWS / 32) * 4, NSS = 128 * 48;
        for (int i = F.bid; i < NPOOL + NSS; i += F.G) {
            if (i < NPOOL) pool_unit(F, i >> 2, i & 3); else { const int j = i - NPOOL; ssd_unit(F, 4 + j / 48, j % 48); }
        }
        p2_copies(F);
        if (BOTH(2)) xcd_barrier(bar);
    }
    if (IN(3)) { p2b_scan(F); if (BOTH(3)) xcd_barrier(bar); }
    if (IN(4)) {
        for (int u = F.bid; u < 512; u += F.G) p2c_unit(F, u >> 7, (u >> 3) & 15, u & 7);
        p3_gate_norm(F);
        if (BOTH(4)) xcd_barrier(bar);
    }
    if (IN(5)) {
        pg8::Gemm g{F.MIX, F.WoutT, MROWS, DMODEL, DMIX}; pg8::StaticOrder S; S.init(MROWS, DMODEL, F.G, F.bid);
        pg8::EpiOut E{F.x_prompt, F.x_sample, F.out};
        pg8::gemm_phase<pg8::EpiOut, pg8::StaticOrder, true, true>(F.lds, g, S, E);
        if (BOTH(5)) xcd_barrier(bar);
    }
    if (IN(6)) { p5_final_norm(F); }
#undef IN
#undef BOTH
}

#ifndef N_LAUNCHES
#define N_LAUNCHES 1
#endif
extern "C" void kernel_launch(void* const* d_in, const int* in_sizes, int n_in, void* d_out, int out_size, void* d_ws, size_t ws_size, hipStream_t stream) {
    static int grid = 0;
    if (grid == 0) {
        if (n_in != 17 || out_size != 73785344 || ws_size < WS_END) { fprintf(stderr, "kernel_launch: unexpected shapes: n_in %d out %d ws %zu\n", n_in, out_size, ws_size); grid = -1; return; }
        int dev = 0, cus = 0, per_cu = 0;
        if (hipGetDevice(&dev) != hipSuccess || hipDeviceGetAttribute(&cus, hipDeviceAttributeMultiprocessorCount, dev) != hipSuccess) { fprintf(stderr, "kernel_launch: device query failed\n"); grid = -1; return; }
        if (hipFuncSetAttribute((const void*)fwd, hipFuncAttributeMaxDynamicSharedMemorySize, LDS_BYTES) != hipSuccess) { fprintf(stderr, "kernel_launch: hipFuncSetAttribute failed\n"); grid = -1; return; }
        if (hipOccupancyMaxActiveBlocksPerMultiprocessor(&per_cu, (const void*)fwd, NTHR, LDS_BYTES) != hipSuccess || per_cu < 1) { fprintf(stderr, "kernel_launch: occupancy query says %d blocks per CU\n", per_cu); }
        (void)hipGetLastError();
        grid = cus;
    }
    if (grid < 0) return;
    (void)hipMemsetAsync((char*)d_ws + WS_CTL, 0, CTL_ZERO_BYTES, stream);
    Args a{};
    for (int i = 0; i < 17; ++i) a.in[i] = (const float*)d_in[i];
    a.out = (float*)d_out; a.ws = (unsigned char*)d_ws;
    if (N_LAUNCHES == 1) {
        a.ph_lo = 0; a.ph_hi = N_PHASES;
        void* kargs[] = {&a};
        hipError_t e = hipLaunchCooperativeKernel((const void*)fwd, dim3(grid), dim3(NTHR), kargs, LDS_BYTES, stream);
        if (e != hipSuccess) fprintf(stderr, "kernel_launch: cooperative launch failed: %s\n", hipGetErrorString(e));
    } else {
        for (int li = 0; li < N_PHASES; ++li) { a.ph_lo = li; a.ph_hi = li + 1; hipLaunchKernelGGL(fwd, dim3(grid), dim3(NTHR), LDS_BYTES, stream, a); }
    }
}
```

```cpp
#include <hip/hip_runtime.h>
#include <cstdio>
#include <cstdint>
namespace pg8 {
#define PG8_LAS __attribute__((address_space(3)))
typedef unsigned short bf16_t;
typedef short bf16x8 __attribute__((ext_vector_type(8)));
typedef float f32x4 __attribute__((ext_vector_type(4)));
typedef unsigned u32x4 __attribute__((ext_vector_type(4)));
constexpr int BM = 256, BK = 64, HALF = 128, HTB = HALF * BK * 2  , STAGE_BYTES = 8 * HTB, NXCD = 8, WGM = 8;

__host__ __device__ __forceinline__ int lds_byte(int r, int c) { const int st = (r >> 4) * 2 + (c >> 5), rr = r & 15, cc = c & 31, ob = rr * 64 + cc * 2; return st * 1024 + (ob ^ (((ob >> 9) & 1) << 5)); }
__host__ __device__ __forceinline__ void stage_rc(int b, int& R, int& C) { const int st = b / 1024, sb = b % 1024, swz = sb ^ (((sb >> 9) & 1) << 5); R = (st >> 1) * 16 + swz / 64; C = (st & 1) * 32 + (swz % 64) / 2; }
__host__ __device__ __forceinline__ int perm32(int rho) { const int n = rho >> 4, i = rho & 15; return 8 * (i >> 2) + 4 * n + (i & 3); }

struct Unit { int pm, pn; };
struct Gemm { const bf16_t* A; const bf16_t* Bt; int M, N, K; };

struct StaticOrder {
    int nM, nN, nwg, G, c;
    __host__ __device__ void init(int M, int N, int G_, int c_) { nM = M / BM; nN = N / BM; nwg = nM * nN; G = G_; c = c_; }
    __host__ __device__ bool next(int i, Unit& u) const {
        const long L = (long)i * G + c; if (L >= nwg) return false;
        int wgid = (int)L; { const int q = nwg / NXCD, r = nwg % NXCD, xcd = wgid % NXCD, off = wgid / NXCD; wgid = (xcd < r ? xcd * (q + 1) : r * (q + 1) + (xcd - r) * q) + off; }
        const int nig = WGM * nN, gid = wgid / nig, fm = gid * WGM, gsz = (nM - fm) < WGM ? (nM - fm) : WGM;
        u.pm = fm + ((wgid % nig) % gsz); u.pn = (wgid % nig) / gsz; return true;
    }
    __device__ __forceinline__ void a_ready(const Unit&) const {}
    __device__ __forceinline__ void done(const Unit&) const {}
};

__device__ __forceinline__ unsigned cvt_pk_bf16(float lo, float hi) { unsigned r; asm volatile("v_cvt_pk_bf16_f32 %0, %1, %2" : "=v"(r) : "v"(lo), "v"(hi)); return r; }

struct EpiProj {
    static constexpr bool PERM = true, AFTER_DRAIN = false;
    bf16_t* P; float* dtraw;
    __device__ __forceinline__ void operator()(const f32x4 (&acc)[2][2][4][2], const Unit& u, int wr, int wc, int fr, int fq) const {
        const int row0 = u.pm * BM + wr * 64 + fr;
        if (u.pn < 40) {
            const int col0 = u.pn * BM + wc * 32 + 8 * fq;
#pragma unroll
            for (int ai = 0; ai < 2; ++ai)
#pragma unroll
                for (int m = 0; m < 4; ++m) { bf16_t* rowp = P + (size_t)(row0 + ai * HALF + m * 16) * 10240 + col0;
#pragma unroll
                    for (int bj = 0; bj < 2; ++bj) { const f32x4 v0 = acc[ai][bj][m][0], v1 = acc[ai][bj][m][1];
                        u32x4 w; w.x = cvt_pk_bf16(v0[0], v0[1]); w.y = cvt_pk_bf16(v0[2], v0[3]); w.z = cvt_pk_bf16(v1[0], v1[1]); w.w = cvt_pk_bf16(v1[2], v1[3]);
                        *(u32x4*)(rowp + bj * HALF) = w; } }
        } else if (wc < 2) {
#pragma unroll
            for (int ai = 0; ai < 2; ++ai)
#pragma unroll
                for (int m = 0; m < 4; ++m) { float* rp = dtraw + (size_t)(row0 + ai * HALF + m * 16) * 64 + wc * 32 + 8 * fq;
                    *(f32x4*)rp = acc[ai][0][m][0]; *(f32x4*)(rp + 4) = acc[ai][0][m][1]; }
        }
    }
};
struct EpiOut {
    static constexpr bool PERM = false, AFTER_DRAIN = false;
    const float* xp; const float* xs; float* out;
    __device__ __forceinline__ void operator()(const f32x4 (&acc)[2][2][4][2], const Unit& u, int wr, int wc, int fr, int fq) const {
        const int row0 = u.pm * BM + wr * 64 + fr, col0 = u.pn * BM + wc * 32 + 4 * fq;
        const float* xb = (u.pm < 32) ? xp : xs - (size_t)8192 * 2048;
#pragma unroll
        for (int ai = 0; ai < 2; ++ai)
#pragma unroll
            for (int m = 0; m < 4; ++m) { const size_t ro = (size_t)(row0 + ai * HALF + m * 16) * 2048 + col0;
#pragma unroll
                for (int bj = 0; bj < 2; ++bj)
#pragma unroll
                    for (int n = 0; n < 2; ++n) { const f32x4 xv = *(const f32x4*)(xb + ro + bj * HALF + n * 16);
                        *(f32x4*)(out + ro + bj * HALF + n * 16) = xv + acc[ai][bj][m][n]; } }
    }
};

template <class Epi, class Sched, bool ALIGN_EPI = false, bool SP2 = false>
__device__ __forceinline__ void gemm_phase(PG8_LAS unsigned char* lds, const Gemm g, const Sched& S, const Epi& E) {
    const int tid = threadIdx.x, wid = __builtin_amdgcn_readfirstlane(tid >> 6), lane = tid & 63, wr = wid >> 2, wc = wid & 3, fr = lane & 15, fq = lane >> 4;
    const int K = g.K, nt = K / BK;
    unsigned voffA[2], voffB[2];
#pragma unroll
    for (int i = 0; i < 2; ++i) { int R, C; stage_rc(tid * 16 + i * 8192, R, C); const int Rb = Epi::PERM ? ((R & ~31) + perm32(R & 31)) : R;
        voffA[i] = (unsigned)(R * K + C) * 2u; voffB[i] = (unsigned)(Rb * K + C) * 2u; }
    const size_t kstep = (size_t)(BK * 2);
    const size_t hstep = (size_t)HALF * K * 2;
    const size_t tstep = 2 * hstep;
    const unsigned ldsw = (unsigned)wid * 1024u;
    const int aoff = lds_byte(wr * 64 + fr, fq * 8), boff = lds_byte(wc * 32 + fr, fq * 8);
#define PG8_SA(b, h) (((b) * 2 + (h)) * HTB)
#define PG8_SB(b, h) ((4 + (b) * 2 + (h)) * HTB)
#define PG8_STAGE(bufoff, gbase, voff) do { _Pragma("unroll") for (int _i = 0; _i < 2; ++_i) \
        __builtin_amdgcn_global_load_lds((const unsigned*)((const char*)(gbase) + (voff)[_i]), (PG8_LAS unsigned*)(lds + (bufoff) + ldsw + _i * 8192), 16, 0, 0); } while (0)
#define PG8_LDA(dst, b, h) do { _Pragma("unroll") for (int m = 0; m < 4; ++m) _Pragma("unroll") for (int k = 0; k < 2; ++k) dst[m][k] = *(const PG8_LAS bf16x8*)(lds + PG8_SA(b, h) + aoff + m * 2048 + k * 1024); } while (0)
#define PG8_LDB(dst, b, h) do { _Pragma("unroll") for (int n = 0; n < 2; ++n) _Pragma("unroll") for (int k = 0; k < 2; ++k) dst[n][k] = *(const PG8_LAS bf16x8*)(lds + PG8_SB(b, h) + boff + n * 2048 + k * 1024); } while (0)
#define PG8_MMA(ai, bj, At, Bt) do { __builtin_amdgcn_s_setprio(1); _Pragma("unroll") for (int m = 0; m < 4; ++m) _Pragma("unroll") for (int n = 0; n < 2; ++n) _Pragma("unroll") for (int k = 0; k < 2; ++k) \
        acc[ai][bj][m][n] = __builtin_amdgcn_mfma_f32_16x16x32_bf16(Bt[n][k], At[m][k], acc[ai][bj][m][n], 0, 0, 0); __builtin_amdgcn_s_setprio(0); } while (0)
#define PG8_WAIT_V(n) asm volatile("s_waitcnt vmcnt(" #n ")" ::: "memory")
#define PG8_WAIT_L(n) asm volatile("s_waitcnt lgkmcnt(" #n ")" ::: "memory")
#define PG8_BAR __builtin_amdgcn_s_barrier()
#define PG8_SCHED __builtin_amdgcn_sched_barrier(0)
    Unit cur, nxt; int ui = 0;
    if (!S.next(0, cur)) return;
    f32x4 acc[2][2][4][2];
#pragma unroll
    for (int a = 0; a < 2; ++a)
#pragma unroll
        for (int b = 0; b < 2; ++b)
#pragma unroll
            for (int m = 0; m < 4; ++m)
#pragma unroll
                for (int n = 0; n < 2; ++n) acc[a][b][m][n] = (f32x4){0.f, 0.f, 0.f, 0.f};
    bf16x8 At[4][2], B0[2][2], B1[2][2];
    const char* cA = (const char*)g.A + (size_t)cur.pm * tstep; const char* cB = (const char*)g.Bt + (size_t)cur.pn * tstep;
    S.a_ready(cur);
    if constexpr (SP2) {
        PG8_STAGE(PG8_SB(0, 0), cB, voffB); PG8_STAGE(PG8_SB(0, 1), cB + hstep, voffB); PG8_STAGE(PG8_SA(0, 0), cA, voffA); PG8_STAGE(PG8_SA(0, 1), cA + hstep, voffA);
        if (wr == 1) PG8_BAR;
        PG8_WAIT_V(2); PG8_BAR;
        PG8_STAGE(PG8_SB(1, 0), cB + kstep, voffB); PG8_STAGE(PG8_SA(1, 0), cA + kstep, voffA); PG8_STAGE(PG8_SB(1, 1), cB + hstep + kstep, voffB);
        PG8_WAIT_V(6); PG8_BAR;
    } else {
        PG8_STAGE(PG8_SB(0, 0), cB, voffB); PG8_STAGE(PG8_SA(0, 0), cA, voffA); PG8_STAGE(PG8_SB(0, 1), cB + hstep, voffB); PG8_STAGE(PG8_SA(0, 1), cA + hstep, voffA);
        if (wr == 1) PG8_BAR;
        PG8_WAIT_V(4); PG8_BAR;
        PG8_STAGE(PG8_SB(1, 0), cB + kstep, voffB); PG8_STAGE(PG8_SA(1, 0), cA + kstep, voffA); PG8_STAGE(PG8_SB(1, 1), cB + hstep + kstep, voffB);
        PG8_WAIT_V(6); PG8_BAR;
    }
    for (;;) {
        const bool has_next = S.next(ui + 1, nxt);
        const char* nA = has_next ? (const char*)g.A + (size_t)nxt.pm * tstep : cA; const char* nB = has_next ? (const char*)g.Bt + (size_t)nxt.pn * tstep : cB;
        for (int t = 0; t < nt; t += 2) {
            const bool last = (t == nt - 2);
            const char* a1 = cA + (size_t)(t + 1) * kstep;
            const char* a2 = last ? nA : cA + (size_t)(t + 2) * kstep; const char* b2 = last ? nB : cB + (size_t)(t + 2) * kstep;
            const char* a3 = a2 + kstep; const char* b3 = b2 + kstep;
            if (last && has_next) S.a_ready(nxt);
            if constexpr (SP2) {
            PG8_LDB(B0, 0, 0); PG8_LDB(B1, 0, 1); PG8_SCHED; PG8_LDA(At, 0, 0); PG8_STAGE(PG8_SA(1, 1), a1 + hstep, voffA);
            PG8_WAIT_V(8); PG8_WAIT_L(0); PG8_BAR; PG8_MMA(0, 0, At, B0); PG8_MMA(0, 1, At, B1); PG8_BAR; PG8_SCHED;
            PG8_LDA(At, 0, 1); PG8_STAGE(PG8_SB(0, 0), b2, voffB); PG8_STAGE(PG8_SB(0, 1), b2 + hstep, voffB); PG8_STAGE(PG8_SA(0, 0), a2, voffA);
            PG8_WAIT_V(8); PG8_WAIT_L(0); PG8_BAR; PG8_MMA(1, 0, At, B0); PG8_MMA(1, 1, At, B1); PG8_BAR; PG8_SCHED;
            PG8_LDB(B0, 1, 0); PG8_LDB(B1, 1, 1); PG8_SCHED; PG8_LDA(At, 1, 0); PG8_STAGE(PG8_SA(0, 1), a2 + hstep, voffA);
            PG8_WAIT_V(8); PG8_WAIT_L(0); PG8_BAR; PG8_MMA(0, 0, At, B0); PG8_MMA(0, 1, At, B1); PG8_BAR; PG8_SCHED;
            PG8_LDA(At, 1, 1); PG8_STAGE(PG8_SB(1, 0), b3, voffB); PG8_STAGE(PG8_SB(1, 1), b3 + hstep, voffB); PG8_STAGE(PG8_SA(1, 0), a3, voffA);
            PG8_WAIT_V(8); PG8_WAIT_L(0); PG8_BAR; PG8_MMA(1, 0, At, B0); PG8_MMA(1, 1, At, B1); PG8_BAR; PG8_SCHED;
            } else {
            PG8_LDB(B0, 0, 0); PG8_SCHED; PG8_LDA(At, 0, 0); PG8_STAGE(PG8_SA(1, 1), a1 + hstep, voffA);
            PG8_WAIT_L(8); PG8_BAR; PG8_WAIT_L(0); PG8_MMA(0, 0, At, B0); PG8_BAR; PG8_SCHED;
            PG8_LDB(B1, 0, 1); PG8_STAGE(PG8_SB(0, 0), b2, voffB);
            PG8_BAR; PG8_WAIT_L(0); PG8_MMA(0, 1, At, B1); PG8_BAR;
            PG8_LDA(At, 0, 1); PG8_STAGE(PG8_SA(0, 0), a2, voffA);
            PG8_BAR; PG8_WAIT_L(0); PG8_MMA(1, 0, At, B0); PG8_BAR; PG8_SCHED;
            PG8_STAGE(PG8_SB(0, 1), b2 + hstep, voffB);
            PG8_WAIT_V(6); PG8_BAR; PG8_MMA(1, 1, At, B1); PG8_BAR;
            PG8_LDB(B0, 1, 0); PG8_SCHED; PG8_LDA(At, 1, 0); PG8_STAGE(PG8_SA(0, 1), a2 + hstep, voffA);
            PG8_WAIT_L(8); PG8_BAR; PG8_WAIT_L(0); PG8_MMA(0, 0, At, B0); PG8_BAR; PG8_SCHED;
            PG8_LDB(B1, 1, 1); PG8_STAGE(PG8_SB(1, 0), b3, voffB);
            PG8_BAR; PG8_WAIT_L(0); PG8_MMA(0, 1, At, B1); PG8_BAR;
            PG8_LDA(At, 1, 1); PG8_STAGE(PG8_SA(1, 0), a3, voffA);
            PG8_BAR; PG8_WAIT_L(0); PG8_MMA(1, 0, At, B0); PG8_BAR; PG8_SCHED;
            PG8_STAGE(PG8_SB(1, 1), b3 + hstep, voffB);
            PG8_WAIT_V(6); PG8_BAR; PG8_MMA(1, 1, At, B1); PG8_BAR;
            }
        }
        if constexpr (ALIGN_EPI) { if (wr == 0) PG8_BAR; }
        if constexpr (!Epi::AFTER_DRAIN) { E(acc, cur, wr, wc, fr, fq); S.done(cur); }
        if (!has_next) break;
#pragma unroll
        for (int a = 0; a < 2; ++a)
#pragma unroll
            for (int b = 0; b < 2; ++b)
#pragma unroll
                for (int m = 0; m < 4; ++m)
#pragma unroll
                    for (int n = 0; n < 2; ++n) acc[a][b][m][n] = (f32x4){0.f, 0.f, 0.f, 0.f};
        cur = nxt; cA = nA; cB = nB; ++ui;
        if constexpr (ALIGN_EPI) { if (wr == 1) PG8_BAR; }
    }
    PG8_WAIT_V(0);
    if constexpr (!ALIGN_EPI) { if (wr == 0) PG8_BAR; }
    PG8_BAR;
    if constexpr (Epi::AFTER_DRAIN) { E.fused(acc, cur, wr, wc, fr, fq, lds, wid, lane); S.done(cur); }
#undef PG8_SA
#undef PG8_SB
#undef PG8_STAGE
#undef PG8_LDA
#undef PG8_LDB
#undef PG8_MMA
#undef PG8_WAIT_V
#undef PG8_WAIT_L
#undef PG8_BAR
#undef PG8_SCHED
}

}

constexpr int DMODEL = 2048, NPR = 8192  , NSM = 512  , MROWS = NPR + NSM;
constexpr int DPOOL = 1024, DSSM = 3072, DCONV = 5120, NHEAD = 48, HDIM = 64, NGRP = 8, DSTATE = 128, DMIX = 4096;
constexpr int NPROJ = 10288, PLD = 10240  , NPROJ_PAD = 10496  ;
constexpr int C_GATE = 1024, C_Z = 2048, C_XBC = 5120;
constexpr float EPS = 1e-5f;
constexpr size_t O_Y = 0, O_POOL_P = 17825792, O_CONV_P = 17887232, O_SSM_P = 17948672, O_POOL_S = 19521536, O_CONV_S = 21487616, O_SSM_S = 23453696;
constexpr size_t MiB = 1u << 20;
constexpr size_t WS_CTL = 0, CTL_ZERO_BYTES = 1 * MiB;
constexpr size_t WS_XN = 2 * MiB;
constexpr size_t WS_WINT = 36 * MiB;
constexpr size_t WS_WOUTT = 78 * MiB;
constexpr size_t WS_PROJ = 96 * MiB;
constexpr size_t WS_DTRAW = 268 * MiB;
constexpr size_t WS_MIX = 272 * MiB;
constexpr size_t WS_YBUF = 344 * MiB;
constexpr size_t WS_ST = 448 * MiB;
constexpr size_t WS_SIN = 544 * MiB;
constexpr size_t WS_CHDEC = 592 * MiB;
constexpr size_t WS_PWT = 593 * MiB;
constexpr size_t WS_END = 594 * MiB;
constexpr int CW_BAR = 4096;
constexpr int NWAVES = 8, NTHR = 512;
constexpr int RING_BYTES = 131072, LDSCTL_OFF = RING_BYTES, MISC_OFF = LDSCTL_OFF + 320, LDS_BYTES = 147456;

#define GAS __attribute__((address_space(1)))
#define LAS __attribute__((address_space(3)))
typedef unsigned short bf16;
typedef unsigned v4u __attribute__((ext_vector_type(4)));
typedef float f32x4 __attribute__((ext_vector_type(4)));
#define LDS_WAIT() asm volatile("s_waitcnt lgkmcnt(0)" ::: "memory")
#define VM_WAIT() asm volatile("s_waitcnt vmcnt(0)" ::: "memory")
__device__ __forceinline__ unsigned f2bf(float f) { unsigned u = __builtin_bit_cast(unsigned, f); return (u + 0x7fffu + ((u >> 16) & 1u)) >> 16; }
__device__ __forceinline__ unsigned pk2(float lo, float hi) { return f2bf(lo) | (f2bf(hi) << 16); }
__device__ __forceinline__ float bf2f(bf16 v) { return __builtin_bit_cast(float, (unsigned)v << 16); }
__device__ __forceinline__ float silu_f(float x) { return x / (1.f + __expf(-x)); }
__device__ __forceinline__ float softplus_f(float x) { return fmaxf(x, 0.f) + log1pf(__expf(-fabsf(x))); }
__device__ __forceinline__ float wave_sum(float v) {
#pragma unroll
    for (int o = 1; o < 64; o <<= 1) v += __shfl_xor(v, o);
    return v;
}

#define XB_TMO      128
#define XB_XCNT(j)  (256  + 64 * (j))
#define XB_XSUB(j)  (1280 + 64 * (j))
#define XB_XGEN(j)  (2304 + 64 * (j))
#define XB_TOP      3328
#define XB_TOPGEN   3392
#define XCD_BAR_WORDS 3456
#define XB_SPIN_CAP (1u << 18)

__device__ __forceinline__ unsigned xb_ld(unsigned* p)              { return __hip_atomic_load(p, __ATOMIC_RELAXED, __HIP_MEMORY_SCOPE_AGENT); }
__device__ __forceinline__ unsigned xb_add(unsigned* p, unsigned v) { return __hip_atomic_fetch_add(p, v, __ATOMIC_RELAXED, __HIP_MEMORY_SCOPE_AGENT); }
__device__ __forceinline__ unsigned xb_xcc_id() { return (unsigned)__builtin_amdgcn_s_getreg((3 << 11) | 20) & 0xFu; }
#define XB_SPIN(cond, bar) do { unsigned _sp = 0; while (cond) { __builtin_amdgcn_s_sleep(1); \
    if ((++_sp & 255u) == 0u) { if (xb_ld(&(bar)[XB_TMO])) break; if (_sp > XB_SPIN_CAP) { atomicAdd(&(bar)[XB_TMO], 1u); break; } } } } while (0)

struct XcdBarrier {
    unsigned* bar; unsigned x;
    volatile LAS unsigned* st;
};

__device__ __forceinline__ XcdBarrier xcd_barrier_post(unsigned* bar, volatile LAS unsigned* st) {
    XcdBarrier b; b.bar = bar; b.x = xb_xcc_id(); b.st = st;
    if (threadIdx.x == 0) (void)xb_add(&bar[XB_XCNT(b.x)], 1u);
    return b;
}
__device__ __forceinline__ void xcd_barrier_complete(unsigned* bar, unsigned x, unsigned& nloc, unsigned& nx) {
    const unsigned G = gridDim.x * gridDim.y * gridDim.z;
    unsigned sum, cnt, mine, sp = 0u;
    for (;;) {
        sum = 0u; cnt = 0u; mine = 0u;
#pragma unroll
        for (unsigned j = 0; j < 16; ++j) { const unsigned c = xb_ld(&bar[XB_XCNT(j)]); sum += c; cnt += (c > 0u) ? 1u : 0u; mine = (j == x) ? c : mine; }
        if (sum == G) break;
        __builtin_amdgcn_s_sleep(1);
        if ((++sp & 255u) == 0u) { if (xb_ld(&bar[XB_TMO])) break; if (sp > XB_SPIN_CAP) { atomicAdd(&bar[XB_TMO], 1u); break; } }
    }
    nloc = mine > 0u ? mine : 1u; nx = cnt > 0u ? cnt : 1u;
}

__device__ __forceinline__ void xcd_barrier(const XcdBarrier& b) {
    asm volatile("s_waitcnt vmcnt(0)" ::: "memory");
    __syncthreads();
    if (threadIdx.x == 0) {
        unsigned* bar = b.bar;
        __builtin_amdgcn_s_waitcnt(0);
        unsigned nloc = b.st[0], nx = b.st[1];
        if (nloc == 0u) { xcd_barrier_complete(bar, b.x, nloc, nx); b.st[0] = nloc; b.st[1] = nx; }
        const unsigned old = xb_add(&bar[XB_XSUB(b.x)], 1u);
        const unsigned gen = old / nloc;
        if (old + 1u == (gen + 1u) * nloc) {
            __builtin_amdgcn_fence(__ATOMIC_RELEASE, "agent");
            asm volatile("s_waitcnt vmcnt(0)" ::: "memory");
            const unsigned og = xb_add(&bar[XB_TOP], 1u);
            const unsigned tg = og / nx;
            if (og + 1u == (tg + 1u) * nx) xb_add(&bar[XB_TOPGEN], 1u);
            else XB_SPIN(xb_ld(&bar[XB_TOPGEN]) == tg, bar);
            __builtin_amdgcn_fence(__ATOMIC_ACQUIRE, "agent");
            xb_add(&bar[XB_XGEN(b.x)], 1u);
            asm volatile("s_waitcnt vmcnt(0)" ::: "memory");
        } else {
            XB_SPIN(xb_ld(&bar[XB_XGEN(b.x)]) == gen, bar);
            __builtin_amdgcn_fence(__ATOMIC_ACQUIRE, "agent");
            asm volatile("s_waitcnt vmcnt(0)" ::: "memory");
        }
    }
    __syncthreads();
}


struct Frame {
    LAS unsigned char* lds;
    int tid, lane, wave, G, bid;
    const float *x_prompt, *x_sample, *state_pool, *state_conv, *state_ssm, *norm_g, *w_in, *conv_w, *conv_b, *dt_bias, *a_log, *d_skip, *ssm_norm_g, *pool_w, *pool_scale, *w_out, *final_g;
    float* out;
    bf16 *XN, *WinT, *WoutT, *PROJ, *MIX, *SIN, *PWT; float *DTRAW, *YBUF, *ST, *CHDEC;
};

__device__ __forceinline__ void p0_transpose_item(const float* W, int K, int N, bf16* WT, LAS float* scr, int item, int lane) {
    const int nblk = (N + 31) / 32, kb = item / nblk, nb = item % nblk, k0 = 64 * kb, n0 = 32 * nb;
    const bool ok = (n0 + (lane & 31)) < N;
#pragma unroll 8
    for (int i = 0; i < 32; ++i) { const int kk = 2 * i + (lane >> 5); scr[kk * 33 + (lane & 31)] = ok ? W[(size_t)(k0 + kk) * N + n0 + (lane & 31)] : 0.f; }
    LDS_WAIT(); asm volatile("" ::: "memory");
    const int c = lane & 7;
#pragma unroll
    for (int j = 0; j < 4; ++j) { const int n = (lane >> 3) + 8 * j; const LAS float* s = scr + (8 * c) * 33 + n;
        v4u o; o.x = pk2(s[0 * 33], s[1 * 33]); o.y = pk2(s[2 * 33], s[3 * 33]); o.z = pk2(s[4 * 33], s[5 * 33]); o.w = pk2(s[6 * 33], s[7 * 33]);
        *(GAS v4u*)(WT + (size_t)(n0 + n) * K + k0 + 8 * c) = o; }
    LDS_WAIT(); asm volatile("" ::: "memory");
}
__device__ __forceinline__ void p0_prologue(Frame& F) {
    LAS float* scr = (LAS float*)(F.lds + F.wave * 16384);
    const int gw = F.bid * NWAVES + F.wave, NGW = F.G * NWAVES;
    constexpr int I_IN = (DMODEL / 64) * ((NPROJ + 31) / 32), I_OUT = (DMIX / 64) * (DMODEL / 32);
    for (int it = gw; it < I_IN + I_OUT + 128; it += NGW) {
        if (it < I_IN) p0_transpose_item(F.w_in, DMODEL, NPROJ, F.WinT, scr, it, F.lane);
        else if (it < I_IN + I_OUT) p0_transpose_item(F.w_out, DMIX, DMODEL, F.WoutT, scr, it - I_IN, F.lane);
        else { const int j = it - I_IN - I_OUT; p0_transpose_item(F.pool_w + (size_t)(j >> 5) * 65536, 256, 256, F.PWT + (size_t)(j >> 5) * 65536, scr, j & 31, F.lane); }
    }
    { const size_t z0 = (size_t)10304 * DMODEL * 2, z1 = (size_t)NPROJ_PAD * DMODEL * 2; GAS v4u* zp = (GAS v4u*)((unsigned char*)F.WinT + z0);
      const size_t nz = (z1 - z0) / 16; for (size_t i = (size_t)F.bid * NTHR + F.tid; i < nz; i += (size_t)F.G * NTHR) zp[i] = (v4u){0u, 0u, 0u, 0u}; }
    for (int m = gw; m < MROWS; m += NGW) {
        const float* xrow = (m < NPR) ? F.x_prompt + (size_t)m * DMODEL : F.x_sample + (size_t)(m - NPR) * DMODEL;
        const GAS f32x4* xr = (const GAS f32x4*)xrow + F.lane; const GAS f32x4* gr = (const GAS f32x4*)F.norm_g + F.lane;
        f32x4 v[8]; float s = 0.f;
#pragma unroll
        for (int j = 0; j < 8; ++j) { v[j] = xr[64 * j]; s += (v[j].x * v[j].x + v[j].y * v[j].y) + (v[j].z * v[j].z + v[j].w * v[j].w); }
        const float r = 1.f / sqrtf(wave_sum(s) * (1.f / DMODEL) + EPS);
        GAS unsigned long long* o8 = (GAS unsigned long long*)(F.XN + (size_t)m * DMODEL) + F.lane;
#pragma unroll
        for (int j = 0; j < 8; ++j) { const f32x4 g = gr[64 * j]; o8[64 * j] = (unsigned long long)pk2(v[j].x * r * g.x, v[j].y * r * g.y) | ((unsigned long long)pk2(v[j].z * r * g.z, v[j].w * r * g.w) << 32); }
    }
}

__device__ __forceinline__ void pool_unit(Frame& F, int tile, int gi) {
    LAS float* pooled = (LAS float*)F.lds;
    const int w = 2 << gi, m0 = tile * 32, c = F.tid & 255, th = F.tid >> 8, ch = gi * 256 + c;
    for (int i = 0; i < 16; ++i) {
        const int t = th * 16 + i, m = m0 + t; const bool prompt = m < NPR;
        int b, tq, cnt; if (prompt) { b = m >> 11; tq = m & 2047; cnt = min(w, tq + 1); } else { const int ms = m - NPR; b = ms >> 2; tq = ms & 3; cnt = w; }
        float sum = 0.f;
        for (int j = 0; j < w; ++j) { const int tt = tq - j; float v;
            if (tt >= 0) v = bf2f(F.PROJ[(size_t)(m - j) * PLD + ch]); else v = prompt ? 0.f : F.state_pool[(size_t)(b * 15 + 15 + tt) * DPOOL + ch];
            sum += v; }
        const float u0 = bf2f(F.PROJ[(size_t)m * PLD + ch]);
        pooled[t * 256 + c] = sum / (float)cnt - u0;
    }
    __syncthreads();
    float acc[16];
#pragma unroll
    for (int i = 0; i < 16; ++i) acc[i] = 0.f;
    const float* W = F.pool_w + (size_t)gi * 65536 + c;
    for (int c4 = 0; c4 < 64; ++c4) {
        const float w0 = W[(size_t)(4 * c4 + 0) * 256], w1 = W[(size_t)(4 * c4 + 1) * 256], w2 = W[(size_t)(4 * c4 + 2) * 256], w3 = W[(size_t)(4 * c4 + 3) * 256];
#pragma unroll
        for (int i = 0; i < 16; ++i) { const f32x4 p4 = *(const LAS f32x4*)(pooled + (th * 16 + i) * 256 + 4 * c4); acc[i] += (p4.x * w0 + p4.y * w1) + (p4.z * w2 + p4.w * w3); }
    }
    const float sc = F.pool_scale[ch];
#pragma unroll
    for (int i = 0; i < 16; ++i) { const int m = m0 + th * 16 + i; const float gate = bf2f(F.PROJ[(size_t)m * PLD + C_GATE + ch]);
        F.MIX[(size_t)m * DMIX + ch] = (bf16)f2bf(acc[i] * sc * silu_f(gate)); }
    __syncthreads();
}

__device__ __forceinline__ void ssd_unit(Frame& F, int seq, int h) {
    const bool prompt = seq < 4; const int L = prompt ? 2048 : 4, sb = seq - 4, row0 = prompt ? seq * 2048 : NPR + sb * 4, g = h / 6;
    const int p = F.tid >> 3, nq = F.tid & 7;
    LAS float* T = (LAS float*)F.lds;
    LAS float* dts = T + 32 * 320; LAS float* dec = dts + 32;
    float S[16];
    if (prompt) {
#pragma unroll
        for (int j = 0; j < 16; ++j) S[j] = 0.f;
    } else { const f32x4* sp = (const f32x4*)(F.state_ssm + ((size_t)(sb * NHEAD + h) * HDIM + p) * DSTATE + nq * 16);
#pragma unroll
        for (int q = 0; q < 4; ++q) { const f32x4 v = sp[q]; S[4 * q] = v.x; S[4 * q + 1] = v.y; S[4 * q + 2] = v.z; S[4 * q + 3] = v.w; } }
    const float a = -__expf(F.a_log[h]), dtb = F.dt_bias[h], dsk = F.d_skip[h];
    for (int t0 = 0; t0 < L; t0 += 32) {
        const int nt = min(32, L - t0);
        __syncthreads();
        for (int e = F.tid; e < nt * 320; e += NTHR) {
            const int t = e / 320, c = e - t * 320;
            const int xch = c < 64 ? h * 64 + c : (c < 192 ? 3072 + g * 128 + (c - 64) : 4096 + g * 128 + (c - 192));
            float acc = F.conv_b[xch];
#pragma unroll
            for (int k = 0; k < 4; ++k) { const int tt = t0 + t + k - 3; float v;
                if (tt >= 0) v = bf2f(F.PROJ[(size_t)(row0 + tt) * PLD + C_XBC + xch]); else v = prompt ? 0.f : F.state_conv[(size_t)(sb * 3 + 3 + tt) * DCONV + xch];
                acc += v * F.conv_w[k * DCONV + xch]; }
            T[e] = silu_f(acc);
        }
        for (int t = F.tid; t < nt; t += NTHR) { const float dt = softplus_f(F.DTRAW[(size_t)(row0 + t0 + t) * 64 + h] + dtb); dts[t] = dt; dec[t] = __expf(dt * a); }
        __syncthreads();
        for (int t = 0; t < nt; ++t) {
            const LAS float* r = T + t * 320;
            const float x = r[p], d = dec[t], dtx = dts[t] * x; float acc = 0.f;
#pragma unroll
            for (int q = 0; q < 4; ++q) { const f32x4 bv = *(const LAS f32x4*)(r + 64 + nq * 16 + 4 * q), cv = *(const LAS f32x4*)(r + 192 + nq * 16 + 4 * q);
                S[4 * q] = d * S[4 * q] + dtx * bv.x; S[4 * q + 1] = d * S[4 * q + 1] + dtx * bv.y; S[4 * q + 2] = d * S[4 * q + 2] + dtx * bv.z; S[4 * q + 3] = d * S[4 * q + 3] + dtx * bv.w;
                acc += (cv.x * S[4 * q] + cv.y * S[4 * q + 1]) + (cv.z * S[4 * q + 2] + cv.w * S[4 * q + 3]); }
            acc += __shfl_xor(acc, 1); acc += __shfl_xor(acc, 2); acc += __shfl_xor(acc, 4);
            if (nq == 0) F.YBUF[(size_t)(row0 + t0 + t) * DSSM + h * 64 + p] = acc + dsk * x;
        }
    }
    float* so = F.out + (prompt ? O_SSM_P + ((size_t)(seq * NHEAD + h) * HDIM + p) * DSTATE : O_SSM_S + ((size_t)(sb * NHEAD + h) * HDIM + p) * DSTATE) + nq * 16;
#pragma unroll
    for (int q = 0; q < 4; ++q) *(f32x4*)(so + 4 * q) = (f32x4){S[4 * q], S[4 * q + 1], S[4 * q + 2], S[4 * q + 3]};
    __syncthreads();
}


typedef short s16x8 __attribute__((ext_vector_type(8)));
typedef float f32x16 __attribute__((ext_vector_type(16)));
typedef unsigned u32x2 __attribute__((ext_vector_type(2)));
typedef float f32x2 __attribute__((ext_vector_type(2)));
constexpr int PT = 272;
__device__ __forceinline__ unsigned cvtpk(float lo, float hi) { return pg8::cvt_pk_bf16(lo, hi); }
__device__ __forceinline__ float bflo(unsigned w) { return __builtin_bit_cast(float, w << 16); }
__device__ __forceinline__ float bfhi(unsigned w) { return __builtin_bit_cast(float, w & 0xffff0000u); }
__device__ __forceinline__ f32x16 mfma32(s16x8 a, s16x8 b, f32x16 c) { return __builtin_amdgcn_mfma_f32_32x32x16_bf16(a, b, c, 0, 0, 0); }
__device__ __forceinline__ s16x8 ldfrag(const LAS unsigned char* img, int row, int ks, int hh) { return *(const LAS s16x8*)(img + row * PT + ks * 32 + hh * 16); }
__device__ __forceinline__ void conv8x2(const Frame& F, int seq_row0, int t0, int xch, float (&o0)[8], float (&o1)[8]) {
    unsigned raw[11];
    const bf16* base = F.PROJ + (size_t)seq_row0 * PLD + C_XBC + xch;
#pragma unroll
    for (int i = 0; i < 11; ++i) { const int t = t0 - 3 + i; raw[i] = (t >= 0) ? *(const unsigned*)(base + (size_t)t * PLD) : 0u; }
    f32x2 w[4];
#pragma unroll
    for (int k = 0; k < 4; ++k) w[k] = *(const f32x2*)(F.conv_w + k * DCONV + xch);
    const f32x2 bb = *(const f32x2*)(F.conv_b + xch);
#pragma unroll
    for (int o = 0; o < 8; ++o) { float a0 = bb.x, a1 = bb.y;
#pragma unroll
        for (int k = 0; k < 4; ++k) { a0 += bflo(raw[o + k]) * w[k].x; a1 += bfhi(raw[o + k]) * w[k].y; }
        o0[o] = silu_f(a0); o1[o] = silu_f(a1); }
}
__device__ __forceinline__ v4u pack8(const float (&o)[8]) { v4u r; r.x = cvtpk(o[0], o[1]); r.y = cvtpk(o[2], o[3]); r.z = cvtpk(o[4], o[5]); r.w = cvtpk(o[6], o[7]); return r; }
__device__ __forceinline__ void chunk_dt(const Frame& F, int row0, int g, LAS float* dtl, LAS float* Ac) {
    if (F.wave < 6) {
        const int h = 6 * g + F.wave; const float a = -__expf(F.a_log[h]), bias = F.dt_bias[h]; const int l0 = 2 * F.lane;
        const float d0 = softplus_f(F.DTRAW[(size_t)(row0 + l0) * 64 + h] + bias), d1 = softplus_f(F.DTRAW[(size_t)(row0 + l0 + 1) * 64 + h] + bias);
        const float e0 = d0 * a, e1 = d1 * a; float s = e0 + e1;
#pragma unroll
        for (int o = 1; o < 64; o <<= 1) { const float u = __shfl_up(s, o); if (F.lane >= o) s += u; }
        dtl[F.wave * 128 + l0] = d0; dtl[F.wave * 128 + l0 + 1] = d1; Ac[F.wave * 128 + l0] = s - e1; Ac[F.wave * 128 + l0 + 1] = s;
    }
}
__device__ __forceinline__ void p2a_unit(Frame& F, int b, int c, int g) {
    LAS unsigned char* XwT = F.lds;
    LAS unsigned char* BT = F.lds + 52224;
    LAS float* dtl = (LAS float*)(F.lds + 87040); LAS float* Ac = (LAS float*)(F.lds + 90112);
    const int seq_row0 = b * 2048, tok0 = c * 128, row0 = seq_row0 + tok0, hh = F.lane >> 5, l31 = F.lane & 31;
    __syncthreads();
    chunk_dt(F, row0, g, dtl, Ac);
    for (int it = F.tid; it < 1024; it += NTHR) { const int cp = it & 63, to = it >> 6; float o0[8], o1[8];
        conv8x2(F, seq_row0, tok0 + 8 * to, 3072 + g * 128 + 2 * cp, o0, o1);
        *(LAS v4u*)(BT + (2 * cp) * PT + to * 16) = pack8(o0); *(LAS v4u*)(BT + (2 * cp + 1) * PT + to * 16) = pack8(o1); }
    __syncthreads();
    if (F.tid < 6) F.CHDEC[(size_t)(b * 16 + c) * NHEAD + 6 * g + F.tid] = __expf(Ac[F.tid * 128 + 127]);
    for (int half = 0; half < 2; ++half) {
        if (half) __syncthreads();
        for (int it = F.tid; it < 1536; it += NTHR) { const int cp = it % 96, to = it / 96, ch = 2 * cp, rl = ch >> 6, p = ch & 63, r = 3 * half + rl; float o0[8], o1[8];
            conv8x2(F, seq_row0, tok0 + 8 * to, (6 * g + r) * 64 + p, o0, o1);
            const float aend = Ac[r * 128 + 127];
#pragma unroll
            for (int o = 0; o < 8; ++o) { const float wl = __expf(aend - Ac[r * 128 + 8 * to + o]) * dtl[r * 128 + 8 * to + o]; o0[o] *= wl; o1[o] *= wl; }
            *(LAS v4u*)(XwT + (rl * 64 + p) * PT + to * 16) = pack8(o0); *(LAS v4u*)(XwT + (rl * 64 + p + 1) * PT + to * 16) = pack8(o1); }
        __syncthreads();
        const int pi = F.wave >> 2, ni = F.wave & 3;
        for (int rl = 0; rl < 3; ++rl) {
            f32x16 acc;
#pragma unroll
            for (int i = 0; i < 16; ++i) acc[i] = 0.f;
#pragma unroll
            for (int ks = 0; ks < 8; ++ks) acc = mfma32(ldfrag(XwT, rl * 64 + 32 * pi + l31, ks, hh), ldfrag(BT, 32 * ni + l31, ks, hh), acc);
            const int h = 6 * g + 3 * half + rl;
            float* so = F.ST + ((size_t)((b * 16 + c) * NHEAD + h) * HDIM) * DSTATE + 32 * ni + l31;
#pragma unroll
            for (int i = 0; i < 16; ++i) { const int p = 32 * pi + (i & 3) + 8 * (i >> 2) + 4 * hh; so[(size_t)p * DSTATE] = acc[i]; }
        }
    }
}
__device__ __forceinline__ void p2b_scan(Frame& F) {
    const int gt = F.bid * NTHR + F.tid, GT = F.G * NTHR;
    for (int i = gt; i < 4 * NHEAD * 2048; i += GT) {
        const int b = i / (NHEAD * 2048), rem = i - b * (NHEAD * 2048), h = rem >> 11, e = rem & 2047;
        f32x4 st[16];
#pragma unroll
        for (int c = 0; c < 16; ++c) st[c] = *((const f32x4*)F.ST + ((size_t)((b * 16 + c) * NHEAD + h) * 2048 + e));
        f32x4 s = (f32x4){0.f, 0.f, 0.f, 0.f};
#pragma unroll
        for (int c = 0; c < 16; ++c) {
            u32x2 pk; pk.x = cvtpk(s.x, s.y); pk.y = cvtpk(s.z, s.w);
            *((u32x2*)F.SIN + ((size_t)((b * 16 + c) * NHEAD + h) * 2048 + e)) = pk;
            const float d = F.CHDEC[(size_t)(b * 16 + c) * NHEAD + h];
            s = s * d + st[c];
        }
        *((f32x4*)(F.out + O_SSM_P) + ((size_t)(b * NHEAD + h) * 2048 + e)) = s;
    }
}
__device__ __forceinline__ void p2c_unit(Frame& F, int b, int c, int g) {
    LAS unsigned char* Cn = F.lds;
    LAS unsigned char* Bn = F.lds + 34816;
    LAS unsigned char* XT = F.lds + 69632;
    LAS unsigned char* Sin = F.lds + 87040;
    LAS float* dtl = (LAS float*)(F.lds + 104448); LAS float* Ac = (LAS float*)(F.lds + 107520);
    LAS float* part = (LAS float*)(F.lds + 69632);
    LAS float* rs = (LAS float*)(F.lds + 110592);
    const int seq_row0 = b * 2048, tok0 = c * 128, row0 = seq_row0 + tok0, hh = F.lane >> 5, l31 = F.lane & 31;
    const int li = F.wave >> 1, sh = F.wave & 1, pj = F.wave & 1;
    __syncthreads();
    chunk_dt(F, row0, g, dtl, Ac);
    for (int it = F.tid; it < 2048; it += NTHR) { const int isC = it >> 10, cp = it & 63, to = (it >> 6) & 15; float o0[8], o1[8];
        conv8x2(F, seq_row0, tok0 + 8 * to, 3072 + isC * 1024 + g * 128 + 2 * cp, o0, o1);
        LAS unsigned char* img = (isC ? Cn : Bn) + (8 * to) * PT + cp * 4;
#pragma unroll
        for (int o = 0; o < 8; ++o) *(LAS unsigned*)(img + o * PT) = cvtpk(o0[o], o1[o]); }
    __syncthreads();
    f32x16 gt0, gt1;
#pragma unroll
    for (int i = 0; i < 16; ++i) { gt0[i] = 0.f; gt1[i] = 0.f; }
    if (2 * sh <= li) {
#pragma unroll
        for (int ks = 0; ks < 8; ++ks) gt0 = mfma32(ldfrag(Bn, 64 * sh + l31, ks, hh), ldfrag(Cn, 32 * li + l31, ks, hh), gt0);
    }
    if (2 * sh + 1 <= li) {
#pragma unroll
        for (int ks = 0; ks < 8; ++ks) gt1 = mfma32(ldfrag(Bn, 64 * sh + 32 + l31, ks, hh), ldfrag(Cn, 32 * li + l31, ks, hh), gt1);
    }
    float ss[16];
#pragma unroll
    for (int i = 0; i < 16; ++i) ss[i] = 0.f;
    for (int r = 0; r < 6; ++r) {
        const int h = 6 * g + r;
        __syncthreads();
        { const int cp = F.tid & 31, to = F.tid >> 5; float o0[8], o1[8];
          conv8x2(F, seq_row0, tok0 + 8 * to, h * 64 + 2 * cp, o0, o1);
          *(LAS v4u*)(XT + (2 * cp) * PT + to * 16) = pack8(o0); *(LAS v4u*)(XT + (2 * cp + 1) * PT + to * 16) = pack8(o1); }
        { const bf16* sg = F.SIN + ((size_t)((b * 16 + c) * NHEAD + h) * HDIM) * DSTATE;
#pragma unroll
          for (int j = 0; j < 2; ++j) { const int idx = F.tid + NTHR * j, p = idx >> 4, seg = idx & 15; *(LAS v4u*)(Sin + p * PT + seg * 16) = *(const v4u*)(sg + p * DSTATE + seg * 8); } }
        { const int l = 32 * li + l31; const float Al = Ac[r * 128 + l];
#pragma unroll
          for (int tsel = 0; tsel < 2; ++tsel) { const int si = 2 * sh + tsel;
            if (si <= li) {
#pragma unroll
                for (int q = 0; q < 4; ++q) { const int s0 = 32 * si + 8 * q + 4 * hh;
                    const f32x4 As4 = *(const LAS f32x4*)(Ac + r * 128 + s0), dt4 = *(const LAS f32x4*)(dtl + r * 128 + s0); float v[4];
#pragma unroll
                    for (int j = 0; j < 4; ++j) { const float gv = tsel ? gt1[4 * q + j] : gt0[4 * q + j]; const float e = __expf(fminf(Al - As4[j], 0.f)); v[j] = (s0 + j <= l) ? gv * e * dt4[j] : 0.f; }
                    u32x2 pk; pk.x = cvtpk(v[0], v[1]); pk.y = cvtpk(v[2], v[3]);
                    *(LAS u32x2*)(Bn + l * PT + s0 * 2) = pk; } } } }
        __syncthreads();
        f32x16 acc;
#pragma unroll
        for (int i = 0; i < 16; ++i) acc[i] = 0.f;
#pragma unroll
        for (int ks = 0; ks < 8; ++ks) acc = mfma32(ldfrag(Cn, 32 * li + l31, ks, hh), ldfrag(Sin, 32 * pj + l31, ks, hh), acc);
#pragma unroll
        for (int q = 0; q < 4; ++q) { const f32x4 A4 = *(const LAS f32x4*)(Ac + r * 128 + 32 * li + 8 * q + 4 * hh);
#pragma unroll
            for (int j = 0; j < 4; ++j) acc[4 * q + j] *= __expf(A4[j]); }
        for (int ks = 0; ks < 2 * (li + 1); ++ks) acc = mfma32(ldfrag(Bn, 32 * li + l31, ks, hh), ldfrag(XT, 32 * pj + l31, ks, hh), acc);
        const float dsk = F.d_skip[h]; const int pcol = h * 64 + 32 * pj + l31;
#pragma unroll
        for (int q = 0; q < 4; ++q) { const int l0 = 32 * li + 8 * q + 4 * hh; const u32x2 x4 = *(const LAS u32x2*)(XT + (32 * pj + l31) * PT + l0 * 2);
            const float xv[4] = {bflo(x4.x), bfhi(x4.x), bflo(x4.y), bfhi(x4.y)};
#pragma unroll
            for (int j = 0; j < 4; ++j) { const size_t row = (size_t)(row0 + l0 + j); const float z = bf2f(F.PROJ[row * PLD + C_Z + pcol]);
                const float yz = (acc[4 * q + j] + dsk * xv[j]) * silu_f(z); ss[4 * q + j] += yz * yz; F.MIX[row * DMIX + DPOOL + pcol] = (bf16)f2bf(yz); } }
    }
    VM_WAIT(); __syncthreads();
#pragma unroll
    for (int i = 0; i < 16; ++i) { const int l = 32 * li + (i & 3) + 8 * (i >> 2) + 4 * hh; part[l * 64 + 32 * pj + l31] = ss[i]; }
    __syncthreads();
    if (F.tid < 128) { float s = 0.f;
#pragma unroll
        for (int j = 0; j < 16; ++j) { const f32x4 v = *(const LAS f32x4*)(part + F.tid * 64 + 4 * j); s += (v.x + v.y) + (v.z + v.w); }
        rs[F.tid] = 1.f / sqrtf(s * (1.f / 384.f) + EPS); }
    __syncthreads();
    for (int it = F.tid; it < 128 * 48; it += NTHR) { const int l = it / 48, k8 = it - l * 48; const float rv = rs[l];
        bf16* mp = F.MIX + (size_t)(row0 + l) * DMIX + DPOOL + g * 384 + 8 * k8; const v4u raw = *(const v4u*)mp;
        const f32x4 g0 = *(const f32x4*)(F.ssm_norm_g + g * 384 + 8 * k8), g1 = *(const f32x4*)(F.ssm_norm_g + g * 384 + 8 * k8 + 4);
        v4u o; o.x = cvtpk(bflo(raw.x) * rv * g0.x, bfhi(raw.x) * rv * g0.y); o.y = cvtpk(bflo(raw.y) * rv * g0.z, bfhi(raw.y) * rv * g0.w);
        o.z = cvtpk(bflo(raw.z) * rv * g1.x, bfhi(raw.z) * rv * g1.y); o.w = cvtpk(bflo(raw.w) * rv * g1.z, bfhi(raw.w) * rv * g1.w);
        *(v4u*)mp = o; }
}

constexpr int PT2 = 528;
template <int W> __device__ __forceinline__ void pool_stage_prompt(const Frame& F, LAS unsigned char* Ap, int m0, int gi) {
    for (int it = F.tid; it < 1024; it += NTHR) { const int cp = it & 127, to = it >> 7, mrow = m0 + 8 * to, tseq = mrow & 2047;
        const bf16* base = F.PROJ + (size_t)mrow * PLD + gi * 256 + 2 * cp;
        unsigned raw[W + 7];
#pragma unroll
        for (int i = 0; i < W + 7; ++i) { const int dt = i - (W - 1); raw[i] = (tseq + dt >= 0) ? *(const unsigned*)(base + (ptrdiff_t)dt * PLD) : 0u; }
        float s0 = 0.f, s1 = 0.f;
#pragma unroll
        for (int i = 0; i < W - 1; ++i) { s0 += bflo(raw[i]); s1 += bfhi(raw[i]); }
#pragma unroll
        for (int o = 0; o < 8; ++o) { const float u0 = bflo(raw[o + W - 1]), u1 = bfhi(raw[o + W - 1]); s0 += u0; s1 += u1;
            const float inv = 1.f / (float)min(W, tseq + o + 1);
            *(LAS unsigned*)(Ap + (8 * to + o) * PT2 + cp * 4) = cvtpk(s0 * inv - u0, s1 * inv - u1);
            s0 -= bflo(raw[o]); s1 -= bfhi(raw[o]); }
    }
}
__device__ __forceinline__ void pool_unit_mfma(Frame& F, int tile, int gi) {
    LAS unsigned char* Ap = F.lds;
    LAS unsigned char* Wt = F.lds + 33792;
    const int m0 = tile * 64, hh = F.lane >> 5, l31 = F.lane & 31;
    __syncthreads();
    if (m0 < NPR) {
        if (gi == 0) pool_stage_prompt<2>(F, Ap, m0, gi); else if (gi == 1) pool_stage_prompt<4>(F, Ap, m0, gi);
        else if (gi == 2) pool_stage_prompt<8>(F, Ap, m0, gi); else pool_stage_prompt<16>(F, Ap, m0, gi);
    } else {
        const int w = 2 << gi;
        for (int e = F.tid; e < 64 * 256; e += NTHR) { const int t = e >> 8, cc = e & 255, ch = gi * 256 + cc, m = m0 + t, ms = m - NPR, b = ms >> 2, tq = ms & 3;
            float sum = 0.f;
            for (int j = 0; j < w; ++j) { const int tt = tq - j; sum += (tt >= 0) ? bf2f(F.PROJ[(size_t)(m - j) * PLD + ch]) : F.state_pool[(size_t)(b * 15 + 15 + tt) * DPOOL + ch]; }
            const float u0 = bf2f(F.PROJ[(size_t)m * PLD + ch]);
            *(LAS bf16*)(Ap + t * PT2 + cc * 2) = (bf16)f2bf(sum / (float)w - u0); }
    }
    const int ti = F.wave >> 2, di = F.wave & 3;
    for (int dh = 0; dh < 2; ++dh) {
        if (dh) __syncthreads();
        { const bf16* wg = F.PWT + (size_t)(gi * 256 + dh * 128) * 256;
#pragma unroll
          for (int j = 0; j < 8; ++j) { const int idx = F.tid + NTHR * j, d = idx >> 5, seg = idx & 31; *(LAS v4u*)(Wt + d * PT2 + seg * 16) = *(const v4u*)(wg + d * 256 + seg * 8); } }
        __syncthreads();
        f32x16 acc;
#pragma unroll
        for (int i = 0; i < 16; ++i) acc[i] = 0.f;
#pragma unroll
        for (int ks = 0; ks < 16; ++ks) acc = mfma32(*(const LAS s16x8*)(Ap + (32 * ti + l31) * PT2 + ks * 32 + hh * 16), *(const LAS s16x8*)(Wt + (32 * di + l31) * PT2 + ks * 32 + hh * 16), acc);
        const int d = gi * 256 + dh * 128 + 32 * di + l31; const float sc = F.pool_scale[d];
#pragma unroll
        for (int i = 0; i < 16; ++i) { const size_t row = (size_t)(m0 + 32 * ti + (i & 3) + 8 * (i >> 2) + 4 * hh); const float gate = bf2f(F.PROJ[row * PLD + C_GATE + d]);
            F.MIX[row * DMIX + d] = (bf16)f2bf(acc[i] * sc * silu_f(gate)); }
    }
}
__device__ __forceinline__ void sample_unit(Frame& F, int sb, int g) {
    LAS float* T = (LAS float*)F.lds;
    LAS float* dts = T + 2560; LAS float* dec = dts + 24; LAS float* ys = dec + 24; LAS float* red = ys + 1536;
    const int row0 = NPR + sb * 4, p = F.tid >> 3, nq = F.tid & 7;
    f32x4 S[6][4];
#pragma unroll
    for (int r = 0; r < 6; ++r) { const f32x4* sp = (const f32x4*)(F.state_ssm + ((size_t)(sb * NHEAD + 6 * g + r) * HDIM + p) * DSTATE + nq * 16);
#pragma unroll
        for (int q = 0; q < 4; ++q) S[r][q] = sp[q]; }
    __syncthreads();
    for (int e = F.tid; e < 2560; e += NTHR) { const int t = e / 640, c = e - t * 640;
        const int xch = c < 128 ? 3072 + g * 128 + c : (c < 256 ? 4096 + g * 128 + (c - 128) : g * 384 + (c - 256));
        float acc = F.conv_b[xch];
#pragma unroll
        for (int k = 0; k < 4; ++k) { const int tt = t + k - 3;
            const float v = (tt >= 0) ? bf2f(F.PROJ[(size_t)(row0 + tt) * PLD + C_XBC + xch]) : F.state_conv[(size_t)(sb * 3 + 3 + tt) * DCONV + xch];
            acc += v * F.conv_w[k * DCONV + xch]; }
        T[e] = silu_f(acc); }
    if (F.tid < 24) { const int r = F.tid >> 2, t = F.tid & 3, h = 6 * g + r; const float dt = softplus_f(F.DTRAW[(size_t)(row0 + t) * 64 + h] + F.dt_bias[h]);
        dts[F.tid] = dt; dec[F.tid] = __expf(-dt * __expf(F.a_log[h])); }
    __syncthreads();
#pragma unroll
    for (int r = 0; r < 6; ++r) { const int h = 6 * g + r; const float dsk = F.d_skip[h];
#pragma unroll
        for (int t = 0; t < 4; ++t) { const LAS float* row = T + t * 640; const float x = row[256 + r * 64 + p], d = dec[r * 4 + t], dtx = dts[r * 4 + t] * x; float acc = 0.f;
#pragma unroll
            for (int q = 0; q < 4; ++q) { const f32x4 bv = *(const LAS f32x4*)(row + nq * 16 + 4 * q), cv = *(const LAS f32x4*)(row + 128 + nq * 16 + 4 * q);
                S[r][q] = S[r][q] * d + bv * dtx; const f32x4 pr = cv * S[r][q]; acc += (pr.x + pr.y) + (pr.z + pr.w); }
            acc += __shfl_xor(acc, 1); acc += __shfl_xor(acc, 2); acc += __shfl_xor(acc, 4);
            if (nq == 0) ys[t * 384 + r * 64 + p] = acc + dsk * x; }
        f32x4* so = (f32x4*)(F.out + O_SSM_S + ((size_t)(sb * NHEAD + h) * HDIM + p) * DSTATE + nq * 16);
#pragma unroll
        for (int q = 0; q < 4; ++q) so[q] = S[r][q]; }
    __syncthreads();
    { const int t = F.tid >> 7, j = F.tid & 127; float v[3]; float ss = 0.f;
#pragma unroll
      for (int k = 0; k < 3; ++k) { const int idx = j + 128 * k; const float z = bf2f(F.PROJ[(size_t)(row0 + t) * PLD + C_Z + g * 384 + idx]); v[k] = ys[t * 384 + idx] * silu_f(z); ss += v[k] * v[k]; }
      ss = wave_sum(ss); if (F.lane == 0) red[F.wave] = ss;
      __syncthreads();
      const float rstd = 1.f / sqrtf((red[2 * t] + red[2 * t + 1]) * (1.f / 384.f) + EPS);
#pragma unroll
      for (int k = 0; k < 3; ++k) { const int idx = j + 128 * k; F.MIX[(size_t)(row0 + t) * DMIX + DPOOL + g * 384 + idx] = (bf16)f2bf(v[k] * rstd * F.ssm_norm_g[g * 384 + idx]); } }
}

__device__ __forceinline__ void p2_copies(Frame& F) {
    const size_t gt = (size_t)F.bid * NTHR + F.tid, GT = (size_t)F.G * NTHR;
    for (size_t i = gt; i < (size_t)4 * 15 * DPOOL; i += GT) { const int ch = i % DPOOL, r = (i / DPOOL) % 15, b = i / (DPOOL * 15);
        F.out[O_POOL_P + i] = bf2f(F.PROJ[(size_t)(b * 2048 + 2033 + r) * PLD + ch]); }
    for (size_t i = gt; i < (size_t)4 * 3 * DCONV; i += GT) { const int ch = i % DCONV, r = (i / DCONV) % 3, b = i / (DCONV * 3);
        F.out[O_CONV_P + i] = bf2f(F.PROJ[(size_t)(b * 2048 + 2045 + r) * PLD + C_XBC + ch]); }
    for (size_t i = gt; i < (size_t)128 * 15 * DPOOL; i += GT) { const int ch = i % DPOOL, r = (i / DPOOL) % 15, b = i / (DPOOL * 15);
        F.out[O_POOL_S + i] = r < 11 ? F.state_pool[(size_t)(b * 15 + r + 4) * DPOOL + ch] : bf2f(F.PROJ[(size_t)(NPR + b * 4 + r - 11) * PLD + ch]); }
    for (size_t i = gt; i < (size_t)128 * 3 * DCONV; i += GT) { const int ch = i % DCONV, r = (i / DCONV) % 3, b = i / (DCONV * 3);
        F.out[O_CONV_S + i] = bf2f(F.PROJ[(size_t)(NPR + b * 4 + 1 + r) * PLD + C_XBC + ch]); }
}

__device__ __forceinline__ void p3_gate_norm(Frame& F) {
    const int gw = F.bid * NWAVES + F.wave, NGW = F.G * NWAVES;
    for (int task = gw; task < NSM * NGRP; task += NGW) {
        const int m = NPR + (task >> 3), g = task & 7; float v[6]; float ss = 0.f;
#pragma unroll
        for (int k = 0; k < 6; ++k) { const int idx = g * 384 + F.lane + 64 * k; const float y = F.YBUF[(size_t)m * DSSM + idx], z = bf2f(F.PROJ[(size_t)m * PLD + C_Z + idx]);
            v[k] = y * silu_f(z); ss += v[k] * v[k]; }
        const float r = 1.f / sqrtf(wave_sum(ss) * (1.f / 384.f) + EPS);
#pragma unroll
        for (int k = 0; k < 6; ++k) { const int idx = g * 384 + F.lane + 64 * k; F.MIX[(size_t)m * DMIX + DPOOL + idx] = (bf16)f2bf(v[k] * r * F.ssm_norm_g[idx]); }
    }
}
__device__ __forceinline__ void p5_final_norm(Frame& F) {
    const int gw = F.bid * NWAVES + F.wave, NGW = F.G * NWAVES;
    for (int m = gw; m < MROWS; m += NGW) {
        GAS f32x4* yr = (GAS f32x4*)(F.out + O_Y + (size_t)m * DMODEL) + F.lane; const GAS f32x4* gr = (const GAS f32x4*)F.final_g + F.lane;
        f32x4 v[8]; float s = 0.f;
#pragma unroll
        for (int j = 0; j < 8; ++j) { v[j] = yr[64 * j]; s += (v[j].x * v[j].x + v[j].y * v[j].y) + (v[j].z * v[j].z + v[j].w * v[j].w); }
        const float r = 1.f / sqrtf(wave_sum(s) * (1.f / DMODEL) + EPS);
#pragma unroll
        for (int j = 0; j < 8; ++j) { const f32x4 g = gr[64 * j]; yr[64 * j] = (f32x4){v[j].x * r * g.x, v[j].y * r * g.y, v[j].z * r * g.z, v[j].w * r * g.w}; }
    }
}

struct Args { const float* in[17]; float* out; unsigned char* ws; int ph_lo, ph_hi; };
constexpr int N_PHASES = 7;
__global__ void __launch_bounds__(NTHR, 2) fwd(Args args) {
    extern __shared__ __attribute__((aligned(16))) unsigned char lds_raw[];
    Frame F;
    F.lds = (LAS unsigned char*)lds_raw;
    F.tid = threadIdx.x; F.lane = F.tid & 63; F.wave = __builtin_amdgcn_readfirstlane(F.tid >> 6); F.G = gridDim.x; F.bid = blockIdx.x;
    unsigned char* ws = args.ws;
    F.x_prompt = args.in[0]; F.x_sample = args.in[1]; F.state_pool = args.in[2]; F.state_conv = args.in[3]; F.state_ssm = args.in[4]; F.norm_g = args.in[5]; F.w_in = args.in[6];
    F.conv_w = args.in[7]; F.conv_b = args.in[8]; F.dt_bias = args.in[9]; F.a_log = args.in[10]; F.d_skip = args.in[11]; F.ssm_norm_g = args.in[12]; F.pool_w = args.in[13];
    F.pool_scale = args.in[14]; F.w_out = args.in[15]; F.final_g = args.in[16]; F.out = args.out;
    F.XN = (bf16*)(ws + WS_XN); F.WinT = (bf16*)(ws + WS_WINT); F.WoutT = (bf16*)(ws + WS_WOUTT); F.PROJ = (bf16*)(ws + WS_PROJ); F.MIX = (bf16*)(ws + WS_MIX);
    F.DTRAW = (float*)(ws + WS_DTRAW); F.YBUF = (float*)(ws + WS_YBUF); F.ST = (float*)(ws + WS_ST); F.SIN = (bf16*)(ws + WS_SIN); F.CHDEC = (float*)(ws + WS_CHDEC); F.PWT = (bf16*)(ws + WS_PWT);
    for (int u = F.tid; u < (LDS_BYTES - LDSCTL_OFF) / 4; u += NTHR) ((LAS unsigned*)(F.lds + LDSCTL_OFF))[u] = 0u;
    __syncthreads();
    const int lo = args.ph_lo, hi = args.ph_hi;
    XcdBarrier bar; bar.bar = (unsigned*)(ws + WS_CTL) + CW_BAR; bar.x = 0; bar.st = nullptr;
    if (hi - lo > 1) bar = xcd_barrier_post((unsigned*)(ws + WS_CTL) + CW_BAR, (volatile LAS unsigned*)(F.lds + MISC_OFF) + 8);
#define IN(k) (lo <= (k) && (k) < hi)
#define BOTH(k) (IN(k) && IN((k) + 1))
    if (IN(0)) { p0_prologue(F); if (BOTH(0)) xcd_barrier(bar); }
    if (IN(1)) {
        pg8::Gemm g{F.XN, F.WinT, MROWS, NPROJ_PAD, DMODEL}; pg8::StaticOrder S; S.init(MROWS, NPROJ_PAD, F.G, F.bid);
        pg8::EpiProj E{F.PROJ, F.DTRAW};
        pg8::gemm_phase<pg8::EpiProj, pg8::StaticOrder, true, true>(F.lds, g, S, E);
        if (BOTH(1)) xcd_barrier(bar);
    }
    if (IN(2)) {
        for (int u = F.bid; u < 512; u += F.G) p2a_unit(F, u >> 7, (u >> 3) & 15, u & 7);
        for (int u = F.bid; u < 1024; u += F.G) sample_unit(F, u >> 3, u & 7);
        for (int u = F.bid; u < 544; u += F.G) pool_unit_mfma(F, u >> 2, u & 3);
        p2_copies(F);
        if (BOTH(2)) xcd_barrier(bar);
    }
    if (IN(3)) { p2b_scan(F); if (BOTH(3)) xcd_barrier(bar); }
    if (IN(4)) {
        for (int u = F.bid; u < 512; u += F.G) p2c_unit(F, u >> 7, (u >> 3) & 15, u & 7);
        if (BOTH(4)) xcd_barrier(bar);
    }
    if (IN(5)) {
        pg8::Gemm g{F.MIX, F.WoutT, MROWS, DMODEL, DMIX}; pg8::StaticOrder S; S.init(MROWS, DMODEL, F.G, F.bid);
        pg8::EpiOut E{F.x_prompt, F.x_sample, F.out};
        pg8::gemm_phase<pg8::EpiOut, pg8::StaticOrder, true, true>(F.lds, g, S, E);
        if (BOTH(5)) xcd_barrier(bar);
    }
    if (IN(6)) { p5_final_norm(F); }
#undef IN
#undef BOTH
}

#ifndef N_LAUNCHES
#define N_LAUNCHES 1
#endif
extern "C" void kernel_launch(void* const* d_in, const int* in_sizes, int n_in, void* d_out, int out_size, void* d_ws, size_t ws_size, hipStream_t stream) {
    static int grid = 0;
    if (grid == 0) {
        if (n_in != 17 || out_size != 73785344 || ws_size < WS_END) { fprintf(stderr, "kernel_launch: unexpected shapes: n_in %d out %d ws %zu\n", n_in, out_size, ws_size); grid = -1; return; }
        int dev = 0, cus = 0, per_cu = 0;
        if (hipGetDevice(&dev) != hipSuccess || hipDeviceGetAttribute(&cus, hipDeviceAttributeMultiprocessorCount, dev) != hipSuccess) { fprintf(stderr, "kernel_launch: device query failed\n"); grid = -1; return; }
        if (hipFuncSetAttribute((const void*)fwd, hipFuncAttributeMaxDynamicSharedMemorySize, LDS_BYTES) != hipSuccess) { fprintf(stderr, "kernel_launch: hipFuncSetAttribute failed\n"); grid = -1; return; }
        if (hipOccupancyMaxActiveBlocksPerMultiprocessor(&per_cu, (const void*)fwd, NTHR, LDS_BYTES) != hipSuccess || per_cu < 1) { fprintf(stderr, "kernel_launch: occupancy query says %d blocks per CU\n", per_cu); }
        (void)hipGetLastError();
        grid = cus;
    }
    if (grid < 0) return;
    (void)hipMemsetAsync((char*)d_ws + WS_CTL, 0, CTL_ZERO_BYTES, stream);
    Args a{};
    for (int i = 0; i < 17; ++i) a.in[i] = (const float*)d_in[i];
    a.out = (float*)d_out; a.ws = (unsigned char*)d_ws;
    if (N_LAUNCHES == 1) {
        a.ph_lo = 0; a.ph_hi = N_PHASES;
        void* kargs[] = {&a};
        hipError_t e = hipLaunchCooperativeKernel((const void*)fwd, dim3(grid), dim3(NTHR), kargs, LDS_BYTES, stream);
        if (e != hipSuccess) fprintf(stderr, "kernel_launch: cooperative launch failed: %s\n", hipGetErrorString(e));
    } else {
        for (int li = 0; li < N_PHASES; ++li) { a.ph_lo = li; a.ph_hi = li + 1; hipLaunchKernelGGL(fwd, dim3(grid), dim3(NTHR), LDS_BYTES, stream, a); }
    }
}
```

```cpp
#include <hip/hip_runtime.h>
#include <cstdio>
#include <cstdint>
namespace pg8 {
#define PG8_LAS __attribute__((address_space(3)))
typedef unsigned short bf16_t;
typedef short bf16x8 __attribute__((ext_vector_type(8)));
typedef float f32x4 __attribute__((ext_vector_type(4)));
typedef unsigned u32x4 __attribute__((ext_vector_type(4)));
constexpr int BM = 256, BK = 64, HALF = 128, HTB = HALF * BK * 2  , STAGE_BYTES = 8 * HTB, NXCD = 8, WGM = 8;

__host__ __device__ __forceinline__ int lds_byte(int r, int c) { const int st = (r >> 4) * 2 + (c >> 5), rr = r & 15, cc = c & 31, ob = rr * 64 + cc * 2; return st * 1024 + (ob ^ (((ob >> 9) & 1) << 5)); }
__host__ __device__ __forceinline__ void stage_rc(int b, int& R, int& C) { const int st = b / 1024, sb = b % 1024, swz = sb ^ (((sb >> 9) & 1) << 5); R = (st >> 1) * 16 + swz / 64; C = (st & 1) * 32 + (swz % 64) / 2; }
__host__ __device__ __forceinline__ int perm32(int rho) { const int n = rho >> 4, i = rho & 15; return 8 * (i >> 2) + 4 * n + (i & 3); }

struct Unit { int pm, pn; };
struct Gemm { const bf16_t* A; const bf16_t* Bt; int M, N, K; };

struct StaticOrder {
    int nM, nN, nwg, G, c;
    __host__ __device__ void init(int M, int N, int G_, int c_) { nM = M / BM; nN = N / BM; nwg = nM * nN; G = G_; c = c_; }
    __host__ __device__ bool next(int i, Unit& u) const {
        const long L = (long)i * G + c; if (L >= nwg) return false;
        int wgid = (int)L; { const int q = nwg / NXCD, r = nwg % NXCD, xcd = wgid % NXCD, off = wgid / NXCD; wgid = (xcd < r ? xcd * (q + 1) : r * (q + 1) + (xcd - r) * q) + off; }
        const int nig = WGM * nN, gid = wgid / nig, fm = gid * WGM, gsz = (nM - fm) < WGM ? (nM - fm) : WGM;
        u.pm = fm + ((wgid % nig) % gsz); u.pn = (wgid % nig) / gsz; return true;
    }
    __device__ __forceinline__ void a_ready(const Unit&) const {}
    __device__ __forceinline__ void done(const Unit&) const {}
};

__device__ __forceinline__ unsigned cvt_pk_bf16(float lo, float hi) { unsigned r; asm volatile("v_cvt_pk_bf16_f32 %0, %1, %2" : "=v"(r) : "v"(lo), "v"(hi)); return r; }

struct EpiProj {
    static constexpr bool PERM = true, AFTER_DRAIN = false;
    bf16_t* P; float* dtraw;
    __device__ __forceinline__ void operator()(const f32x4 (&acc)[2][2][4][2], const Unit& u, int wr, int wc, int fr, int fq) const {
        const int row0 = u.pm * BM + wr * 64 + fr;
        if (u.pn < 40) {
            const int col0 = u.pn * BM + wc * 32 + 8 * fq;
#pragma unroll
            for (int ai = 0; ai < 2; ++ai)
#pragma unroll
                for (int m = 0; m < 4; ++m) { bf16_t* rowp = P + (size_t)(row0 + ai * HALF + m * 16) * 10240 + col0;
#pragma unroll
                    for (int bj = 0; bj < 2; ++bj) { const f32x4 v0 = acc[ai][bj][m][0], v1 = acc[ai][bj][m][1];
                        u32x4 w; w.x = cvt_pk_bf16(v0[0], v0[1]); w.y = cvt_pk_bf16(v0[2], v0[3]); w.z = cvt_pk_bf16(v1[0], v1[1]); w.w = cvt_pk_bf16(v1[2], v1[3]);
                        *(u32x4*)(rowp + bj * HALF) = w; } }
        } else if (wc < 2) {
#pragma unroll
            for (int ai = 0; ai < 2; ++ai)
#pragma unroll
                for (int m = 0; m < 4; ++m) { float* rp = dtraw + (size_t)(row0 + ai * HALF + m * 16) * 64 + wc * 32 + 8 * fq;
                    *(f32x4*)rp = acc[ai][0][m][0]; *(f32x4*)(rp + 4) = acc[ai][0][m][1]; }
        }
    }
};
struct EpiOut {
    static constexpr bool PERM = false, AFTER_DRAIN = false;
    const float* xp; const float* xs; float* out;
    __device__ __forceinline__ void operator()(const f32x4 (&acc)[2][2][4][2], const Unit& u, int wr, int wc, int fr, int fq) const {
        const int row0 = u.pm * BM + wr * 64 + fr, col0 = u.pn * BM + wc * 32 + 4 * fq;
        const float* xb = (u.pm < 32) ? xp : xs - (size_t)8192 * 2048;
#pragma unroll
        for (int ai = 0; ai < 2; ++ai)
#pragma unroll
            for (int m = 0; m < 4; ++m) { const size_t ro = (size_t)(row0 + ai * HALF + m * 16) * 2048 + col0;
#pragma unroll
                for (int bj = 0; bj < 2; ++bj)
#pragma unroll
                    for (int n = 0; n < 2; ++n) { const f32x4 xv = *(const f32x4*)(xb + ro + bj * HALF + n * 16);
                        *(f32x4*)(out + ro + bj * HALF + n * 16) = xv + acc[ai][bj][m][n]; } }
    }
};

template <class Epi, class Sched, bool ALIGN_EPI = false, bool SP2 = false>
__device__ __forceinline__ void gemm_phase(PG8_LAS unsigned char* lds, const Gemm g, const Sched& S, const Epi& E) {
    const int tid = threadIdx.x, wid = __builtin_amdgcn_readfirstlane(tid >> 6), lane = tid & 63, wr = wid >> 2, wc = wid & 3, fr = lane & 15, fq = lane >> 4;
    const int K = g.K, nt = K / BK;
    unsigned voffA[2], voffB[2];
#pragma unroll
    for (int i = 0; i < 2; ++i) { int R, C; stage_rc(tid * 16 + i * 8192, R, C); const int Rb = Epi::PERM ? ((R & ~31) + perm32(R & 31)) : R;
        voffA[i] = (unsigned)(R * K + C) * 2u; voffB[i] = (unsigned)(Rb * K + C) * 2u; }
    const size_t kstep = (size_t)(BK * 2);
    const size_t hstep = (size_t)HALF * K * 2;
    const size_t tstep = 2 * hstep;
    const unsigned ldsw = (unsigned)wid * 1024u;
    const int aoff = lds_byte(wr * 64 + fr, fq * 8), boff = lds_byte(wc * 32 + fr, fq * 8);
#define PG8_SA(b, h) (((b) * 2 + (h)) * HTB)
#define PG8_SB(b, h) ((4 + (b) * 2 + (h)) * HTB)
#define PG8_STAGE(bufoff, gbase, voff) do { _Pragma("unroll") for (int _i = 0; _i < 2; ++_i) \
        __builtin_amdgcn_global_load_lds((const unsigned*)((const char*)(gbase) + (voff)[_i]), (PG8_LAS unsigned*)(lds + (bufoff) + ldsw + _i * 8192), 16, 0, 0); } while (0)
#define PG8_LDA(dst, b, h) do { _Pragma("unroll") for (int m = 0; m < 4; ++m) _Pragma("unroll") for (int k = 0; k < 2; ++k) dst[m][k] = *(const PG8_LAS bf16x8*)(lds + PG8_SA(b, h) + aoff + m * 2048 + k * 1024); } while (0)
#define PG8_LDB(dst, b, h) do { _Pragma("unroll") for (int n = 0; n < 2; ++n) _Pragma("unroll") for (int k = 0; k < 2; ++k) dst[n][k] = *(const PG8_LAS bf16x8*)(lds + PG8_SB(b, h) + boff + n * 2048 + k * 1024); } while (0)
#define PG8_MMA(ai, bj, At, Bt) do { __builtin_amdgcn_s_setprio(1); _Pragma("unroll") for (int m = 0; m < 4; ++m) _Pragma("unroll") for (int n = 0; n < 2; ++n) _Pragma("unroll") for (int k = 0; k < 2; ++k) \
        acc[ai][bj][m][n] = __builtin_amdgcn_mfma_f32_16x16x32_bf16(Bt[n][k], At[m][k], acc[ai][bj][m][n], 0, 0, 0); __builtin_amdgcn_s_setprio(0); } while (0)
#define PG8_WAIT_V(n) asm volatile("s_waitcnt vmcnt(" #n ")" ::: "memory")
#define PG8_WAIT_L(n) asm volatile("s_waitcnt lgkmcnt(" #n ")" ::: "memory")
#define PG8_BAR __builtin_amdgcn_s_barrier()
#define PG8_SCHED __builtin_amdgcn_sched_barrier(0)
    Unit cur, nxt; int ui = 0;
    if (!S.next(0, cur)) return;
    f32x4 acc[2][2][4][2];
#pragma unroll
    for (int a = 0; a < 2; ++a)
#pragma unroll
        for (int b = 0; b < 2; ++b)
#pragma unroll
            for (int m = 0; m < 4; ++m)
#pragma unroll
                for (int n = 0; n < 2; ++n) acc[a][b][m][n] = (f32x4){0.f, 0.f, 0.f, 0.f};
    bf16x8 At[4][2], B0[2][2], B1[2][2];
    const char* cA = (const char*)g.A + (size_t)cur.pm * tstep; const char* cB = (const char*)g.Bt + (size_t)cur.pn * tstep;
    S.a_ready(cur);
    if constexpr (SP2) {
        PG8_STAGE(PG8_SB(0, 0), cB, voffB); PG8_STAGE(PG8_SB(0, 1), cB + hstep, voffB); PG8_STAGE(PG8_SA(0, 0), cA, voffA); PG8_STAGE(PG8_SA(0, 1), cA + hstep, voffA);
        if (wr == 1) PG8_BAR;
        PG8_WAIT_V(2); PG8_BAR;
        PG8_STAGE(PG8_SB(1, 0), cB + kstep, voffB); PG8_STAGE(PG8_SA(1, 0), cA + kstep, voffA); PG8_STAGE(PG8_SB(1, 1), cB + hstep + kstep, voffB);
        PG8_WAIT_V(6); PG8_BAR;
    } else {
        PG8_STAGE(PG8_SB(0, 0), cB, voffB); PG8_STAGE(PG8_SA(0, 0), cA, voffA); PG8_STAGE(PG8_SB(0, 1), cB + hstep, voffB); PG8_STAGE(PG8_SA(0, 1), cA + hstep, voffA);
        if (wr == 1) PG8_BAR;
        PG8_WAIT_V(4); PG8_BAR;
        PG8_STAGE(PG8_SB(1, 0), cB + kstep, voffB); PG8_STAGE(PG8_SA(1, 0), cA + kstep, voffA); PG8_STAGE(PG8_SB(1, 1), cB + hstep + kstep, voffB);
        PG8_WAIT_V(6); PG8_BAR;
    }
    for (;;) {
        const bool has_next = S.next(ui + 1, nxt);
        const char* nA = has_next ? (const char*)g.A + (size_t)nxt.pm * tstep : cA; const char* nB = has_next ? (const char*)g.Bt + (size_t)nxt.pn * tstep : cB;
        for (int t = 0; t < nt; t += 2) {
            const bool last = (t == nt - 2);
            const char* a1 = cA + (size_t)(t + 1) * kstep;
            const char* a2 = last ? nA : cA + (size_t)(t + 2) * kstep; const char* b2 = last ? nB : cB + (size_t)(t + 2) * kstep;
            const char* a3 = a2 + kstep; const char* b3 = b2 + kstep;
            if (last && has_next) S.a_ready(nxt);
            if constexpr (SP2) {
            PG8_LDB(B0, 0, 0); PG8_LDB(B1, 0, 1); PG8_SCHED; PG8_LDA(At, 0, 0); PG8_STAGE(PG8_SA(1, 1), a1 + hstep, voffA);
            PG8_WAIT_V(8); PG8_WAIT_L(0); PG8_BAR; PG8_MMA(0, 0, At, B0); PG8_MMA(0, 1, At, B1); PG8_BAR; PG8_SCHED;
            PG8_LDA(At, 0, 1); PG8_STAGE(PG8_SB(0, 0), b2, voffB); PG8_STAGE(PG8_SB(0, 1), b2 + hstep, voffB); PG8_STAGE(PG8_SA(0, 0), a2, voffA);
            PG8_WAIT_V(8); PG8_WAIT_L(0); PG8_BAR; PG8_MMA(1, 0, At, B0); PG8_MMA(1, 1, At, B1); PG8_BAR; PG8_SCHED;
            PG8_LDB(B0, 1, 0); PG8_LDB(B1, 1, 1); PG8_SCHED; PG8_LDA(At, 1, 0); PG8_STAGE(PG8_SA(0, 1), a2 + hstep, voffA);
            PG8_WAIT_V(8); PG8_WAIT_L(0); PG8_BAR; PG8_MMA(0, 0, At, B0); PG8_MMA(0, 1, At, B1); PG8_BAR; PG8_SCHED;
            PG8_LDA(At, 1, 1); PG8_STAGE(PG8_SB(1, 0), b3, voffB); PG8_STAGE(PG8_SB(1, 1), b3 + hstep, voffB); PG8_STAGE(PG8_SA(1, 0), a3, voffA);
            PG8_WAIT_V(8); PG8_WAIT_L(0); PG8_BAR; PG8_MMA(1, 0, At, B0); PG8_MMA(1, 1, At, B1); PG8_BAR; PG8_SCHED;
            } else {
            PG8_LDB(B0, 0, 0); PG8_SCHED; PG8_LDA(At, 0, 0); PG8_STAGE(PG8_SA(1, 1), a1 + hstep, voffA);
            PG8_WAIT_L(8); PG8_BAR; PG8_WAIT_L(0); PG8_MMA(0, 0, At, B0); PG8_BAR; PG8_SCHED;
            PG8_LDB(B1, 0, 1); PG8_STAGE(PG8_SB(0, 0), b2, voffB);
            PG8_BAR; PG8_WAIT_L(0); PG8_MMA(0, 1, At, B1); PG8_BAR;
            PG8_LDA(At, 0, 1); PG8_STAGE(PG8_SA(0, 0), a2, voffA);
            PG8_BAR; PG8_WAIT_L(0); PG8_MMA(1, 0, At, B0); PG8_BAR; PG8_SCHED;
            PG8_STAGE(PG8_SB(0, 1), b2 + hstep, voffB);
            PG8_WAIT_V(6); PG8_BAR; PG8_MMA(1, 1, At, B1); PG8_BAR;
            PG8_LDB(B0, 1, 0); PG8_SCHED; PG8_LDA(At, 1, 0); PG8_STAGE(PG8_SA(0, 1), a2 + hstep, voffA);
            PG8_WAIT_L(8); PG8_BAR; PG8_WAIT_L(0); PG8_MMA(0, 0, At, B0); PG8_BAR; PG8_SCHED;
            PG8_LDB(B1, 1, 1); PG8_STAGE(PG8_SB(1, 0), b3, voffB);
            PG8_BAR; PG8_WAIT_L(0); PG8_MMA(0, 1, At, B1); PG8_BAR;
            PG8_LDA(At, 1, 1); PG8_STAGE(PG8_SA(1, 0), a3, voffA);
            PG8_BAR; PG8_WAIT_L(0); PG8_MMA(1, 0, At, B0); PG8_BAR; PG8_SCHED;
            PG8_STAGE(PG8_SB(1, 1), b3 + hstep, voffB);
            PG8_WAIT_V(6); PG8_BAR; PG8_MMA(1, 1, At, B1); PG8_BAR;
            }
        }
        if constexpr (ALIGN_EPI) { if (wr == 0) PG8_BAR; }
        if constexpr (!Epi::AFTER_DRAIN) { E(acc, cur, wr, wc, fr, fq); S.done(cur); }
        if (!has_next) break;
#pragma unroll
        for (int a = 0; a < 2; ++a)
#pragma unroll
            for (int b = 0; b < 2; ++b)
#pragma unroll
                for (int m = 0; m < 4; ++m)
#pragma unroll
                    for (int n = 0; n < 2; ++n) acc[a][b][m][n] = (f32x4){0.f, 0.f, 0.f, 0.f};
        cur = nxt; cA = nA; cB = nB; ++ui;
        if constexpr (ALIGN_EPI) { if (wr == 1) PG8_BAR; }
    }
    PG8_WAIT_V(0);
    if constexpr (!ALIGN_EPI) { if (wr == 0) PG8_BAR; }
    PG8_BAR;
    if constexpr (Epi::AFTER_DRAIN) { E.fused(acc, cur, wr, wc, fr, fq, lds, wid, lane); S.done(cur); }
#undef PG8_SA
#undef PG8_SB
#undef PG8_STAGE
#undef PG8_LDA
#undef PG8_LDB
#undef PG8_MMA
#undef PG8_WAIT_V
#undef PG8_WAIT_L
#undef PG8_BAR
#undef PG8_SCHED
}

}

constexpr int DMODEL = 2048, NPR = 8192  , NSM = 512  , MROWS = NPR + NSM;
constexpr int DPOOL = 1024, DSSM = 3072, DCONV = 5120, NHEAD = 48, HDIM = 64, NGRP = 8, DSTATE = 128, DMIX = 4096;
constexpr int NPROJ = 10288, PLD = 10240  , NPROJ_PAD = 10496  ;
constexpr int C_GATE = 1024, C_Z = 2048, C_XBC = 5120;
constexpr float EPS = 1e-5f;
constexpr size_t O_Y = 0, O_POOL_P = 17825792, O_CONV_P = 17887232, O_SSM_P = 17948672, O_POOL_S = 19521536, O_CONV_S = 21487616, O_SSM_S = 23453696;
constexpr size_t MiB = 1u << 20;
constexpr size_t WS_CTL = 0, CTL_ZERO_BYTES = 1 * MiB;
constexpr size_t WS_XN = 2 * MiB;
constexpr size_t WS_WINT = 36 * MiB;
constexpr size_t WS_WOUTT = 78 * MiB;
constexpr size_t WS_PROJ = 96 * MiB;
constexpr size_t WS_DTRAW = 268 * MiB;
constexpr size_t WS_MIX = 272 * MiB;
constexpr size_t WS_YBUF = 344 * MiB;
constexpr size_t WS_ST = 448 * MiB;
constexpr size_t WS_SIN = 544 * MiB;
constexpr size_t WS_CHDEC = 592 * MiB;
constexpr size_t WS_PWT = 593 * MiB;
constexpr size_t WS_END = 594 * MiB;
constexpr int CW_BAR = 4096;
constexpr int NWAVES = 8, NTHR = 512;
constexpr int RING_BYTES = 131072, LDSCTL_OFF = RING_BYTES, MISC_OFF = LDSCTL_OFF + 320, LDS_BYTES = 147456;

#define GAS __attribute__((address_space(1)))
#define LAS __attribute__((address_space(3)))
typedef unsigned short bf16;
typedef unsigned v4u __attribute__((ext_vector_type(4)));
typedef float f32x4 __attribute__((ext_vector_type(4)));
#define LDS_WAIT() asm volatile("s_waitcnt lgkmcnt(0)" ::: "memory")
#define VM_WAIT() asm volatile("s_waitcnt vmcnt(0)" ::: "memory")
__device__ __forceinline__ unsigned f2bf(float f) { unsigned u = __builtin_bit_cast(unsigned, f); return (u + 0x7fffu + ((u >> 16) & 1u)) >> 16; }
__device__ __forceinline__ unsigned pk2(float lo, float hi) { return f2bf(lo) | (f2bf(hi) << 16); }
__device__ __forceinline__ float bf2f(bf16 v) { return __builtin_bit_cast(float, (unsigned)v << 16); }
__device__ __forceinline__ float silu_f(float x) { return x / (1.f + __expf(-x)); }
__device__ __forceinline__ float softplus_f(float x) { return fmaxf(x, 0.f) + log1pf(__expf(-fabsf(x))); }
__device__ __forceinline__ float wave_sum(float v) {
#pragma unroll
    for (int o = 1; o < 64; o <<= 1) v += __shfl_xor(v, o);
    return v;
}

#define XB_TMO      128
#define XB_XCNT(j)  (256  + 64 * (j))
#define XB_XSUB(j)  (1280 + 64 * (j))
#define XB_XGEN(j)  (2304 + 64 * (j))
#define XB_TOP      3328
#define XB_TOPGEN   3392
#define XCD_BAR_WORDS 3456
#define XB_SPIN_CAP (1u << 18)

__device__ __forceinline__ unsigned xb_ld(unsigned* p)              { return __hip_atomic_load(p, __ATOMIC_RELAXED, __HIP_MEMORY_SCOPE_AGENT); }
__device__ __forceinline__ unsigned xb_add(unsigned* p, unsigned v) { return __hip_atomic_fetch_add(p, v, __ATOMIC_RELAXED, __HIP_MEMORY_SCOPE_AGENT); }
__device__ __forceinline__ unsigned xb_xcc_id() { return (unsigned)__builtin_amdgcn_s_getreg((3 << 11) | 20) & 0xFu; }
#define XB_SPIN(cond, bar) do { unsigned _sp = 0; while (cond) { __builtin_amdgcn_s_sleep(1); \
    if ((++_sp & 255u) == 0u) { if (xb_ld(&(bar)[XB_TMO])) break; if (_sp > XB_SPIN_CAP) { atomicAdd(&(bar)[XB_TMO], 1u); break; } } } } while (0)

struct XcdBarrier {
    unsigned* bar; unsigned x;
    volatile LAS unsigned* st;
};

__device__ __forceinline__ XcdBarrier xcd_barrier_post(unsigned* bar, volatile LAS unsigned* st) {
    XcdBarrier b; b.bar = bar; b.x = xb_xcc_id(); b.st = st;
    if (threadIdx.x == 0) (void)xb_add(&bar[XB_XCNT(b.x)], 1u);
    return b;
}
__device__ __forceinline__ void xcd_barrier_complete(unsigned* bar, unsigned x, unsigned& nloc, unsigned& nx) {
    const unsigned G = gridDim.x * gridDim.y * gridDim.z;
    unsigned sum, cnt, mine, sp = 0u;
    for (;;) {
        sum = 0u; cnt = 0u; mine = 0u;
#pragma unroll
        for (unsigned j = 0; j < 16; ++j) { const unsigned c = xb_ld(&bar[XB_XCNT(j)]); sum += c; cnt += (c > 0u) ? 1u : 0u; mine = (j == x) ? c : mine; }
        if (sum == G) break;
        __builtin_amdgcn_s_sleep(1);
        if ((++sp & 255u) == 0u) { if (xb_ld(&bar[XB_TMO])) break; if (sp > XB_SPIN_CAP) { atomicAdd(&bar[XB_TMO], 1u); break; } }
    }
    nloc = mine > 0u ? mine : 1u; nx = cnt > 0u ? cnt : 1u;
}

__device__ __forceinline__ void xcd_barrier(const XcdBarrier& b) {
    asm volatile("s_waitcnt vmcnt(0)" ::: "memory");
    __syncthreads();
    if (threadIdx.x == 0) {
        unsigned* bar = b.bar;
        __builtin_amdgcn_s_waitcnt(0);
        unsigned nloc = b.st[0], nx = b.st[1];
        if (nloc == 0u) { xcd_barrier_complete(bar, b.x, nloc, nx); b.st[0] = nloc; b.st[1] = nx; }
        const unsigned old = xb_add(&bar[XB_XSUB(b.x)], 1u);
        const unsigned gen = old / nloc;
        if (old + 1u == (gen + 1u) * nloc) {
            __builtin_amdgcn_fence(__ATOMIC_RELEASE, "agent");
            asm volatile("s_waitcnt vmcnt(0)" ::: "memory");
            const unsigned og = xb_add(&bar[XB_TOP], 1u);
            const unsigned tg = og / nx;
            if (og + 1u == (tg + 1u) * nx) xb_add(&bar[XB_TOPGEN], 1u);
            else XB_SPIN(xb_ld(&bar[XB_TOPGEN]) == tg, bar);
            __builtin_amdgcn_fence(__ATOMIC_ACQUIRE, "agent");
            xb_add(&bar[XB_XGEN(b.x)], 1u);
            asm volatile("s_waitcnt vmcnt(0)" ::: "memory");
        } else {
            XB_SPIN(xb_ld(&bar[XB_XGEN(b.x)]) == gen, bar);
            __builtin_amdgcn_fence(__ATOMIC_ACQUIRE, "agent");
            asm volatile("s_waitcnt vmcnt(0)" ::: "memory");
        }
    }
    __syncthreads();
}


struct Args { const float* in[17]; float* out; unsigned char* ws; int ph_lo, ph_hi; };
struct Frame {
    LAS unsigned char* lds;
    int tid, lane, wave, G, bid;
    const Args& A;
    __device__ __forceinline__ const float* x_prompt() const { return A.in[0]; }
    __device__ __forceinline__ const float* x_sample() const { return A.in[1]; }
    __device__ __forceinline__ const float* state_pool() const { return A.in[2]; }
    __device__ __forceinline__ const float* state_conv() const { return A.in[3]; }
    __device__ __forceinline__ const float* state_ssm() const { return A.in[4]; }
    __device__ __forceinline__ const float* norm_g() const { return A.in[5]; }
    __device__ __forceinline__ const float* w_in() const { return A.in[6]; }
    __device__ __forceinline__ const float* conv_w() const { return A.in[7]; }
    __device__ __forceinline__ const float* conv_b() const { return A.in[8]; }
    __device__ __forceinline__ const float* dt_bias() const { return A.in[9]; }
    __device__ __forceinline__ const float* a_log() const { return A.in[10]; }
    __device__ __forceinline__ const float* d_skip() const { return A.in[11]; }
    __device__ __forceinline__ const float* ssm_norm_g() const { return A.in[12]; }
    __device__ __forceinline__ const float* pool_w() const { return A.in[13]; }
    __device__ __forceinline__ const float* pool_scale() const { return A.in[14]; }
    __device__ __forceinline__ const float* w_out() const { return A.in[15]; }
    __device__ __forceinline__ const float* final_g() const { return A.in[16]; }
    __device__ __forceinline__ bf16* XN() const { return (bf16*)(A.ws + WS_XN); }
    __device__ __forceinline__ bf16* WinT() const { return (bf16*)(A.ws + WS_WINT); }
    __device__ __forceinline__ bf16* WoutT() const { return (bf16*)(A.ws + WS_WOUTT); }
    __device__ __forceinline__ bf16* PROJ() const { return (bf16*)(A.ws + WS_PROJ); }
    __device__ __forceinline__ bf16* MIX() const { return (bf16*)(A.ws + WS_MIX); }
    __device__ __forceinline__ bf16* SIN() const { return (bf16*)(A.ws + WS_SIN); }
    __device__ __forceinline__ bf16* PWT() const { return (bf16*)(A.ws + WS_PWT); }
    __device__ __forceinline__ float* DTRAW() const { return (float*)(A.ws + WS_DTRAW); }
    __device__ __forceinline__ float* YBUF() const { return (float*)(A.ws + WS_YBUF); }
    __device__ __forceinline__ float* ST() const { return (float*)(A.ws + WS_ST); }
    __device__ __forceinline__ float* CHDEC() const { return (float*)(A.ws + WS_CHDEC); }
    __device__ __forceinline__ float* out() const { return A.out; }
};

__device__ __forceinline__ void p0_transpose_item(const float* W, int K, int N, bf16* WT, LAS float* scr, int item, int lane) {
    const int nblk = (N + 31) / 32, kb = item / nblk, nb = item % nblk, k0 = 64 * kb, n0 = 32 * nb;
    const bool ok = (n0 + (lane & 31)) < N;
    float tv[32];
#pragma unroll
    for (int i = 0; i < 32; ++i) { const int kk = 2 * i + (lane >> 5); tv[i] = ok ? W[(size_t)(k0 + kk) * N + n0 + (lane & 31)] : 0.f; }
#pragma unroll
    for (int i = 0; i < 32; ++i) { const int kk = 2 * i + (lane >> 5); scr[kk * 33 + (lane & 31)] = tv[i]; }
    LDS_WAIT(); asm volatile("" ::: "memory");
    const int c = lane & 7;
#pragma unroll
    for (int j = 0; j < 4; ++j) { const int n = (lane >> 3) + 8 * j; const LAS float* s = scr + (8 * c) * 33 + n;
        v4u o; o.x = pk2(s[0 * 33], s[1 * 33]); o.y = pk2(s[2 * 33], s[3 * 33]); o.z = pk2(s[4 * 33], s[5 * 33]); o.w = pk2(s[6 * 33], s[7 * 33]);
        *(GAS v4u*)(WT + (size_t)(n0 + n) * K + k0 + 8 * c) = o; }
    LDS_WAIT(); asm volatile("" ::: "memory");
}
__device__ __forceinline__ void p0_prologue(Frame& F) {
    LAS float* scr = (LAS float*)(F.lds + F.wave * 16384);
    const int gw = F.bid * NWAVES + F.wave, NGW = F.G * NWAVES;
    constexpr int I_IN = (DMODEL / 64) * ((NPROJ + 31) / 32), I_OUT = (DMIX / 64) * (DMODEL / 32);
    for (int it = gw; it < I_IN + I_OUT + 128; it += NGW) {
        if (it < I_IN) p0_transpose_item(F.w_in(), DMODEL, NPROJ, F.WinT(), scr, it, F.lane);
        else if (it < I_IN + I_OUT) p0_transpose_item(F.w_out(), DMIX, DMODEL, F.WoutT(), scr, it - I_IN, F.lane);
        else { const int j = it - I_IN - I_OUT; p0_transpose_item(F.pool_w() + (size_t)(j >> 5) * 65536, 256, 256, F.PWT() + (size_t)(j >> 5) * 65536, scr, j & 31, F.lane); }
    }
    { const size_t z0 = (size_t)10304 * DMODEL * 2, z1 = (size_t)NPROJ_PAD * DMODEL * 2; GAS v4u* zp = (GAS v4u*)((unsigned char*)F.WinT() + z0);
      const size_t nz = (z1 - z0) / 16; for (size_t i = (size_t)F.bid * NTHR + F.tid; i < nz; i += (size_t)F.G * NTHR) zp[i] = (v4u){0u, 0u, 0u, 0u}; }
    for (int m = gw; m < MROWS; m += NGW) {
        const float* xrow = (m < NPR) ? F.x_prompt() + (size_t)m * DMODEL : F.x_sample() + (size_t)(m - NPR) * DMODEL;
        const GAS f32x4* xr = (const GAS f32x4*)xrow + F.lane; const GAS f32x4* gr = (const GAS f32x4*)F.norm_g() + F.lane;
        f32x4 v[8]; float s = 0.f;
#pragma unroll
        for (int j = 0; j < 8; ++j) { v[j] = xr[64 * j]; s += (v[j].x * v[j].x + v[j].y * v[j].y) + (v[j].z * v[j].z + v[j].w * v[j].w); }
        const float r = 1.f / sqrtf(wave_sum(s) * (1.f / DMODEL) + EPS);
        GAS unsigned long long* o8 = (GAS unsigned long long*)(F.XN() + (size_t)m * DMODEL) + F.lane;
#pragma unroll
        for (int j = 0; j < 8; ++j) { const f32x4 g = gr[64 * j]; o8[64 * j] = (unsigned long long)pk2(v[j].x * r * g.x, v[j].y * r * g.y) | ((unsigned long long)pk2(v[j].z * r * g.z, v[j].w * r * g.w) << 32); }
    }
}

__device__ __forceinline__ void pool_unit(Frame& F, int tile, int gi) {
    LAS float* pooled = (LAS float*)F.lds;
    const int w = 2 << gi, m0 = tile * 32, c = F.tid & 255, th = F.tid >> 8, ch = gi * 256 + c;
    for (int i = 0; i < 16; ++i) {
        const int t = th * 16 + i, m = m0 + t; const bool prompt = m < NPR;
        int b, tq, cnt; if (prompt) { b = m >> 11; tq = m & 2047; cnt = min(w, tq + 1); } else { const int ms = m - NPR; b = ms >> 2; tq = ms & 3; cnt = w; }
        float sum = 0.f;
        for (int j = 0; j < w; ++j) { const int tt = tq - j; float v;
            if (tt >= 0) v = bf2f(F.PROJ()[(size_t)(m - j) * PLD + ch]); else v = prompt ? 0.f : F.state_pool()[(size_t)(b * 15 + 15 + tt) * DPOOL + ch];
            sum += v; }
        const float u0 = bf2f(F.PROJ()[(size_t)m * PLD + ch]);
        pooled[t * 256 + c] = sum / (float)cnt - u0;
    }
    __syncthreads();
    float acc[16];
#pragma unroll
    for (int i = 0; i < 16; ++i) acc[i] = 0.f;
    const float* W = F.pool_w() + (size_t)gi * 65536 + c;
    for (int c4 = 0; c4 < 64; ++c4) {
        const float w0 = W[(size_t)(4 * c4 + 0) * 256], w1 = W[(size_t)(4 * c4 + 1) * 256], w2 = W[(size_t)(4 * c4 + 2) * 256], w3 = W[(size_t)(4 * c4 + 3) * 256];
#pragma unroll
        for (int i = 0; i < 16; ++i) { const f32x4 p4 = *(const LAS f32x4*)(pooled + (th * 16 + i) * 256 + 4 * c4); acc[i] += (p4.x * w0 + p4.y * w1) + (p4.z * w2 + p4.w * w3); }
    }
    const float sc = F.pool_scale()[ch];
#pragma unroll
    for (int i = 0; i < 16; ++i) { const int m = m0 + th * 16 + i; const float gate = bf2f(F.PROJ()[(size_t)m * PLD + C_GATE + ch]);
        F.MIX()[(size_t)m * DMIX + ch] = (bf16)f2bf(acc[i] * sc * silu_f(gate)); }
    __syncthreads();
}

__device__ __forceinline__ void ssd_unit(Frame& F, int seq, int h) {
    const bool prompt = seq < 4; const int L = prompt ? 2048 : 4, sb = seq - 4, row0 = prompt ? seq * 2048 : NPR + sb * 4, g = h / 6;
    const int p = F.tid >> 3, nq = F.tid & 7;
    LAS float* T = (LAS float*)F.lds;
    LAS float* dts = T + 32 * 320; LAS float* dec = dts + 32;
    float S[16];
    if (prompt) {
#pragma unroll
        for (int j = 0; j < 16; ++j) S[j] = 0.f;
    } else { const f32x4* sp = (const f32x4*)(F.state_ssm() + ((size_t)(sb * NHEAD + h) * HDIM + p) * DSTATE + nq * 16);
#pragma unroll
        for (int q = 0; q < 4; ++q) { const f32x4 v = sp[q]; S[4 * q] = v.x; S[4 * q + 1] = v.y; S[4 * q + 2] = v.z; S[4 * q + 3] = v.w; } }
    const float a = -__expf(F.a_log()[h]), dtb = F.dt_bias()[h], dsk = F.d_skip()[h];
    for (int t0 = 0; t0 < L; t0 += 32) {
        const int nt = min(32, L - t0);
        __syncthreads();
        for (int e = F.tid; e < nt * 320; e += NTHR) {
            const int t = e / 320, c = e - t * 320;
            const int xch = c < 64 ? h * 64 + c : (c < 192 ? 3072 + g * 128 + (c - 64) : 4096 + g * 128 + (c - 192));
            float acc = F.conv_b()[xch];
#pragma unroll
            for (int k = 0; k < 4; ++k) { const int tt = t0 + t + k - 3; float v;
                if (tt >= 0) v = bf2f(F.PROJ()[(size_t)(row0 + tt) * PLD + C_XBC + xch]); else v = prompt ? 0.f : F.state_conv()[(size_t)(sb * 3 + 3 + tt) * DCONV + xch];
                acc += v * F.conv_w()[k * DCONV + xch]; }
            T[e] = silu_f(acc);
        }
        for (int t = F.tid; t < nt; t += NTHR) { const float dt = softplus_f(F.DTRAW()[(size_t)(row0 + t0 + t) * 64 + h] + dtb); dts[t] = dt; dec[t] = __expf(dt * a); }
        __syncthreads();
        for (int t = 0; t < nt; ++t) {
            const LAS float* r = T + t * 320;
            const float x = r[p], d = dec[t], dtx = dts[t] * x; float acc = 0.f;
#pragma unroll
            for (int q = 0; q < 4; ++q) { const f32x4 bv = *(const LAS f32x4*)(r + 64 + nq * 16 + 4 * q), cv = *(const LAS f32x4*)(r + 192 + nq * 16 + 4 * q);
                S[4 * q] = d * S[4 * q] + dtx * bv.x; S[4 * q + 1] = d * S[4 * q + 1] + dtx * bv.y; S[4 * q + 2] = d * S[4 * q + 2] + dtx * bv.z; S[4 * q + 3] = d * S[4 * q + 3] + dtx * bv.w;
                acc += (cv.x * S[4 * q] + cv.y * S[4 * q + 1]) + (cv.z * S[4 * q + 2] + cv.w * S[4 * q + 3]); }
            acc += __shfl_xor(acc, 1); acc += __shfl_xor(acc, 2); acc += __shfl_xor(acc, 4);
            if (nq == 0) F.YBUF()[(size_t)(row0 + t0 + t) * DSSM + h * 64 + p] = acc + dsk * x;
        }
    }
    float* so = F.out() + (prompt ? O_SSM_P + ((size_t)(seq * NHEAD + h) * HDIM + p) * DSTATE : O_SSM_S + ((size_t)(sb * NHEAD + h) * HDIM + p) * DSTATE) + nq * 16;
#pragma unroll
    for (int q = 0; q < 4; ++q) *(f32x4*)(so + 4 * q) = (f32x4){S[4 * q], S[4 * q + 1], S[4 * q + 2], S[4 * q + 3]};
    __syncthreads();
}


typedef short s16x8 __attribute__((ext_vector_type(8)));
typedef float f32x16 __attribute__((ext_vector_type(16)));
typedef unsigned u32x2 __attribute__((ext_vector_type(2)));
typedef float f32x2 __attribute__((ext_vector_type(2)));
constexpr int PT = 272;
__device__ __forceinline__ unsigned cvtpk(float lo, float hi) { return pg8::cvt_pk_bf16(lo, hi); }
__device__ __forceinline__ float bflo(unsigned w) { return __builtin_bit_cast(float, w << 16); }
__device__ __forceinline__ float bfhi(unsigned w) { return __builtin_bit_cast(float, w & 0xffff0000u); }
__device__ __forceinline__ f32x16 mfma32(s16x8 a, s16x8 b, f32x16 c) { return __builtin_amdgcn_mfma_f32_32x32x16_bf16(a, b, c, 0, 0, 0); }
__device__ __forceinline__ s16x8 ldfrag(const LAS unsigned char* img, int row, int ks, int hh) { return *(const LAS s16x8*)(img + row * PT + ks * 32 + hh * 16); }
__device__ __forceinline__ void conv8x2(const Frame& F, int seq_row0, int t0, int xch, float (&o0)[8], float (&o1)[8]) {
    unsigned raw[11];
    const bf16* base = F.PROJ() + (size_t)seq_row0 * PLD + C_XBC + xch;
#pragma unroll
    for (int i = 0; i < 11; ++i) { const int t = t0 - 3 + i; raw[i] = (t >= 0) ? *(const unsigned*)(base + (size_t)t * PLD) : 0u; }
    f32x2 w[4];
#pragma unroll
    for (int k = 0; k < 4; ++k) w[k] = *(const f32x2*)(F.conv_w() + k * DCONV + xch);
    const f32x2 bb = *(const f32x2*)(F.conv_b() + xch);
#pragma unroll
    for (int o = 0; o < 8; ++o) { float a0 = bb.x, a1 = bb.y;
#pragma unroll
        for (int k = 0; k < 4; ++k) { a0 += bflo(raw[o + k]) * w[k].x; a1 += bfhi(raw[o + k]) * w[k].y; }
        o0[o] = silu_f(a0); o1[o] = silu_f(a1); }
}
__device__ __forceinline__ v4u pack8(const float (&o)[8]) { v4u r; r.x = cvtpk(o[0], o[1]); r.y = cvtpk(o[2], o[3]); r.z = cvtpk(o[4], o[5]); r.w = cvtpk(o[6], o[7]); return r; }
__device__ __forceinline__ void chunk_dt(const Frame& F, int row0, int g, LAS float* dtl, LAS float* Ac) {
    if (F.wave < 6) {
        const int h = 6 * g + F.wave; const float a = -__expf(F.a_log()[h]), bias = F.dt_bias()[h]; const int l0 = 2 * F.lane;
        const float d0 = softplus_f(F.DTRAW()[(size_t)(row0 + l0) * 64 + h] + bias), d1 = softplus_f(F.DTRAW()[(size_t)(row0 + l0 + 1) * 64 + h] + bias);
        const float e0 = d0 * a, e1 = d1 * a; float s = e0 + e1;
#pragma unroll
        for (int o = 1; o < 64; o <<= 1) { const float u = __shfl_up(s, o); if (F.lane >= o) s += u; }
        dtl[F.wave * 128 + l0] = d0; dtl[F.wave * 128 + l0 + 1] = d1; Ac[F.wave * 128 + l0] = s - e1; Ac[F.wave * 128 + l0 + 1] = s;
    }
}
__device__ __forceinline__ void p2a_unit(Frame& F, int b, int c, int g) {
    LAS unsigned char* XwT = F.lds;
    LAS unsigned char* BT = F.lds + 52224;
    LAS float* dtl = (LAS float*)(F.lds + 87040); LAS float* Ac = (LAS float*)(F.lds + 90112);
    const int seq_row0 = b * 2048, tok0 = c * 128, row0 = seq_row0 + tok0, hh = F.lane >> 5, l31 = F.lane & 31;
    __syncthreads();
    chunk_dt(F, row0, g, dtl, Ac);
    for (int it = F.tid; it < 1024; it += NTHR) { const int cp = it & 63, to = it >> 6; float o0[8], o1[8];
        conv8x2(F, seq_row0, tok0 + 8 * to, 3072 + g * 128 + 2 * cp, o0, o1);
        *(LAS v4u*)(BT + (2 * cp) * PT + to * 16) = pack8(o0); *(LAS v4u*)(BT + (2 * cp + 1) * PT + to * 16) = pack8(o1); }
    __syncthreads();
    if (F.tid < 6) F.CHDEC()[(size_t)(b * 16 + c) * NHEAD + 6 * g + F.tid] = __expf(Ac[F.tid * 128 + 127]);
    for (int half = 0; half < 2; ++half) {
        if (half) __syncthreads();
        for (int it = F.tid; it < 1536; it += NTHR) { const int cp = it % 96, to = it / 96, ch = 2 * cp, rl = ch >> 6, p = ch & 63, r = 3 * half + rl; float o0[8], o1[8];
            conv8x2(F, seq_row0, tok0 + 8 * to, (6 * g + r) * 64 + p, o0, o1);
            const float aend = Ac[r * 128 + 127];
#pragma unroll
            for (int o = 0; o < 8; ++o) { const float wl = __expf(aend - Ac[r * 128 + 8 * to + o]) * dtl[r * 128 + 8 * to + o]; o0[o] *= wl; o1[o] *= wl; }
            *(LAS v4u*)(XwT + (rl * 64 + p) * PT + to * 16) = pack8(o0); *(LAS v4u*)(XwT + (rl * 64 + p + 1) * PT + to * 16) = pack8(o1); }
        __syncthreads();
        const int pi = F.wave >> 2, ni = F.wave & 3;
        for (int rl = 0; rl < 3; ++rl) {
            f32x16 acc;
#pragma unroll
            for (int i = 0; i < 16; ++i) acc[i] = 0.f;
#pragma unroll
            for (int ks = 0; ks < 8; ++ks) acc = mfma32(ldfrag(XwT, rl * 64 + 32 * pi + l31, ks, hh), ldfrag(BT, 32 * ni + l31, ks, hh), acc);
            const int h = 6 * g + 3 * half + rl;
            float* so = F.ST() + ((size_t)((b * 16 + c) * NHEAD + h) * HDIM) * DSTATE + 32 * ni + l31;
#pragma unroll
            for (int i = 0; i < 16; ++i) { const int p = 32 * pi + (i & 3) + 8 * (i >> 2) + 4 * hh; so[(size_t)p * DSTATE] = acc[i]; }
        }
    }
}
__device__ __forceinline__ void p2b_scan(Frame& F) {
    const int gt = F.bid * NTHR + F.tid, GT = F.G * NTHR;
    for (int i = gt; i < 4 * NHEAD * 2048; i += GT) {
        const int b = i / (NHEAD * 2048), rem = i - b * (NHEAD * 2048), h = rem >> 11, e = rem & 2047;
        f32x4 st[16];
#pragma unroll
        for (int c = 0; c < 16; ++c) st[c] = *((const f32x4*)F.ST() + ((size_t)((b * 16 + c) * NHEAD + h) * 2048 + e));
        f32x4 s = (f32x4){0.f, 0.f, 0.f, 0.f};
#pragma unroll
        for (int c = 0; c < 16; ++c) {
            u32x2 pk; pk.x = cvtpk(s.x, s.y); pk.y = cvtpk(s.z, s.w);
            *((u32x2*)F.SIN() + ((size_t)((b * 16 + c) * NHEAD + h) * 2048 + e)) = pk;
            const float d = F.CHDEC()[(size_t)(b * 16 + c) * NHEAD + h];
            s = s * d + st[c];
        }
        *((f32x4*)(F.out() + O_SSM_P) + ((size_t)(b * NHEAD + h) * 2048 + e)) = s;
    }
}
__device__ __forceinline__ void p2c_unit(Frame& F, int b, int c, int g) {
    LAS unsigned char* Cn = F.lds;
    LAS unsigned char* Bn = F.lds + 34816;
    LAS unsigned char* XT = F.lds + 69632;
    LAS unsigned char* Sin = F.lds + 87040;
    LAS float* dtl = (LAS float*)(F.lds + 104448); LAS float* Ac = (LAS float*)(F.lds + 107520);
    LAS float* part = (LAS float*)(F.lds + 69632);
    LAS float* rs = (LAS float*)(F.lds + 110592);
    const int seq_row0 = b * 2048, tok0 = c * 128, row0 = seq_row0 + tok0, hh = F.lane >> 5, l31 = F.lane & 31;
    const int li = F.wave >> 1, sh = F.wave & 1, pj = F.wave & 1;
    __syncthreads();
    chunk_dt(F, row0, g, dtl, Ac);
    for (int it = F.tid; it < 2048; it += NTHR) { const int isC = it >> 10, cp = it & 63, to = (it >> 6) & 15; float o0[8], o1[8];
        conv8x2(F, seq_row0, tok0 + 8 * to, 3072 + isC * 1024 + g * 128 + 2 * cp, o0, o1);
        LAS unsigned char* img = (isC ? Cn : Bn) + (8 * to) * PT + cp * 4;
#pragma unroll
        for (int o = 0; o < 8; ++o) *(LAS unsigned*)(img + o * PT) = cvtpk(o0[o], o1[o]); }
    __syncthreads();
    f32x16 gt0, gt1;
#pragma unroll
    for (int i = 0; i < 16; ++i) { gt0[i] = 0.f; gt1[i] = 0.f; }
    if (2 * sh <= li) {
#pragma unroll
        for (int ks = 0; ks < 8; ++ks) gt0 = mfma32(ldfrag(Bn, 64 * sh + l31, ks, hh), ldfrag(Cn, 32 * li + l31, ks, hh), gt0);
    }
    if (2 * sh + 1 <= li) {
#pragma unroll
        for (int ks = 0; ks < 8; ++ks) gt1 = mfma32(ldfrag(Bn, 64 * sh + 32 + l31, ks, hh), ldfrag(Cn, 32 * li + l31, ks, hh), gt1);
    }
    float ss[16];
#pragma unroll
    for (int i = 0; i < 16; ++i) ss[i] = 0.f;
    for (int r = 0; r < 6; ++r) {
        const int h = 6 * g + r;
        __syncthreads();
        { const int cp = F.tid & 31, to = F.tid >> 5; float o0[8], o1[8];
          conv8x2(F, seq_row0, tok0 + 8 * to, h * 64 + 2 * cp, o0, o1);
          *(LAS v4u*)(XT + (2 * cp) * PT + to * 16) = pack8(o0); *(LAS v4u*)(XT + (2 * cp + 1) * PT + to * 16) = pack8(o1); }
        { const bf16* sg = F.SIN() + ((size_t)((b * 16 + c) * NHEAD + h) * HDIM) * DSTATE;
#pragma unroll
          for (int j = 0; j < 2; ++j) { const int idx = F.tid + NTHR * j, p = idx >> 4, seg = idx & 15; *(LAS v4u*)(Sin + p * PT + seg * 16) = *(const v4u*)(sg + p * DSTATE + seg * 8); } }
        { const int l = 32 * li + l31; const float Al = Ac[r * 128 + l];
#pragma unroll
          for (int tsel = 0; tsel < 2; ++tsel) { const int si = 2 * sh + tsel;
            if (si <= li) {
#pragma unroll
                for (int q = 0; q < 4; ++q) { const int s0 = 32 * si + 8 * q + 4 * hh;
                    const f32x4 As4 = *(const LAS f32x4*)(Ac + r * 128 + s0), dt4 = *(const LAS f32x4*)(dtl + r * 128 + s0); float v[4];
#pragma unroll
                    for (int j = 0; j < 4; ++j) { const float gv = tsel ? gt1[4 * q + j] : gt0[4 * q + j]; const float e = __expf(fminf(Al - As4[j], 0.f)); v[j] = (s0 + j <= l) ? gv * e * dt4[j] : 0.f; }
                    u32x2 pk; pk.x = cvtpk(v[0], v[1]); pk.y = cvtpk(v[2], v[3]);
                    *(LAS u32x2*)(Bn + l * PT + s0 * 2) = pk; } } } }
        __syncthreads();
        f32x16 acc;
#pragma unroll
        for (int i = 0; i < 16; ++i) acc[i] = 0.f;
#pragma unroll
        for (int ks = 0; ks < 8; ++ks) acc = mfma32(ldfrag(Cn, 32 * li + l31, ks, hh), ldfrag(Sin, 32 * pj + l31, ks, hh), acc);
#pragma unroll
        for (int q = 0; q < 4; ++q) { const f32x4 A4 = *(const LAS f32x4*)(Ac + r * 128 + 32 * li + 8 * q + 4 * hh);
#pragma unroll
            for (int j = 0; j < 4; ++j) acc[4 * q + j] *= __expf(A4[j]); }
        for (int ks = 0; ks < 2 * (li + 1); ++ks) acc = mfma32(ldfrag(Bn, 32 * li + l31, ks, hh), ldfrag(XT, 32 * pj + l31, ks, hh), acc);
        const float dsk = F.d_skip()[h]; const int pcol = h * 64 + 32 * pj + l31;
#pragma unroll
        for (int q = 0; q < 4; ++q) { const int l0 = 32 * li + 8 * q + 4 * hh; const u32x2 x4 = *(const LAS u32x2*)(XT + (32 * pj + l31) * PT + l0 * 2);
            const float xv[4] = {bflo(x4.x), bfhi(x4.x), bflo(x4.y), bfhi(x4.y)};
#pragma unroll
            for (int j = 0; j < 4; ++j) { const size_t row = (size_t)(row0 + l0 + j); const float z = bf2f(F.PROJ()[row * PLD + C_Z + pcol]);
                const float yz = (acc[4 * q + j] + dsk * xv[j]) * silu_f(z); ss[4 * q + j] += yz * yz; F.MIX()[row * DMIX + DPOOL + pcol] = (bf16)f2bf(yz); } }
    }
    VM_WAIT(); __syncthreads();
#pragma unroll
    for (int i = 0; i < 16; ++i) { const int l = 32 * li + (i & 3) + 8 * (i >> 2) + 4 * hh; part[l * 64 + 32 * pj + l31] = ss[i]; }
    __syncthreads();
    if (F.tid < 128) { float s = 0.f;
#pragma unroll
        for (int j = 0; j < 16; ++j) { const f32x4 v = *(const LAS f32x4*)(part + F.tid * 64 + 4 * j); s += (v.x + v.y) + (v.z + v.w); }
        rs[F.tid] = 1.f / sqrtf(s * (1.f / 384.f) + EPS); }
    __syncthreads();
    for (int it = F.tid; it < 128 * 48; it += NTHR) { const int l = it / 48, k8 = it - l * 48; const float rv = rs[l];
        bf16* mp = F.MIX() + (size_t)(row0 + l) * DMIX + DPOOL + g * 384 + 8 * k8; const v4u raw = *(const v4u*)mp;
        const f32x4 g0 = *(const f32x4*)(F.ssm_norm_g() + g * 384 + 8 * k8), g1 = *(const f32x4*)(F.ssm_norm_g() + g * 384 + 8 * k8 + 4);
        v4u o; o.x = cvtpk(bflo(raw.x) * rv * g0.x, bfhi(raw.x) * rv * g0.y); o.y = cvtpk(bflo(raw.y) * rv * g0.z, bfhi(raw.y) * rv * g0.w);
        o.z = cvtpk(bflo(raw.z) * rv * g1.x, bfhi(raw.z) * rv * g1.y); o.w = cvtpk(bflo(raw.w) * rv * g1.z, bfhi(raw.w) * rv * g1.w);
        *(v4u*)mp = o; }
}

constexpr int PT2 = 528;
template <int W> __device__ __forceinline__ void pool_stage_prompt(const Frame& F, LAS unsigned char* Ap, int m0, int gi) {
    for (int it = F.tid; it < 1024; it += NTHR) { const int cp = it & 127, to = it >> 7, mrow = m0 + 8 * to, tseq = mrow & 2047;
        const bf16* base = F.PROJ() + (size_t)mrow * PLD + gi * 256 + 2 * cp;
        unsigned raw[W + 7];
#pragma unroll
        for (int i = 0; i < W + 7; ++i) { const int dt = i - (W - 1); raw[i] = (tseq + dt >= 0) ? *(const unsigned*)(base + (ptrdiff_t)dt * PLD) : 0u; }
        float s0 = 0.f, s1 = 0.f;
#pragma unroll
        for (int i = 0; i < W - 1; ++i) { s0 += bflo(raw[i]); s1 += bfhi(raw[i]); }
#pragma unroll
        for (int o = 0; o < 8; ++o) { const float u0 = bflo(raw[o + W - 1]), u1 = bfhi(raw[o + W - 1]); s0 += u0; s1 += u1;
            const float inv = 1.f / (float)min(W, tseq + o + 1);
            *(LAS unsigned*)(Ap + (8 * to + o) * PT2 + cp * 4) = cvtpk(s0 * inv - u0, s1 * inv - u1);
            s0 -= bflo(raw[o]); s1 -= bfhi(raw[o]); }
    }
}
template <int W> __device__ __forceinline__ void pool_stage_sample(const Frame& F, LAS unsigned char* Ap, int m0, int gi) {
    for (int it = F.tid; it < 2048; it += NTHR) { const int cp = it & 127, sq = it >> 7, b = (m0 - NPR) / 4 + sq, ch = gi * 256 + 2 * cp;
        f32x2 hv[W - 1]; unsigned raw[4];
#pragma unroll
        for (int i = 0; i < W - 1; ++i) hv[i] = *(const f32x2*)(F.state_pool() + (size_t)(b * 15 + 15 - (W - 1) + i) * DPOOL + ch);
#pragma unroll
        for (int t = 0; t < 4; ++t) raw[t] = *(const unsigned*)(F.PROJ() + (size_t)(NPR + 4 * b + t) * PLD + ch);
        float e0[W + 3], e1[W + 3];
#pragma unroll
        for (int i = 0; i < W - 1; ++i) { e0[i] = hv[i].x; e1[i] = hv[i].y; }
#pragma unroll
        for (int t = 0; t < 4; ++t) { e0[W - 1 + t] = bflo(raw[t]); e1[W - 1 + t] = bfhi(raw[t]); }
        float s0 = 0.f, s1 = 0.f;
#pragma unroll
        for (int i = 0; i < W - 1; ++i) { s0 += e0[i]; s1 += e1[i]; }
#pragma unroll
        for (int t = 0; t < 4; ++t) { s0 += e0[W - 1 + t]; s1 += e1[W - 1 + t];
            *(LAS unsigned*)(Ap + (4 * sq + t) * PT2 + cp * 4) = cvtpk(s0 * (1.f / W) - e0[W - 1 + t], s1 * (1.f / W) - e1[W - 1 + t]);
            s0 -= e0[t]; s1 -= e1[t]; }
    }
}
__device__ __forceinline__ void pool_unit_mfma(Frame& F, int tile, int gi) {
    LAS unsigned char* Ap = F.lds;
    LAS unsigned char* Wt = F.lds + 33792;
    const int m0 = tile * 64, hh = F.lane >> 5, l31 = F.lane & 31;
    __syncthreads();
    if (m0 < NPR) {
        if (gi == 0) pool_stage_prompt<2>(F, Ap, m0, gi); else if (gi == 1) pool_stage_prompt<4>(F, Ap, m0, gi);
        else if (gi == 2) pool_stage_prompt<8>(F, Ap, m0, gi); else pool_stage_prompt<16>(F, Ap, m0, gi);
    } else {
        if (gi == 0) pool_stage_sample<2>(F, Ap, m0, gi); else if (gi == 1) pool_stage_sample<4>(F, Ap, m0, gi);
        else if (gi == 2) pool_stage_sample<8>(F, Ap, m0, gi); else pool_stage_sample<16>(F, Ap, m0, gi);
    }
    const int ti = F.wave >> 2, di = F.wave & 3;
    for (int dh = 0; dh < 2; ++dh) {
        if (dh) __syncthreads();
        { const bf16* wg = F.PWT() + (size_t)(gi * 256 + dh * 128) * 256;
#pragma unroll
          for (int j = 0; j < 8; ++j) { const int idx = F.tid + NTHR * j, d = idx >> 5, seg = idx & 31; *(LAS v4u*)(Wt + d * PT2 + seg * 16) = *(const v4u*)(wg + d * 256 + seg * 8); } }
        __syncthreads();
        f32x16 acc;
#pragma unroll
        for (int i = 0; i < 16; ++i) acc[i] = 0.f;
#pragma unroll
        for (int ks = 0; ks < 16; ++ks) acc = mfma32(*(const LAS s16x8*)(Ap + (32 * ti + l31) * PT2 + ks * 32 + hh * 16), *(const LAS s16x8*)(Wt + (32 * di + l31) * PT2 + ks * 32 + hh * 16), acc);
        const int d = gi * 256 + dh * 128 + 32 * di + l31; const float sc = F.pool_scale()[d];
#pragma unroll
        for (int i = 0; i < 16; ++i) { const size_t row = (size_t)(m0 + 32 * ti + (i & 3) + 8 * (i >> 2) + 4 * hh); const float gate = bf2f(F.PROJ()[row * PLD + C_GATE + d]);
            F.MIX()[row * DMIX + d] = (bf16)f2bf(acc[i] * sc * silu_f(gate)); }
    }
}
__device__ __forceinline__ void sample_unit(Frame& F, int sb, int g) {
    LAS float* T = (LAS float*)F.lds;
    LAS float* dts = T + 2560; LAS float* dec = dts + 24; LAS float* ys = dec + 24; LAS float* red = ys + 1536;
    const int row0 = NPR + sb * 4, p = F.tid >> 3, nq = F.tid & 7;
    f32x4 S[3][4];
#pragma unroll
    for (int r = 0; r < 2; ++r) { const f32x4* sp = (const f32x4*)(F.state_ssm() + ((size_t)(sb * NHEAD + 6 * g + r) * HDIM + p) * DSTATE + nq * 16);
#pragma unroll
        for (int q = 0; q < 4; ++q) S[r][q] = sp[q]; }
    __syncthreads();
    if (F.tid < 320) { const int c = 2 * F.tid;
        const int xch = c < 128 ? 3072 + g * 128 + c : (c < 256 ? 4096 + g * 128 + (c - 128) : g * 384 + (c - 256));
        f32x2 hv[3], w[4]; unsigned raw[4];
#pragma unroll
        for (int i = 0; i < 3; ++i) hv[i] = *(const f32x2*)(F.state_conv() + (size_t)(sb * 3 + i) * DCONV + xch);
#pragma unroll
        for (int t = 0; t < 4; ++t) raw[t] = *(const unsigned*)(F.PROJ() + (size_t)(row0 + t) * PLD + C_XBC + xch);
#pragma unroll
        for (int k = 0; k < 4; ++k) w[k] = *(const f32x2*)(F.conv_w() + k * DCONV + xch);
        const f32x2 bb = *(const f32x2*)(F.conv_b() + xch);
        float e0[7], e1[7];
#pragma unroll
        for (int i = 0; i < 3; ++i) { e0[i] = hv[i].x; e1[i] = hv[i].y; }
#pragma unroll
        for (int t = 0; t < 4; ++t) { e0[3 + t] = bflo(raw[t]); e1[3 + t] = bfhi(raw[t]); }
#pragma unroll
        for (int t = 0; t < 4; ++t) { float a0 = bb.x, a1 = bb.y;
#pragma unroll
            for (int k = 0; k < 4; ++k) { a0 += e0[t + k] * w[k].x; a1 += e1[t + k] * w[k].y; }
            T[t * 640 + c] = silu_f(a0); T[t * 640 + c + 1] = silu_f(a1); } }
    if (F.tid < 24) { const int r = F.tid >> 2, t = F.tid & 3, h = 6 * g + r; const float dt = softplus_f(F.DTRAW()[(size_t)(row0 + t) * 64 + h] + F.dt_bias()[h]);
        dts[F.tid] = dt; dec[F.tid] = __expf(-dt * __expf(F.a_log()[h])); }
    __syncthreads();
#pragma unroll
    for (int r = 0; r < 6; ++r) { const int h = 6 * g + r, cur = r % 3; const float dsk = F.d_skip()[h];
        if (r + 2 < 6) { const f32x4* sp = (const f32x4*)(F.state_ssm() + ((size_t)(sb * NHEAD + h + 2) * HDIM + p) * DSTATE + nq * 16);
#pragma unroll
            for (int q = 0; q < 4; ++q) S[(r + 2) % 3][q] = sp[q]; }
#pragma unroll
        for (int t = 0; t < 4; ++t) { const LAS float* row = T + t * 640; const float x = row[256 + r * 64 + p], d = dec[r * 4 + t], dtx = dts[r * 4 + t] * x; float acc = 0.f;
#pragma unroll
            for (int q = 0; q < 4; ++q) { const f32x4 bv = *(const LAS f32x4*)(row + nq * 16 + 4 * q), cv = *(const LAS f32x4*)(row + 128 + nq * 16 + 4 * q);
                S[cur][q] = S[cur][q] * d + bv * dtx; const f32x4 pr = cv * S[cur][q]; acc += (pr.x + pr.y) + (pr.z + pr.w); }
            acc += __shfl_xor(acc, 1); acc += __shfl_xor(acc, 2); acc += __shfl_xor(acc, 4);
            if (nq == 0) ys[t * 384 + r * 64 + p] = acc + dsk * x; }
        f32x4* so = (f32x4*)(F.out() + O_SSM_S + ((size_t)(sb * NHEAD + h) * HDIM + p) * DSTATE + nq * 16);
#pragma unroll
        for (int q = 0; q < 4; ++q) so[q] = S[cur][q]; }
    __syncthreads();
    { const int t = F.tid >> 7, j = F.tid & 127; float v[3]; float ss = 0.f;
#pragma unroll
      for (int k = 0; k < 3; ++k) { const int idx = j + 128 * k; const float z = bf2f(F.PROJ()[(size_t)(row0 + t) * PLD + C_Z + g * 384 + idx]); v[k] = ys[t * 384 + idx] * silu_f(z); ss += v[k] * v[k]; }
      ss = wave_sum(ss); if (F.lane == 0) red[F.wave] = ss;
      __syncthreads();
      const float rstd = 1.f / sqrtf((red[2 * t] + red[2 * t + 1]) * (1.f / 384.f) + EPS);
#pragma unroll
      for (int k = 0; k < 3; ++k) { const int idx = j + 128 * k; F.MIX()[(size_t)(row0 + t) * DMIX + DPOOL + g * 384 + idx] = (bf16)f2bf(v[k] * rstd * F.ssm_norm_g()[g * 384 + idx]); } }
}

__device__ __forceinline__ void copy_seg_bf16(const bf16* src, float* dst, int lane) {
    const v4u a = *((const v4u*)src + 2 * lane), b = *((const v4u*)src + 2 * lane + 1); f32x4* d = (f32x4*)dst + 4 * lane;
    d[0] = (f32x4){bflo(a.x), bfhi(a.x), bflo(a.y), bfhi(a.y)}; d[1] = (f32x4){bflo(a.z), bfhi(a.z), bflo(a.w), bfhi(a.w)};
    d[2] = (f32x4){bflo(b.x), bfhi(b.x), bflo(b.y), bfhi(b.y)}; d[3] = (f32x4){bflo(b.z), bfhi(b.z), bflo(b.w), bfhi(b.w)};
}
__device__ __forceinline__ void p2_copies(Frame& F) {
    const int gw = F.bid * NWAVES + F.wave, NGW = F.G * NWAVES;
    constexpr int NPP = 4 * 15, NPS = 128 * 15, NCP = 4 * 3 * 5, NCS = 128 * 3 * 5;
    for (int task = gw; task < NPP + NPS + NCP + NCS; task += NGW) {
        int t = task;
        if (t < NPP) { const int b = t / 15, r = t - b * 15; copy_seg_bf16(F.PROJ() + (size_t)(b * 2048 + 2033 + r) * PLD, F.out() + O_POOL_P + (size_t)t * DPOOL, F.lane); continue; }
        t -= NPP;
        if (t < NPS) { const int b = t / 15, r = t - b * 15; float* dst = F.out() + O_POOL_S + (size_t)t * DPOOL;
            if (r < 11) { const f32x4* sp = (const f32x4*)(F.state_pool() + (size_t)(b * 15 + r + 4) * DPOOL) + 4 * F.lane; f32x4* d = (f32x4*)dst + 4 * F.lane; d[0] = sp[0]; d[1] = sp[1]; d[2] = sp[2]; d[3] = sp[3]; }
            else copy_seg_bf16(F.PROJ() + (size_t)(NPR + b * 4 + r - 11) * PLD, dst, F.lane);
            continue; }
        t -= NPS;
        if (t < NCP) { const int row = t / 5, sg = t - row * 5, b = row / 3, r = row - b * 3;
            copy_seg_bf16(F.PROJ() + (size_t)(b * 2048 + 2045 + r) * PLD + C_XBC + sg * 1024, F.out() + O_CONV_P + (size_t)row * DCONV + sg * 1024, F.lane); continue; }
        t -= NCP;
        { const int row = t / 5, sg = t - row * 5, b = row / 3, r = row - b * 3;
          copy_seg_bf16(F.PROJ() + (size_t)(NPR + b * 4 + 1 + r) * PLD + C_XBC + sg * 1024, F.out() + O_CONV_S + (size_t)row * DCONV + sg * 1024, F.lane); }
    }
}

__device__ __forceinline__ void p3_gate_norm(Frame& F) {
    const int gw = F.bid * NWAVES + F.wave, NGW = F.G * NWAVES;
    for (int task = gw; task < NSM * NGRP; task += NGW) {
        const int m = NPR + (task >> 3), g = task & 7; float v[6]; float ss = 0.f;
#pragma unroll
        for (int k = 0; k < 6; ++k) { const int idx = g * 384 + F.lane + 64 * k; const float y = F.YBUF()[(size_t)m * DSSM + idx], z = bf2f(F.PROJ()[(size_t)m * PLD + C_Z + idx]);
            v[k] = y * silu_f(z); ss += v[k] * v[k]; }
        const float r = 1.f / sqrtf(wave_sum(ss) * (1.f / 384.f) + EPS);
#pragma unroll
        for (int k = 0; k < 6; ++k) { const int idx = g * 384 + F.lane + 64 * k; F.MIX()[(size_t)m * DMIX + DPOOL + idx] = (bf16)f2bf(v[k] * r * F.ssm_norm_g()[idx]); }
    }
}
__device__ __forceinline__ void p5_final_norm(Frame& F) {
    const int gw = F.bid * NWAVES + F.wave, NGW = F.G * NWAVES;
    for (int m = gw; m < MROWS; m += NGW) {
        GAS f32x4* yr = (GAS f32x4*)(F.out() + O_Y + (size_t)m * DMODEL) + F.lane; const GAS f32x4* gr = (const GAS f32x4*)F.final_g() + F.lane;
        f32x4 v[8]; float s = 0.f;
#pragma unroll
        for (int j = 0; j < 8; ++j) { v[j] = yr[64 * j]; s += (v[j].x * v[j].x + v[j].y * v[j].y) + (v[j].z * v[j].z + v[j].w * v[j].w); }
        const float r = 1.f / sqrtf(wave_sum(s) * (1.f / DMODEL) + EPS);
#pragma unroll
        for (int j = 0; j < 8; ++j) { const f32x4 g = gr[64 * j]; yr[64 * j] = (f32x4){v[j].x * r * g.x, v[j].y * r * g.y, v[j].z * r * g.z, v[j].w * r * g.w}; }
    }
}

constexpr int N_PHASES = 10;
__global__ void __launch_bounds__(NTHR, 2) fwd(Args args) {
    extern __shared__ __attribute__((aligned(16))) unsigned char lds_raw[];
    Frame F{(LAS unsigned char*)lds_raw, (int)threadIdx.x, (int)(threadIdx.x & 63), __builtin_amdgcn_readfirstlane((int)(threadIdx.x >> 6)), (int)gridDim.x, (int)blockIdx.x, args};
    unsigned char* ws = args.ws;
    for (int u = F.tid; u < (LDS_BYTES - LDSCTL_OFF) / 4; u += NTHR) ((LAS unsigned*)(F.lds + LDSCTL_OFF))[u] = 0u;
    __syncthreads();
    const int lo = args.ph_lo, hi = args.ph_hi;
    XcdBarrier bar; bar.bar = (unsigned*)(ws + WS_CTL) + CW_BAR; bar.x = 0; bar.st = nullptr;
    if (hi - lo > 1) bar = xcd_barrier_post((unsigned*)(ws + WS_CTL) + CW_BAR, (volatile LAS unsigned*)(F.lds + MISC_OFF) + 8);
#define IN(k) (lo <= (k) && (k) < hi)
#define BOTH(k) (IN(k) && IN((k) + 1))
    if (IN(0)) { p0_prologue(F); if (BOTH(0)) xcd_barrier(bar); }
    if (IN(1)) {
        pg8::Gemm g{F.XN(), F.WinT(), MROWS, NPROJ_PAD, DMODEL}; pg8::StaticOrder S; S.init(MROWS, NPROJ_PAD, F.G, F.bid);
        pg8::EpiProj E{F.PROJ(), F.DTRAW()};
        pg8::gemm_phase<pg8::EpiProj, pg8::StaticOrder, true, true>(F.lds, g, S, E);
        if (BOTH(1)) xcd_barrier(bar);
    }
    if (IN(2)) { for (int u = F.bid; u < 512; u += F.G) p2a_unit(F, u >> 7, (u >> 3) & 15, u & 7); }
    if (IN(3)) { for (int u = F.bid; u < 1024; u += F.G) sample_unit(F, u >> 3, u & 7); }
    if (IN(4)) { for (int u = F.bid; u < 544; u += F.G) pool_unit_mfma(F, u >> 2, u & 3); }
    if (IN(5)) { p2_copies(F); if (BOTH(5)) xcd_barrier(bar); }
    if (IN(6)) { p2b_scan(F); if (BOTH(6)) xcd_barrier(bar); }
    if (IN(7)) { for (int u = F.bid; u < 512; u += F.G) p2c_unit(F, u >> 7, (u >> 3) & 15, u & 7); if (BOTH(7)) xcd_barrier(bar); }
    if (IN(8)) {
        pg8::Gemm g{F.MIX(), F.WoutT(), MROWS, DMODEL, DMIX}; pg8::StaticOrder S; S.init(MROWS, DMODEL, F.G, F.bid);
        pg8::EpiOut E{F.x_prompt(), F.x_sample(), F.out()};
        pg8::gemm_phase<pg8::EpiOut, pg8::StaticOrder, true, true>(F.lds, g, S, E);
        if (BOTH(8)) xcd_barrier(bar);
    }
    if (IN(9)) { p5_final_norm(F); }
#undef IN
#undef BOTH
}

#ifndef N_LAUNCHES
#define N_LAUNCHES 1
#endif
extern "C" void kernel_launch(void* const* d_in, const int* in_sizes, int n_in, void* d_out, int out_size, void* d_ws, size_t ws_size, hipStream_t stream) {
    static int grid = 0;
    if (grid == 0) {
        if (n_in != 17 || out_size != 73785344 || ws_size < WS_END) { fprintf(stderr, "kernel_launch: unexpected shapes: n_in %d out %d ws %zu\n", n_in, out_size, ws_size); grid = -1; return; }
        int dev = 0, cus = 0, per_cu = 0;
        if (hipGetDevice(&dev) != hipSuccess || hipDeviceGetAttribute(&cus, hipDeviceAttributeMultiprocessorCount, dev) != hipSuccess) { fprintf(stderr, "kernel_launch: device query failed\n"); grid = -1; return; }
        if (hipFuncSetAttribute((const void*)fwd, hipFuncAttributeMaxDynamicSharedMemorySize, LDS_BYTES) != hipSuccess) { fprintf(stderr, "kernel_launch: hipFuncSetAttribute failed\n"); grid = -1; return; }
        if (hipOccupancyMaxActiveBlocksPerMultiprocessor(&per_cu, (const void*)fwd, NTHR, LDS_BYTES) != hipSuccess || per_cu < 1) { fprintf(stderr, "kernel_launch: occupancy query says %d blocks per CU\n", per_cu); }
        (void)hipGetLastError();
        grid = cus;
    }
    if (grid < 0) return;
    (void)hipMemsetAsync((char*)d_ws + WS_CTL, 0, CTL_ZERO_BYTES, stream);
    Args a{};
    for (int i = 0; i < 17; ++i) a.in[i] = (const float*)d_in[i];
    a.out = (float*)d_out; a.ws = (unsigned char*)d_ws;
    if (N_LAUNCHES == 1) {
        a.ph_lo = 0; a.ph_hi = N_PHASES;
        void* kargs[] = {&a};
        hipError_t e = hipLaunchCooperativeKernel((const void*)fwd, dim3(grid), dim3(NTHR), kargs, LDS_BYTES, stream);
        if (e != hipSuccess) fprintf(stderr, "kernel_launch: cooperative launch failed: %s\n", hipGetErrorString(e));
#ifdef PROBE_PHASE
        a.ph_lo = PROBE_PHASE; a.ph_hi = PROBE_PHASE + 1; hipLaunchKernelGGL(fwd, dim3(grid), dim3(NTHR), LDS_BYTES, stream, a);
#ifdef PROBE_PHASE2
        a.ph_lo = PROBE_PHASE2; a.ph_hi = PROBE_PHASE2 + 1; hipLaunchKernelGGL(fwd, dim3(grid), dim3(NTHR), LDS_BYTES, stream, a);
#endif
#endif
    } else {
        for (int li = 0; li < N_PHASES; ++li) { a.ph_lo = li; a.ph_hi = li + 1; hipLaunchKernelGGL(fwd, dim3(grid), dim3(NTHR), LDS_BYTES, stream, a); }
    }
}
```

```cpp
#include <hip/hip_runtime.h>
#include <cstdio>
#include <cstdint>
namespace pg8 {
#define PG8_LAS __attribute__((address_space(3)))
typedef unsigned short bf16_t;
typedef short bf16x8 __attribute__((ext_vector_type(8)));
typedef float f32x4 __attribute__((ext_vector_type(4)));
typedef unsigned u32x4 __attribute__((ext_vector_type(4)));
constexpr int BM = 256, BK = 64, HALF = 128, HTB = HALF * BK * 2  , STAGE_BYTES = 8 * HTB, NXCD = 8, WGM = 8;

__host__ __device__ __forceinline__ int lds_byte(int r, int c) { const int st = (r >> 4) * 2 + (c >> 5), rr = r & 15, cc = c & 31, ob = rr * 64 + cc * 2; return st * 1024 + (ob ^ (((ob >> 9) & 1) << 5)); }
__host__ __device__ __forceinline__ void stage_rc(int b, int& R, int& C) { const int st = b / 1024, sb = b % 1024, swz = sb ^ (((sb >> 9) & 1) << 5); R = (st >> 1) * 16 + swz / 64; C = (st & 1) * 32 + (swz % 64) / 2; }
__host__ __device__ __forceinline__ int perm32(int rho) { const int n = rho >> 4, i = rho & 15; return 8 * (i >> 2) + 4 * n + (i & 3); }

struct Unit { int pm, pn, k0, nt; };
struct Gemm { const bf16_t* A; const bf16_t* Bt; int M, N, K; };

struct StaticOrder {
    int nM, nN, nwg, G, c, ntk;
    __host__ __device__ void init(int M, int N, int K, int G_, int c_) { nM = M / BM; nN = N / BM; nwg = nM * nN; G = G_; c = c_; ntk = K / BK; }
    __host__ __device__ bool next(int i, Unit& u) const {
        const long L = (long)i * G + c; if (L >= nwg) return false;
        int wgid = (int)L; { const int q = nwg / NXCD, r = nwg % NXCD, xcd = wgid % NXCD, off = wgid / NXCD; wgid = (xcd < r ? xcd * (q + 1) : r * (q + 1) + (xcd - r) * q) + off; }
        const int nig = WGM * nN, gid = wgid / nig, fm = gid * WGM, gsz = (nM - fm) < WGM ? (nM - fm) : WGM;
        u.pm = fm + ((wgid % nig) % gsz); u.pn = (wgid % nig) / gsz; u.k0 = 0; u.nt = ntk; return true;
    }
    __device__ __forceinline__ void a_ready(const Unit&) const {}
    __device__ __forceinline__ void done(const Unit&) const {}
};

__device__ __forceinline__ unsigned cvt_pk_bf16(float lo, float hi) { unsigned r; asm volatile("v_cvt_pk_bf16_f32 %0, %1, %2" : "=v"(r) : "v"(lo), "v"(hi)); return r; }

struct EpiProj {
    static constexpr bool PERM = true, AFTER_DRAIN = false;
    bf16_t* P; float* dtraw;
    __device__ __forceinline__ void operator()(const f32x4 (&acc)[2][2][4][2], const Unit& u, int wr, int wc, int fr, int fq) const {
        const int row0 = u.pm * BM + wr * 64 + fr;
        if (u.pn < 40) {
            const int col0 = u.pn * BM + wc * 32 + 8 * fq;
#pragma unroll
            for (int ai = 0; ai < 2; ++ai)
#pragma unroll
                for (int m = 0; m < 4; ++m) { bf16_t* rowp = P + (size_t)(row0 + ai * HALF + m * 16) * 10240 + col0;
#pragma unroll
                    for (int bj = 0; bj < 2; ++bj) { const f32x4 v0 = acc[ai][bj][m][0], v1 = acc[ai][bj][m][1];
                        u32x4 w; w.x = cvt_pk_bf16(v0[0], v0[1]); w.y = cvt_pk_bf16(v0[2], v0[3]); w.z = cvt_pk_bf16(v1[0], v1[1]); w.w = cvt_pk_bf16(v1[2], v1[3]);
                        *(u32x4*)(rowp + bj * HALF) = w; } }
        } else if (wc < 2) {
#pragma unroll
            for (int ai = 0; ai < 2; ++ai)
#pragma unroll
                for (int m = 0; m < 4; ++m) { float* rp = dtraw + (size_t)(row0 + ai * HALF + m * 16) * 64 + wc * 32 + 8 * fq;
                    *(f32x4*)rp = acc[ai][0][m][0]; *(f32x4*)(rp + 4) = acc[ai][0][m][1]; }
        }
    }
};
struct EpiOut {
    static constexpr bool PERM = false, AFTER_DRAIN = false;
    const float* xp; const float* xs; float* out;
    __device__ __forceinline__ void operator()(const f32x4 (&acc)[2][2][4][2], const Unit& u, int wr, int wc, int fr, int fq) const {
        const int row0 = u.pm * BM + wr * 64 + fr, col0 = u.pn * BM + wc * 32 + 4 * fq;
        const float* xb = (u.pm < 32) ? xp : xs - (size_t)8192 * 2048;
#pragma unroll
        for (int ai = 0; ai < 2; ++ai)
#pragma unroll
            for (int m = 0; m < 4; ++m) { const size_t ro = (size_t)(row0 + ai * HALF + m * 16) * 2048 + col0;
#pragma unroll
                for (int bj = 0; bj < 2; ++bj)
#pragma unroll
                    for (int n = 0; n < 2; ++n) { const f32x4 xv = *(const f32x4*)(xb + ro + bj * HALF + n * 16);
                        *(f32x4*)(out + ro + bj * HALF + n * 16) = xv + acc[ai][bj][m][n]; } }
    }
};

struct EpiOut2 {
    static constexpr bool PERM = false, AFTER_DRAIN = false;
    const float* xp; float* out; float* slab;
    __device__ __forceinline__ void operator()(const f32x4 (&acc)[2][2][4][2], const Unit& u, int wr, int wc, int fr, int fq) const {
        const int row0 = u.pm * BM + wr * 64 + fr, col0 = u.pn * BM + wc * 32 + 4 * fq;
        if (u.pm < 32) {
#pragma unroll
            for (int ai = 0; ai < 2; ++ai)
#pragma unroll
                for (int m = 0; m < 4; ++m) { const size_t ro = (size_t)(row0 + ai * HALF + m * 16) * 2048 + col0;
#pragma unroll
                    for (int bj = 0; bj < 2; ++bj)
#pragma unroll
                        for (int n = 0; n < 2; ++n) { const f32x4 xv = *(const f32x4*)(xp + ro + bj * HALF + n * 16);
                            *(f32x4*)(out + ro + bj * HALF + n * 16) = xv + acc[ai][bj][m][n]; } }
        } else {
            float* sl = slab + (size_t)(u.k0 >> 8) * (512 * 2048) - (size_t)8192 * 2048;
#pragma unroll
            for (int ai = 0; ai < 2; ++ai)
#pragma unroll
                for (int m = 0; m < 4; ++m) { const size_t ro = (size_t)(row0 + ai * HALF + m * 16) * 2048 + col0;
#pragma unroll
                    for (int bj = 0; bj < 2; ++bj)
#pragma unroll
                        for (int n = 0; n < 2; ++n) *(f32x4*)(sl + ro + bj * HALF + n * 16) = acc[ai][bj][m][n]; }
        }
    }
};
struct OutOrder {
    int c;
    __device__ __forceinline__ bool next(int i, Unit& u) const {
        if (i == 0) { const int x = c & 7, j = c >> 3; u.pm = 4 * x + (j & 3); u.pn = j >> 2; u.k0 = 0; u.nt = 64; return true; }
        if (i == 1) { const int tile = c >> 4, sl = c & 15; u.pm = 32 + (tile >> 3); u.pn = tile & 7; u.k0 = sl * 256; u.nt = 4; return true; }
        return false;
    }
    __device__ __forceinline__ void a_ready(const Unit&) const {}
    __device__ __forceinline__ void done(const Unit&) const {}
};

template <class Epi, class Sched, bool ALIGN_EPI = false, bool SP2 = false>
__device__ __forceinline__ void gemm_phase(PG8_LAS unsigned char* lds, const Gemm g, const Sched& S, const Epi& E) {
    const int tid = threadIdx.x, wid = __builtin_amdgcn_readfirstlane(tid >> 6), lane = tid & 63, wr = wid >> 2, wc = wid & 3, fr = lane & 15, fq = lane >> 4;
    const int K = g.K;
    unsigned voffA[2], voffB[2];
#pragma unroll
    for (int i = 0; i < 2; ++i) { int R, C; stage_rc(tid * 16 + i * 8192, R, C); const int Rb = Epi::PERM ? ((R & ~31) + perm32(R & 31)) : R;
        voffA[i] = (unsigned)(R * K + C) * 2u; voffB[i] = (unsigned)(Rb * K + C) * 2u; }
    const size_t kstep = (size_t)(BK * 2);
    const size_t hstep = (size_t)HALF * K * 2;
    const size_t tstep = 2 * hstep;
    const unsigned ldsw = (unsigned)wid * 1024u;
    const int aoff = lds_byte(wr * 64 + fr, fq * 8), boff = lds_byte(wc * 32 + fr, fq * 8);
#define PG8_SA(b, h) (((b) * 2 + (h)) * HTB)
#define PG8_SB(b, h) ((4 + (b) * 2 + (h)) * HTB)
#define PG8_STAGE(bufoff, gbase, voff) do { _Pragma("unroll") for (int _i = 0; _i < 2; ++_i) \
        __builtin_amdgcn_global_load_lds((const unsigned*)((const char*)(gbase) + (voff)[_i]), (PG8_LAS unsigned*)(lds + (bufoff) + ldsw + _i * 8192), 16, 0, 0); } while (0)
#define PG8_LDA(dst, b, h) do { _Pragma("unroll") for (int m = 0; m < 4; ++m) _Pragma("unroll") for (int k = 0; k < 2; ++k) dst[m][k] = *(const PG8_LAS bf16x8*)(lds + PG8_SA(b, h) + aoff + m * 2048 + k * 1024); } while (0)
#define PG8_LDB(dst, b, h) do { _Pragma("unroll") for (int n = 0; n < 2; ++n) _Pragma("unroll") for (int k = 0; k < 2; ++k) dst[n][k] = *(const PG8_LAS bf16x8*)(lds + PG8_SB(b, h) + boff + n * 2048 + k * 1024); } while (0)
#define PG8_MMA(ai, bj, At, Bt) do { __builtin_amdgcn_s_setprio(1); _Pragma("unroll") for (int m = 0; m < 4; ++m) _Pragma("unroll") for (int n = 0; n < 2; ++n) _Pragma("unroll") for (int k = 0; k < 2; ++k) \
        acc[ai][bj][m][n] = __builtin_amdgcn_mfma_f32_16x16x32_bf16(Bt[n][k], At[m][k], acc[ai][bj][m][n], 0, 0, 0); __builtin_amdgcn_s_setprio(0); } while (0)
#define PG8_WAIT_V(n) asm volatile("s_waitcnt vmcnt(" #n ")" ::: "memory")
#define PG8_WAIT_L(n) asm volatile("s_waitcnt lgkmcnt(" #n ")" ::: "memory")
#define PG8_BAR __builtin_amdgcn_s_barrier()
#define PG8_SCHED __builtin_amdgcn_sched_barrier(0)
    Unit cur, nxt; int ui = 0;
    if (!S.next(0, cur)) return;
    f32x4 acc[2][2][4][2];
#pragma unroll
    for (int a = 0; a < 2; ++a)
#pragma unroll
        for (int b = 0; b < 2; ++b)
#pragma unroll
            for (int m = 0; m < 4; ++m)
#pragma unroll
                for (int n = 0; n < 2; ++n) acc[a][b][m][n] = (f32x4){0.f, 0.f, 0.f, 0.f};
    bf16x8 At[4][2], B0[2][2], B1[2][2];
    const char* cA = (const char*)g.A + (size_t)cur.pm * tstep + (size_t)cur.k0 * 2; const char* cB = (const char*)g.Bt + (size_t)cur.pn * tstep + (size_t)cur.k0 * 2;
    S.a_ready(cur);
    if constexpr (SP2) {
        PG8_STAGE(PG8_SB(0, 0), cB, voffB); PG8_STAGE(PG8_SB(0, 1), cB + hstep, voffB); PG8_STAGE(PG8_SA(0, 0), cA, voffA); PG8_STAGE(PG8_SA(0, 1), cA + hstep, voffA);
        if (wr == 1) PG8_BAR;
        PG8_WAIT_V(2); PG8_BAR;
        PG8_STAGE(PG8_SB(1, 0), cB + kstep, voffB); PG8_STAGE(PG8_SA(1, 0), cA + kstep, voffA); PG8_STAGE(PG8_SB(1, 1), cB + hstep + kstep, voffB);
        PG8_WAIT_V(6); PG8_BAR;
    } else {
        PG8_STAGE(PG8_SB(0, 0), cB, voffB); PG8_STAGE(PG8_SA(0, 0), cA, voffA); PG8_STAGE(PG8_SB(0, 1), cB + hstep, voffB); PG8_STAGE(PG8_SA(0, 1), cA + hstep, voffA);
        if (wr == 1) PG8_BAR;
        PG8_WAIT_V(4); PG8_BAR;
        PG8_STAGE(PG8_SB(1, 0), cB + kstep, voffB); PG8_STAGE(PG8_SA(1, 0), cA + kstep, voffA); PG8_STAGE(PG8_SB(1, 1), cB + hstep + kstep, voffB);
        PG8_WAIT_V(6); PG8_BAR;
    }
    for (;;) {
        const bool has_next = S.next(ui + 1, nxt);
        const char* nA = has_next ? (const char*)g.A + (size_t)nxt.pm * tstep + (size_t)nxt.k0 * 2 : cA; const char* nB = has_next ? (const char*)g.Bt + (size_t)nxt.pn * tstep + (size_t)nxt.k0 * 2 : cB;
        const int nt = cur.nt;
        for (int t = 0; t < nt; t += 2) {
            const bool last = (t == nt - 2);
            const char* a1 = cA + (size_t)(t + 1) * kstep;
            const char* a2 = last ? nA : cA + (size_t)(t + 2) * kstep; const char* b2 = last ? nB : cB + (size_t)(t + 2) * kstep;
            const char* a3 = a2 + kstep; const char* b3 = b2 + kstep;
            if (last && has_next) S.a_ready(nxt);
            if constexpr (SP2) {
            PG8_LDB(B0, 0, 0); PG8_LDB(B1, 0, 1); PG8_SCHED; PG8_LDA(At, 0, 0); PG8_STAGE(PG8_SA(1, 1), a1 + hstep, voffA);
            PG8_WAIT_V(8); PG8_WAIT_L(0); PG8_BAR; PG8_MMA(0, 0, At, B0); PG8_MMA(0, 1, At, B1); PG8_BAR; PG8_SCHED;
            PG8_LDA(At, 0, 1); PG8_STAGE(PG8_SB(0, 0), b2, voffB); PG8_STAGE(PG8_SB(0, 1), b2 + hstep, voffB); PG8_STAGE(PG8_SA(0, 0), a2, voffA);
            PG8_WAIT_V(8); PG8_WAIT_L(0); PG8_BAR; PG8_MMA(1, 0, At, B0); PG8_MMA(1, 1, At, B1); PG8_BAR; PG8_SCHED;
            PG8_LDB(B0, 1, 0); PG8_LDB(B1, 1, 1); PG8_SCHED; PG8_LDA(At, 1, 0); PG8_STAGE(PG8_SA(0, 1), a2 + hstep, voffA);
            PG8_WAIT_V(8); PG8_WAIT_L(0); PG8_BAR; PG8_MMA(0, 0, At, B0); PG8_MMA(0, 1, At, B1); PG8_BAR; PG8_SCHED;
            PG8_LDA(At, 1, 1); PG8_STAGE(PG8_SB(1, 0), b3, voffB); PG8_STAGE(PG8_SB(1, 1), b3 + hstep, voffB); PG8_STAGE(PG8_SA(1, 0), a3, voffA);
            PG8_WAIT_V(8); PG8_WAIT_L(0); PG8_BAR; PG8_MMA(1, 0, At, B0); PG8_MMA(1, 1, At, B1); PG8_BAR; PG8_SCHED;
            } else {
            PG8_LDB(B0, 0, 0); PG8_SCHED; PG8_LDA(At, 0, 0); PG8_STAGE(PG8_SA(1, 1), a1 + hstep, voffA);
            PG8_WAIT_L(8); PG8_BAR; PG8_WAIT_L(0); PG8_MMA(0, 0, At, B0); PG8_BAR; PG8_SCHED;
            PG8_LDB(B1, 0, 1); PG8_STAGE(PG8_SB(0, 0), b2, voffB);
            PG8_BAR; PG8_WAIT_L(0); PG8_MMA(0, 1, At, B1); PG8_BAR;
            PG8_LDA(At, 0, 1); PG8_STAGE(PG8_SA(0, 0), a2, voffA);
            PG8_BAR; PG8_WAIT_L(0); PG8_MMA(1, 0, At, B0); PG8_BAR; PG8_SCHED;
            PG8_STAGE(PG8_SB(0, 1), b2 + hstep, voffB);
            PG8_WAIT_V(6); PG8_BAR; PG8_MMA(1, 1, At, B1); PG8_BAR;
            PG8_LDB(B0, 1, 0); PG8_SCHED; PG8_LDA(At, 1, 0); PG8_STAGE(PG8_SA(0, 1), a2 + hstep, voffA);
            PG8_WAIT_L(8); PG8_BAR; PG8_WAIT_L(0); PG8_MMA(0, 0, At, B0); PG8_BAR; PG8_SCHED;
            PG8_LDB(B1, 1, 1); PG8_STAGE(PG8_SB(1, 0), b3, voffB);
            PG8_BAR; PG8_WAIT_L(0); PG8_MMA(0, 1, At, B1); PG8_BAR;
            PG8_LDA(At, 1, 1); PG8_STAGE(PG8_SA(1, 0), a3, voffA);
            PG8_BAR; PG8_WAIT_L(0); PG8_MMA(1, 0, At, B0); PG8_BAR; PG8_SCHED;
            PG8_STAGE(PG8_SB(1, 1), b3 + hstep, voffB);
            PG8_WAIT_V(6); PG8_BAR; PG8_MMA(1, 1, At, B1); PG8_BAR;
            }
        }
        if constexpr (ALIGN_EPI) { if (wr == 0) PG8_BAR; }
        if constexpr (!Epi::AFTER_DRAIN) { E(acc, cur, wr, wc, fr, fq); S.done(cur); }
        if (!has_next) break;
#pragma unroll
        for (int a = 0; a < 2; ++a)
#pragma unroll
            for (int b = 0; b < 2; ++b)
#pragma unroll
                for (int m = 0; m < 4; ++m)
#pragma unroll
                    for (int n = 0; n < 2; ++n) acc[a][b][m][n] = (f32x4){0.f, 0.f, 0.f, 0.f};
        cur = nxt; cA = nA; cB = nB; ++ui;
        if constexpr (ALIGN_EPI) { if (wr == 1) PG8_BAR; }
    }
    PG8_WAIT_V(0);
    if constexpr (!ALIGN_EPI) { if (wr == 0) PG8_BAR; }
    PG8_BAR;
    if constexpr (Epi::AFTER_DRAIN) { E.fused(acc, cur, wr, wc, fr, fq, lds, wid, lane); S.done(cur); }
#undef PG8_SA
#undef PG8_SB
#undef PG8_STAGE
#undef PG8_LDA
#undef PG8_LDB
#undef PG8_MMA
#undef PG8_WAIT_V
#undef PG8_WAIT_L
#undef PG8_BAR
#undef PG8_SCHED
}

}

constexpr int DMODEL = 2048, NPR = 8192  , NSM = 512  , MROWS = NPR + NSM;
constexpr int DPOOL = 1024, DSSM = 3072, DCONV = 5120, NHEAD = 48, HDIM = 64, NGRP = 8, DSTATE = 128, DMIX = 4096;
constexpr int NPROJ = 10288, PLD = 10240  , NPROJ_PAD = 10496  ;
constexpr int C_GATE = 1024, C_Z = 2048, C_XBC = 5120;
constexpr float EPS = 1e-5f;
constexpr size_t O_Y = 0, O_POOL_P = 17825792, O_CONV_P = 17887232, O_SSM_P = 17948672, O_POOL_S = 19521536, O_CONV_S = 21487616, O_SSM_S = 23453696;
constexpr size_t MiB = 1u << 20;
constexpr size_t WS_CTL = 0, CTL_ZERO_BYTES = 1 * MiB;
constexpr size_t WS_XN = 2 * MiB;
constexpr size_t WS_WINT = 36 * MiB;
constexpr size_t WS_WOUTT = 78 * MiB;
constexpr size_t WS_PROJ = 96 * MiB;
constexpr size_t WS_DTRAW = 268 * MiB;
constexpr size_t WS_MIX = 272 * MiB;
constexpr size_t WS_YBUF = 344 * MiB;
constexpr size_t WS_ST = 448 * MiB;
constexpr size_t WS_SIN = 544 * MiB;
constexpr size_t WS_CHDEC = 592 * MiB;
constexpr size_t WS_PWT = 593 * MiB;
constexpr size_t WS_END = 594 * MiB;
constexpr int CW_BAR = 4096;
constexpr int NWAVES = 8, NTHR = 512;
constexpr int RING_BYTES = 131072, LDSCTL_OFF = RING_BYTES, MISC_OFF = LDSCTL_OFF + 320, LDS_BYTES = 147456;

#define GAS __attribute__((address_space(1)))
#define LAS __attribute__((address_space(3)))
typedef unsigned short bf16;
typedef unsigned v4u __attribute__((ext_vector_type(4)));
typedef float f32x4 __attribute__((ext_vector_type(4)));
#define LDS_WAIT() asm volatile("s_waitcnt lgkmcnt(0)" ::: "memory")
#define VM_WAIT() asm volatile("s_waitcnt vmcnt(0)" ::: "memory")
__device__ __forceinline__ unsigned f2bf(float f) { unsigned u = __builtin_bit_cast(unsigned, f); return (u + 0x7fffu + ((u >> 16) & 1u)) >> 16; }
__device__ __forceinline__ unsigned pk2(float lo, float hi) { return f2bf(lo) | (f2bf(hi) << 16); }
__device__ __forceinline__ float bf2f(bf16 v) { return __builtin_bit_cast(float, (unsigned)v << 16); }
__device__ __forceinline__ float silu_f(float x) { return x * __builtin_amdgcn_rcpf(1.f + __expf(-x)); }
__device__ __forceinline__ float softplus_f(float x) { return fmaxf(x, 0.f) + log1pf(__expf(-fabsf(x))); }
__device__ __forceinline__ float wave_sum(float v) {
#pragma unroll
    for (int o = 1; o < 64; o <<= 1) v += __shfl_xor(v, o);
    return v;
}

#define XB_TMO      128
#define XB_XCNT(j)  (256  + 64 * (j))
#define XB_XSUB(j)  (1280 + 64 * (j))
#define XB_XGEN(j)  (2304 + 64 * (j))
#define XB_TOP      3328
#define XB_TOPGEN   3392
#define XCD_BAR_WORDS 3456
#define XB_SPIN_CAP (1u << 18)

__device__ __forceinline__ unsigned xb_ld(unsigned* p)              { return __hip_atomic_load(p, __ATOMIC_RELAXED, __HIP_MEMORY_SCOPE_AGENT); }
__device__ __forceinline__ unsigned xb_add(unsigned* p, unsigned v) { return __hip_atomic_fetch_add(p, v, __ATOMIC_RELAXED, __HIP_MEMORY_SCOPE_AGENT); }
__device__ __forceinline__ unsigned xb_xcc_id() { return (unsigned)__builtin_amdgcn_s_getreg((3 << 11) | 20) & 0xFu; }
#define XB_SPIN(cond, bar) do { unsigned _sp = 0; while (cond) { __builtin_amdgcn_s_sleep(1); \
    if ((++_sp & 255u) == 0u) { if (xb_ld(&(bar)[XB_TMO])) break; if (_sp > XB_SPIN_CAP) { atomicAdd(&(bar)[XB_TMO], 1u); break; } } } } while (0)

struct XcdBarrier {
    unsigned* bar; unsigned x;
    volatile LAS unsigned* st;
};

__device__ __forceinline__ XcdBarrier xcd_barrier_post(unsigned* bar, volatile LAS unsigned* st) {
    XcdBarrier b; b.bar = bar; b.x = xb_xcc_id(); b.st = st;
    if (threadIdx.x == 0) (void)xb_add(&bar[XB_XCNT(b.x)], 1u);
    return b;
}
__device__ __forceinline__ void xcd_barrier_complete(unsigned* bar, unsigned x, unsigned& nloc, unsigned& nx) {
    const unsigned G = gridDim.x * gridDim.y * gridDim.z;
    unsigned sum, cnt, mine, sp = 0u;
    for (;;) {
        sum = 0u; cnt = 0u; mine = 0u;
#pragma unroll
        for (unsigned j = 0; j < 16; ++j) { const unsigned c = xb_ld(&bar[XB_XCNT(j)]); sum += c; cnt += (c > 0u) ? 1u : 0u; mine = (j == x) ? c : mine; }
        if (sum == G) break;
        __builtin_amdgcn_s_sleep(1);
        if ((++sp & 255u) == 0u) { if (xb_ld(&bar[XB_TMO])) break; if (sp > XB_SPIN_CAP) { atomicAdd(&bar[XB_TMO], 1u); break; } }
    }
    nloc = mine > 0u ? mine : 1u; nx = cnt > 0u ? cnt : 1u;
}

__device__ __forceinline__ void xcd_barrier(const XcdBarrier& b) {
    asm volatile("s_waitcnt vmcnt(0)" ::: "memory");
    __syncthreads();
    if (threadIdx.x == 0) {
        unsigned* bar = b.bar;
        __builtin_amdgcn_s_waitcnt(0);
        unsigned nloc = b.st[0], nx = b.st[1];
        if (nloc == 0u) { xcd_barrier_complete(bar, b.x, nloc, nx); b.st[0] = nloc; b.st[1] = nx; }
        const unsigned old = xb_add(&bar[XB_XSUB(b.x)], 1u);
        const unsigned gen = old / nloc;
        if (old + 1u == (gen + 1u) * nloc) {
            __builtin_amdgcn_fence(__ATOMIC_RELEASE, "agent");
            asm volatile("s_waitcnt vmcnt(0)" ::: "memory");
            const unsigned og = xb_add(&bar[XB_TOP], 1u);
            const unsigned tg = og / nx;
            if (og + 1u == (tg + 1u) * nx) xb_add(&bar[XB_TOPGEN], 1u);
            else XB_SPIN(xb_ld(&bar[XB_TOPGEN]) == tg, bar);
            __builtin_amdgcn_fence(__ATOMIC_ACQUIRE, "agent");
            xb_add(&bar[XB_XGEN(b.x)], 1u);
            asm volatile("s_waitcnt vmcnt(0)" ::: "memory");
        } else {
            XB_SPIN(xb_ld(&bar[XB_XGEN(b.x)]) == gen, bar);
            __builtin_amdgcn_fence(__ATOMIC_ACQUIRE, "agent");
            asm volatile("s_waitcnt vmcnt(0)" ::: "memory");
        }
    }
    __syncthreads();
}


struct Args { const float* in[17]; float* out; unsigned char* ws; int ph_lo, ph_hi; };
struct Frame {
    LAS unsigned char* lds;
    int tid, lane, wave, G, bid;
    const Args& A;
    __device__ __forceinline__ const float* x_prompt() const { return A.in[0]; }
    __device__ __forceinline__ const float* x_sample() const { return A.in[1]; }
    __device__ __forceinline__ const float* state_pool() const { return A.in[2]; }
    __device__ __forceinline__ const float* state_conv() const { return A.in[3]; }
    __device__ __forceinline__ const float* state_ssm() const { return A.in[4]; }
    __device__ __forceinline__ const float* norm_g() const { return A.in[5]; }
    __device__ __forceinline__ const float* w_in() const { return A.in[6]; }
    __device__ __forceinline__ const float* conv_w() const { return A.in[7]; }
    __device__ __forceinline__ const float* conv_b() const { return A.in[8]; }
    __device__ __forceinline__ const float* dt_bias() const { return A.in[9]; }
    __device__ __forceinline__ const float* a_log() const { return A.in[10]; }
    __device__ __forceinline__ const float* d_skip() const { return A.in[11]; }
    __device__ __forceinline__ const float* ssm_norm_g() const { return A.in[12]; }
    __device__ __forceinline__ const float* pool_w() const { return A.in[13]; }
    __device__ __forceinline__ const float* pool_scale() const { return A.in[14]; }
    __device__ __forceinline__ const float* w_out() const { return A.in[15]; }
    __device__ __forceinline__ const float* final_g() const { return A.in[16]; }
    __device__ __forceinline__ bf16* XN() const { return (bf16*)(A.ws + WS_XN); }
    __device__ __forceinline__ bf16* WinT() const { return (bf16*)(A.ws + WS_WINT); }
    __device__ __forceinline__ bf16* WoutT() const { return (bf16*)(A.ws + WS_WOUTT); }
    __device__ __forceinline__ bf16* PROJ() const { return (bf16*)(A.ws + WS_PROJ); }
    __device__ __forceinline__ bf16* MIX() const { return (bf16*)(A.ws + WS_MIX); }
    __device__ __forceinline__ bf16* SIN() const { return (bf16*)(A.ws + WS_SIN); }
    __device__ __forceinline__ bf16* PWT() const { return (bf16*)(A.ws + WS_PWT); }
    __device__ __forceinline__ float* DTRAW() const { return (float*)(A.ws + WS_DTRAW); }
    __device__ __forceinline__ float* YBUF() const { return (float*)(A.ws + WS_YBUF); }
    __device__ __forceinline__ float* ST() const { return (float*)(A.ws + WS_ST); }
    __device__ __forceinline__ float* CHDEC() const { return (float*)(A.ws + WS_CHDEC); }
    __device__ __forceinline__ float* out() const { return A.out; }
};

__device__ __forceinline__ void p0_transpose_item(const float* W, int K, int N, bf16* WT, LAS float* scr, int item, int lane) {
    const int nblk = (N + 31) / 32, kb = item / nblk, nb = item % nblk, k0 = 64 * kb, n0 = 32 * nb;
    const bool ok = (n0 + (lane & 31)) < N;
    float tv[32];
#pragma unroll
    for (int i = 0; i < 32; ++i) { const int kk = 2 * i + (lane >> 5); tv[i] = ok ? W[(size_t)(k0 + kk) * N + n0 + (lane & 31)] : 0.f; }
#pragma unroll
    for (int i = 0; i < 32; ++i) { const int kk = 2 * i + (lane >> 5); scr[kk * 33 + (lane & 31)] = tv[i]; }
    LDS_WAIT(); asm volatile("" ::: "memory");
    const int c = lane & 7;
#pragma unroll
    for (int j = 0; j < 4; ++j) { const int n = (lane >> 3) + 8 * j; const LAS float* s = scr + (8 * c) * 33 + n;
        v4u o; o.x = pk2(s[0 * 33], s[1 * 33]); o.y = pk2(s[2 * 33], s[3 * 33]); o.z = pk2(s[4 * 33], s[5 * 33]); o.w = pk2(s[6 * 33], s[7 * 33]);
        *(GAS v4u*)(WT + (size_t)(n0 + n) * K + k0 + 8 * c) = o; }
    LDS_WAIT(); asm volatile("" ::: "memory");
}
__device__ __forceinline__ void p0_prologue(Frame& F) {
    LAS float* scr = (LAS float*)(F.lds + F.wave * 16384);
    const int gw = F.bid * NWAVES + F.wave, NGW = F.G * NWAVES;
    constexpr int I_IN = (DMODEL / 64) * ((NPROJ + 31) / 32), I_OUT = (DMIX / 64) * (DMODEL / 32);
    for (int it = gw; it < I_IN + I_OUT + 128; it += NGW) {
        if (it < I_IN) p0_transpose_item(F.w_in(), DMODEL, NPROJ, F.WinT(), scr, it, F.lane);
        else if (it < I_IN + I_OUT) p0_transpose_item(F.w_out(), DMIX, DMODEL, F.WoutT(), scr, it - I_IN, F.lane);
        else { const int j = it - I_IN - I_OUT; p0_transpose_item(F.pool_w() + (size_t)(j >> 5) * 65536, 256, 256, F.PWT() + (size_t)(j >> 5) * 65536, scr, j & 31, F.lane); }
    }
    { const size_t z0 = (size_t)10304 * DMODEL * 2, z1 = (size_t)NPROJ_PAD * DMODEL * 2; GAS v4u* zp = (GAS v4u*)((unsigned char*)F.WinT() + z0);
      const size_t nz = (z1 - z0) / 16; for (size_t i = (size_t)F.bid * NTHR + F.tid; i < nz; i += (size_t)F.G * NTHR) zp[i] = (v4u){0u, 0u, 0u, 0u}; }
    for (int m = gw; m < MROWS; m += NGW) {
        const float* xrow = (m < NPR) ? F.x_prompt() + (size_t)m * DMODEL : F.x_sample() + (size_t)(m - NPR) * DMODEL;
        const GAS f32x4* xr = (const GAS f32x4*)xrow + F.lane; const GAS f32x4* gr = (const GAS f32x4*)F.norm_g() + F.lane;
        f32x4 v[8]; float s = 0.f;
#pragma unroll
        for (int j = 0; j < 8; ++j) { v[j] = xr[64 * j]; s += (v[j].x * v[j].x + v[j].y * v[j].y) + (v[j].z * v[j].z + v[j].w * v[j].w); }
        const float r = 1.f / sqrtf(wave_sum(s) * (1.f / DMODEL) + EPS);
        GAS unsigned long long* o8 = (GAS unsigned long long*)(F.XN() + (size_t)m * DMODEL) + F.lane;
#pragma unroll
        for (int j = 0; j < 8; ++j) { const f32x4 g = gr[64 * j]; o8[64 * j] = (unsigned long long)pk2(v[j].x * r * g.x, v[j].y * r * g.y) | ((unsigned long long)pk2(v[j].z * r * g.z, v[j].w * r * g.w) << 32); }
    }
}

__device__ __forceinline__ void pool_unit(Frame& F, int tile, int gi) {
    LAS float* pooled = (LAS float*)F.lds;
    const int w = 2 << gi, m0 = tile * 32, c = F.tid & 255, th = F.tid >> 8, ch = gi * 256 + c;
    for (int i = 0; i < 16; ++i) {
        const int t = th * 16 + i, m = m0 + t; const bool prompt = m < NPR;
        int b, tq, cnt; if (prompt) { b = m >> 11; tq = m & 2047; cnt = min(w, tq + 1); } else { const int ms = m - NPR; b = ms >> 2; tq = ms & 3; cnt = w; }
        float sum = 0.f;
        for (int j = 0; j < w; ++j) { const int tt = tq - j; float v;
            if (tt >= 0) v = bf2f(F.PROJ()[(size_t)(m - j) * PLD + ch]); else v = prompt ? 0.f : F.state_pool()[(size_t)(b * 15 + 15 + tt) * DPOOL + ch];
            sum += v; }
        const float u0 = bf2f(F.PROJ()[(size_t)m * PLD + ch]);
        pooled[t * 256 + c] = sum / (float)cnt - u0;
    }
    __syncthreads();
    float acc[16];
#pragma unroll
    for (int i = 0; i < 16; ++i) acc[i] = 0.f;
    const float* W = F.pool_w() + (size_t)gi * 65536 + c;
    for (int c4 = 0; c4 < 64; ++c4) {
        const float w0 = W[(size_t)(4 * c4 + 0) * 256], w1 = W[(size_t)(4 * c4 + 1) * 256], w2 = W[(size_t)(4 * c4 + 2) * 256], w3 = W[(size_t)(4 * c4 + 3) * 256];
#pragma unroll
        for (int i = 0; i < 16; ++i) { const f32x4 p4 = *(const LAS f32x4*)(pooled + (th * 16 + i) * 256 + 4 * c4); acc[i] += (p4.x * w0 + p4.y * w1) + (p4.z * w2 + p4.w * w3); }
    }
    const float sc = F.pool_scale()[ch];
#pragma unroll
    for (int i = 0; i < 16; ++i) { const int m = m0 + th * 16 + i; const float gate = bf2f(F.PROJ()[(size_t)m * PLD + C_GATE + ch]);
        F.MIX()[(size_t)m * DMIX + ch] = (bf16)f2bf(acc[i] * sc * silu_f(gate)); }
    __syncthreads();
}

__device__ __forceinline__ void ssd_unit(Frame& F, int seq, int h) {
    const bool prompt = seq < 4; const int L = prompt ? 2048 : 4, sb = seq - 4, row0 = prompt ? seq * 2048 : NPR + sb * 4, g = h / 6;
    const int p = F.tid >> 3, nq = F.tid & 7;
    LAS float* T = (LAS float*)F.lds;
    LAS float* dts = T + 32 * 320; LAS float* dec = dts + 32;
    float S[16];
    if (prompt) {
#pragma unroll
        for (int j = 0; j < 16; ++j) S[j] = 0.f;
    } else { const f32x4* sp = (const f32x4*)(F.state_ssm() + ((size_t)(sb * NHEAD + h) * HDIM + p) * DSTATE + nq * 16);
#pragma unroll
        for (int q = 0; q < 4; ++q) { const f32x4 v = sp[q]; S[4 * q] = v.x; S[4 * q + 1] = v.y; S[4 * q + 2] = v.z; S[4 * q + 3] = v.w; } }
    const float a = -__expf(F.a_log()[h]), dtb = F.dt_bias()[h], dsk = F.d_skip()[h];
    for (int t0 = 0; t0 < L; t0 += 32) {
        const int nt = min(32, L - t0);
        __syncthreads();
        for (int e = F.tid; e < nt * 320; e += NTHR) {
            const int t = e / 320, c = e - t * 320;
            const int xch = c < 64 ? h * 64 + c : (c < 192 ? 3072 + g * 128 + (c - 64) : 4096 + g * 128 + (c - 192));
            float acc = F.conv_b()[xch];
#pragma unroll
            for (int k = 0; k < 4; ++k) { const int tt = t0 + t + k - 3; float v;
                if (tt >= 0) v = bf2f(F.PROJ()[(size_t)(row0 + tt) * PLD + C_XBC + xch]); else v = prompt ? 0.f : F.state_conv()[(size_t)(sb * 3 + 3 + tt) * DCONV + xch];
                acc += v * F.conv_w()[k * DCONV + xch]; }
            T[e] = silu_f(acc);
        }
        for (int t = F.tid; t < nt; t += NTHR) { const float dt = softplus_f(F.DTRAW()[(size_t)(row0 + t0 + t) * 64 + h] + dtb); dts[t] = dt; dec[t] = __expf(dt * a); }
        __syncthreads();
        for (int t = 0; t < nt; ++t) {
            const LAS float* r = T + t * 320;
            const float x = r[p], d = dec[t], dtx = dts[t] * x; float acc = 0.f;
#pragma unroll
            for (int q = 0; q < 4; ++q) { const f32x4 bv = *(const LAS f32x4*)(r + 64 + nq * 16 + 4 * q), cv = *(const LAS f32x4*)(r + 192 + nq * 16 + 4 * q);
                S[4 * q] = d * S[4 * q] + dtx * bv.x; S[4 * q + 1] = d * S[4 * q + 1] + dtx * bv.y; S[4 * q + 2] = d * S[4 * q + 2] + dtx * bv.z; S[4 * q + 3] = d * S[4 * q + 3] + dtx * bv.w;
                acc += (cv.x * S[4 * q] + cv.y * S[4 * q + 1]) + (cv.z * S[4 * q + 2] + cv.w * S[4 * q + 3]); }
            acc += __shfl_xor(acc, 1); acc += __shfl_xor(acc, 2); acc += __shfl_xor(acc, 4);
            if (nq == 0) F.YBUF()[(size_t)(row0 + t0 + t) * DSSM + h * 64 + p] = acc + dsk * x;
        }
    }
    float* so = F.out() + (prompt ? O_SSM_P + ((size_t)(seq * NHEAD + h) * HDIM + p) * DSTATE : O_SSM_S + ((size_t)(sb * NHEAD + h) * HDIM + p) * DSTATE) + nq * 16;
#pragma unroll
    for (int q = 0; q < 4; ++q) *(f32x4*)(so + 4 * q) = (f32x4){S[4 * q], S[4 * q + 1], S[4 * q + 2], S[4 * q + 3]};
    __syncthreads();
}


typedef short s16x8 __attribute__((ext_vector_type(8)));
typedef float f32x16 __attribute__((ext_vector_type(16)));
typedef unsigned u32x2 __attribute__((ext_vector_type(2)));
typedef float f32x2 __attribute__((ext_vector_type(2)));
constexpr int PT = 272;
__device__ __forceinline__ unsigned cvtpk(float lo, float hi) { return pg8::cvt_pk_bf16(lo, hi); }
__device__ __forceinline__ float bflo(unsigned w) { return __builtin_bit_cast(float, w << 16); }
__device__ __forceinline__ float bfhi(unsigned w) { return __builtin_bit_cast(float, w & 0xffff0000u); }
__device__ __forceinline__ f32x16 mfma32(s16x8 a, s16x8 b, f32x16 c) { return __builtin_amdgcn_mfma_f32_32x32x16_bf16(a, b, c, 0, 0, 0); }
__device__ __forceinline__ s16x8 ldfrag(const LAS unsigned char* img, int row, int ks, int hh) { return *(const LAS s16x8*)(img + row * PT + ks * 32 + hh * 16); }
__device__ __forceinline__ void conv_load(const Frame& F, int seq_row0, int t0, int xch, unsigned (&raw)[11]) {
    const bf16* base = F.PROJ() + (size_t)seq_row0 * PLD + C_XBC + xch;
#pragma unroll
    for (int i = 0; i < 11; ++i) { const int t = t0 - 3 + i; raw[i] = (t >= 0) ? *(const unsigned*)(base + (size_t)t * PLD) : 0u; }
}
__device__ __forceinline__ void conv_fin(const Frame& F, int xch, const unsigned (&raw)[11], float (&o0)[8], float (&o1)[8]) {
    f32x2 w[4];
#pragma unroll
    for (int k = 0; k < 4; ++k) w[k] = *(const f32x2*)(F.conv_w() + k * DCONV + xch);
    const f32x2 bb = *(const f32x2*)(F.conv_b() + xch);
#pragma unroll
    for (int o = 0; o < 8; ++o) { float a0 = bb.x, a1 = bb.y;
#pragma unroll
        for (int k = 0; k < 4; ++k) { a0 += bflo(raw[o + k]) * w[k].x; a1 += bfhi(raw[o + k]) * w[k].y; }
        o0[o] = silu_f(a0); o1[o] = silu_f(a1); }
}
__device__ __forceinline__ void conv8x2(const Frame& F, int seq_row0, int t0, int xch, float (&o0)[8], float (&o1)[8]) { unsigned raw[11]; conv_load(F, seq_row0, t0, xch, raw); conv_fin(F, xch, raw, o0, o1); }
__device__ __forceinline__ v4u pack8(const float (&o)[8]) { v4u r; r.x = cvtpk(o[0], o[1]); r.y = cvtpk(o[2], o[3]); r.z = cvtpk(o[4], o[5]); r.w = cvtpk(o[6], o[7]); return r; }
__device__ __forceinline__ void chunk_dt(const Frame& F, int row0, int g, LAS float* dtl, LAS float* Ac) {
    if (F.wave < 6) {
        const int h = 6 * g + F.wave; const float a = -__expf(F.a_log()[h]), bias = F.dt_bias()[h]; const int l0 = 2 * F.lane;
        const float d0 = softplus_f(F.DTRAW()[(size_t)(row0 + l0) * 64 + h] + bias), d1 = softplus_f(F.DTRAW()[(size_t)(row0 + l0 + 1) * 64 + h] + bias);
        const float e0 = d0 * a, e1 = d1 * a; float s = e0 + e1;
#pragma unroll
        for (int o = 1; o < 64; o <<= 1) { const float u = __shfl_up(s, o); if (F.lane >= o) s += u; }
        dtl[F.wave * 128 + l0] = d0; dtl[F.wave * 128 + l0 + 1] = d1; Ac[F.wave * 128 + l0] = s - e1; Ac[F.wave * 128 + l0 + 1] = s;
    }
}
__device__ __forceinline__ void p2a_unit(Frame& F, int b, int c, int g) {
    LAS unsigned char* XwT = F.lds;
    LAS unsigned char* BT = F.lds + 52224;
    LAS float* dtl = (LAS float*)(F.lds + 87040); LAS float* Ac = (LAS float*)(F.lds + 90112);
    const int seq_row0 = b * 2048, tok0 = c * 128, row0 = seq_row0 + tok0, hh = F.lane >> 5, l31 = F.lane & 31;
    __syncthreads();
    chunk_dt(F, row0, g, dtl, Ac);
    { unsigned raw[2][11];
#pragma unroll
      for (int j = 0; j < 2; ++j) { const int it = F.tid + NTHR * j, cp = it & 63, to = it >> 6; conv_load(F, seq_row0, tok0 + 8 * to, 3072 + g * 128 + 2 * cp, raw[j]); }
#pragma unroll
      for (int j = 0; j < 2; ++j) { const int it = F.tid + NTHR * j, cp = it & 63, to = it >> 6; float o0[8], o1[8];
        conv_fin(F, 3072 + g * 128 + 2 * cp, raw[j], o0, o1);
        *(LAS v4u*)(BT + (2 * cp) * PT + to * 16) = pack8(o0); *(LAS v4u*)(BT + (2 * cp + 1) * PT + to * 16) = pack8(o1); } }
    __syncthreads();
    if (F.tid < 6) F.CHDEC()[(size_t)(b * 16 + c) * NHEAD + 6 * g + F.tid] = __expf(Ac[F.tid * 128 + 127]);
    for (int half = 0; half < 2; ++half) {
        if (half) __syncthreads();
        unsigned raw[3][11];
#pragma unroll
        for (int j = 0; j < 3; ++j) { const int it = F.tid + NTHR * j, cp = it % 96, to = it / 96, ch = 2 * cp, rl = ch >> 6, p = ch & 63, r = 3 * half + rl;
            conv_load(F, seq_row0, tok0 + 8 * to, (6 * g + r) * 64 + p, raw[j]); }
#pragma unroll
        for (int j = 0; j < 3; ++j) { const int it = F.tid + NTHR * j, cp = it % 96, to = it / 96, ch = 2 * cp, rl = ch >> 6, p = ch & 63, r = 3 * half + rl; float o0[8], o1[8];
            conv_fin(F, (6 * g + r) * 64 + p, raw[j], o0, o1);
            const float aend = Ac[r * 128 + 127];
#pragma unroll
            for (int o = 0; o < 8; ++o) { const float wl = __expf(aend - Ac[r * 128 + 8 * to + o]) * dtl[r * 128 + 8 * to + o]; o0[o] *= wl; o1[o] *= wl; }
            *(LAS v4u*)(XwT + (rl * 64 + p) * PT + to * 16) = pack8(o0); *(LAS v4u*)(XwT + (rl * 64 + p + 1) * PT + to * 16) = pack8(o1); }
        __syncthreads();
        const int pi = F.wave >> 2, ni = F.wave & 3;
        for (int rl = 0; rl < 3; ++rl) {
            f32x16 acc;
#pragma unroll
            for (int i = 0; i < 16; ++i) acc[i] = 0.f;
#pragma unroll
            for (int ks = 0; ks < 8; ++ks) acc = mfma32(ldfrag(XwT, rl * 64 + 32 * pi + l31, ks, hh), ldfrag(BT, 32 * ni + l31, ks, hh), acc);
            const int h = 6 * g + 3 * half + rl;
            float* so = F.ST() + ((size_t)((b * 16 + c) * NHEAD + h) * HDIM) * DSTATE + 32 * ni + l31;
#pragma unroll
            for (int i = 0; i < 16; ++i) { const int p = 32 * pi + (i & 3) + 8 * (i >> 2) + 4 * hh; so[(size_t)p * DSTATE] = acc[i]; }
        }
    }
}
__device__ __forceinline__ void p2b_scan(Frame& F) {
    const int gt = F.bid * NTHR + F.tid, GT = F.G * NTHR;
    for (int i = gt; i < 4 * NHEAD * 2048; i += GT) {
        const int b = i / (NHEAD * 2048), rem = i - b * (NHEAD * 2048), h = rem >> 11, e = rem & 2047;
        f32x4 st[16];
#pragma unroll
        for (int c = 0; c < 16; ++c) st[c] = *((const f32x4*)F.ST() + ((size_t)((b * 16 + c) * NHEAD + h) * 2048 + e));
        f32x4 s = (f32x4){0.f, 0.f, 0.f, 0.f};
#pragma unroll
        for (int c = 0; c < 16; ++c) {
            u32x2 pk; pk.x = cvtpk(s.x, s.y); pk.y = cvtpk(s.z, s.w);
            *((u32x2*)F.SIN() + ((size_t)((b * 16 + c) * NHEAD + h) * 2048 + e)) = pk;
            const float d = F.CHDEC()[(size_t)(b * 16 + c) * NHEAD + h];
            s = s * d + st[c];
        }
        *((f32x4*)(F.out() + O_SSM_P) + ((size_t)(b * NHEAD + h) * 2048 + e)) = s;
    }
}
__device__ __forceinline__ void p2c_unit(Frame& F, int b, int c, int g) {
    LAS unsigned char* Cn = F.lds;
    LAS unsigned char* Bn = F.lds + 34816;
    LAS unsigned char* XT = F.lds + 69632;
    LAS float* dtl = (LAS float*)(F.lds + 87040); LAS float* Ac = (LAS float*)(F.lds + 90112);
    LAS float* part = (LAS float*)(F.lds + 93184);
    const int seq_row0 = b * 2048, tok0 = c * 128, row0 = seq_row0 + tok0, hh = F.lane >> 5, l31 = F.lane & 31;
    const int li = F.wave >> 1, sh = F.wave & 1, pj = F.wave & 1, l = 32 * li + l31;
    const int xcp = F.tid & 31, xto = F.tid >> 5;
    const bf16* zrow = F.PROJ() + (size_t)(row0 + l) * PLD + C_Z + 32 * pj + 4 * hh;
    const bf16* sing = F.SIN() + ((size_t)((b * 16 + c) * NHEAD) * HDIM + 32 * pj + l31) * DSTATE + 8 * hh;
    __syncthreads();
    chunk_dt(F, row0, g, dtl, Ac);
    { unsigned raw[4][11];
#pragma unroll
      for (int j = 0; j < 4; ++j) { const int it = F.tid + NTHR * j, isC = it >> 10, cp = it & 63, to = (it >> 6) & 15; conv_load(F, seq_row0, tok0 + 8 * to, 3072 + isC * 1024 + g * 128 + 2 * cp, raw[j]); }
#pragma unroll
      for (int j = 0; j < 4; ++j) { const int it = F.tid + NTHR * j, isC = it >> 10, cp = it & 63, to = (it >> 6) & 15; float o0[8], o1[8];
        conv_fin(F, 3072 + isC * 1024 + g * 128 + 2 * cp, raw[j], o0, o1);
        LAS unsigned char* img = (isC ? Cn : Bn) + (8 * to) * PT + cp * 4;
#pragma unroll
        for (int o = 0; o < 8; ++o) *(LAS unsigned*)(img + o * PT) = cvtpk(o0[o], o1[o]); } }
    unsigned rawx[11];
    conv_load(F, seq_row0, tok0 + 8 * xto, (6 * g) * 64 + 2 * xcp, rawx);
    __syncthreads();
    f32x16 gt0, gt1;
#pragma unroll
    for (int i = 0; i < 16; ++i) { gt0[i] = 0.f; gt1[i] = 0.f; }
    if (2 * sh <= li) {
#pragma unroll
        for (int ks = 0; ks < 8; ++ks) gt0 = mfma32(ldfrag(Bn, 64 * sh + l31, ks, hh), ldfrag(Cn, l, ks, hh), gt0);
    }
    if (2 * sh + 1 <= li) {
#pragma unroll
        for (int ks = 0; ks < 8; ++ks) gt1 = mfma32(ldfrag(Bn, 64 * sh + 32 + l31, ks, hh), ldfrag(Cn, l, ks, hh), gt1);
    }
    float ss = 0.f;
    bf16* mrow = F.MIX() + (size_t)(row0 + l) * DMIX + DPOOL + 32 * pj + 4 * hh;
#pragma unroll 1
    for (int r = 0; r < 6; ++r) {
        const int h = 6 * g + r; const float dsk = F.d_skip()[h];
        __syncthreads();
        v4u sinc[8]; u32x2 zc[4];
#pragma unroll
        for (int ks = 0; ks < 8; ++ks) sinc[ks] = *(const v4u*)(sing + (size_t)h * HDIM * DSTATE + 16 * ks);
#pragma unroll
        for (int q = 0; q < 4; ++q) zc[q] = *(const u32x2*)(zrow + h * 64 + 8 * q);
        { float o0[8], o1[8]; conv_fin(F, h * 64 + 2 * xcp, rawx, o0, o1);
          *(LAS v4u*)(XT + (2 * xcp) * PT + xto * 16) = pack8(o0); *(LAS v4u*)(XT + (2 * xcp + 1) * PT + xto * 16) = pack8(o1); }
        { const float Al = Ac[r * 128 + l];
#pragma unroll
          for (int tsel = 0; tsel < 2; ++tsel) { const int si = 2 * sh + tsel;
            if (si <= li) {
#pragma unroll
                for (int q = 0; q < 4; ++q) { const int s0 = 32 * si + 8 * q + 4 * hh;
                    const f32x4 As4 = *(const LAS f32x4*)(Ac + r * 128 + s0), dt4 = *(const LAS f32x4*)(dtl + r * 128 + s0); float v[4];
#pragma unroll
                    for (int j = 0; j < 4; ++j) { const float gv = tsel ? gt1[4 * q + j] : gt0[4 * q + j]; const float e = __expf(fminf(Al - As4[j], 0.f));
                        v[j] = (s0 + j <= l) ? gv * e * dt4[j] : 0.f; v[j] += (s0 + j == l) ? dsk : 0.f; }
                    u32x2 pk; pk.x = cvtpk(v[0], v[1]); pk.y = cvtpk(v[2], v[3]);
                    *(LAS u32x2*)(Bn + l * PT + s0 * 2) = pk; } } } }
        if (r < 5) conv_load(F, seq_row0, tok0 + 8 * xto, (h + 1) * 64 + 2 * xcp, rawx);
        __syncthreads();
        f32x16 acc;
#pragma unroll
        for (int i = 0; i < 16; ++i) acc[i] = 0.f;
#pragma unroll
        for (int ks = 0; ks < 8; ++ks) acc = mfma32(__builtin_bit_cast(s16x8, sinc[ks]), ldfrag(Cn, l, ks, hh), acc);
        { const float ea = __expf(Ac[r * 128 + l]);
#pragma unroll
          for (int i = 0; i < 16; ++i) acc[i] *= ea; }
        for (int ks = 0; ks < 2 * (li + 1); ++ks) acc = mfma32(ldfrag(XT, 32 * pj + l31, ks, hh), ldfrag(Bn, l, ks, hh), acc);
#pragma unroll
        for (int q = 0; q < 4; ++q) { const float z0 = bflo(zc[q].x), z1 = bfhi(zc[q].x), z2 = bflo(zc[q].y), z3 = bfhi(zc[q].y);
            const float y0 = acc[4 * q] * silu_f(z0), y1 = acc[4 * q + 1] * silu_f(z1), y2 = acc[4 * q + 2] * silu_f(z2), y3 = acc[4 * q + 3] * silu_f(z3);
            ss += (y0 * y0 + y1 * y1) + (y2 * y2 + y3 * y3); u32x2 o; o.x = cvtpk(y0, y1); o.y = cvtpk(y2, y3); *(u32x2*)(mrow + h * 64 + 8 * q) = o; }
    }
    part[l * 4 + pj * 2 + hh] = ss;
    __syncthreads();
    const f32x4 pv = *(const LAS f32x4*)(part + l * 4);
    const float rstd = 1.f / sqrtf(((pv.x + pv.y) + (pv.z + pv.w)) * (1.f / 384.f) + EPS);
    VM_WAIT();
#pragma unroll 1
    for (int r = 0; r < 6; ++r) { const int h = 6 * g + r;
#pragma unroll
        for (int q = 0; q < 4; ++q) { const f32x4 ng = *(const f32x4*)(F.ssm_norm_g() + h * 64 + 32 * pj + 4 * hh + 8 * q); const u32x2 yv = *(const u32x2*)(mrow + h * 64 + 8 * q);
            u32x2 o; o.x = cvtpk(bflo(yv.x) * rstd * ng.x, bfhi(yv.x) * rstd * ng.y); o.y = cvtpk(bflo(yv.y) * rstd * ng.z, bfhi(yv.y) * rstd * ng.w);
            *(u32x2*)(mrow + h * 64 + 8 * q) = o; } }
}
constexpr int PT2 = 528;
template <int W> __device__ __forceinline__ void pool_stage_prompt(const Frame& F, LAS unsigned char* Ap, int m0, int gi) {
    for (int it = F.tid; it < 1024; it += NTHR) { const int cp = it & 127, to = it >> 7, mrow = m0 + 8 * to, tseq = mrow & 2047;
        const bf16* base = F.PROJ() + (size_t)mrow * PLD + gi * 256 + 2 * cp;
        unsigned raw[W + 7];
#pragma unroll
        for (int i = 0; i < W + 7; ++i) { const int dt = i - (W - 1); raw[i] = (tseq + dt >= 0) ? *(const unsigned*)(base + (ptrdiff_t)dt * PLD) : 0u; }
        float s0 = 0.f, s1 = 0.f;
#pragma unroll
        for (int i = 0; i < W - 1; ++i) { s0 += bflo(raw[i]); s1 += bfhi(raw[i]); }
#pragma unroll
        for (int o = 0; o < 8; ++o) { const float u0 = bflo(raw[o + W - 1]), u1 = bfhi(raw[o + W - 1]); s0 += u0; s1 += u1;
            const float inv = 1.f / (float)min(W, tseq + o + 1);
            *(LAS unsigned*)(Ap + (8 * to + o) * PT2 + cp * 4) = cvtpk(s0 * inv - u0, s1 * inv - u1);
            s0 -= bflo(raw[o]); s1 -= bfhi(raw[o]); }
    }
}
template <int W> __device__ __forceinline__ void pool_stage_sample(const Frame& F, LAS unsigned char* Ap, int m0, int gi) {
    for (int it = F.tid; it < 2048; it += NTHR) { const int cp = it & 127, sq = it >> 7, b = (m0 - NPR) / 4 + sq, ch = gi * 256 + 2 * cp;
        f32x2 hv[W - 1]; unsigned raw[4];
#pragma unroll
        for (int i = 0; i < W - 1; ++i) hv[i] = *(const f32x2*)(F.state_pool() + (size_t)(b * 15 + 15 - (W - 1) + i) * DPOOL + ch);
#pragma unroll
        for (int t = 0; t < 4; ++t) raw[t] = *(const unsigned*)(F.PROJ() + (size_t)(NPR + 4 * b + t) * PLD + ch);
        float e0[W + 3], e1[W + 3];
#pragma unroll
        for (int i = 0; i < W - 1; ++i) { e0[i] = hv[i].x; e1[i] = hv[i].y; }
#pragma unroll
        for (int t = 0; t < 4; ++t) { e0[W - 1 + t] = bflo(raw[t]); e1[W - 1 + t] = bfhi(raw[t]); }
        float s0 = 0.f, s1 = 0.f;
#pragma unroll
        for (int i = 0; i < W - 1; ++i) { s0 += e0[i]; s1 += e1[i]; }
#pragma unroll
        for (int t = 0; t < 4; ++t) { s0 += e0[W - 1 + t]; s1 += e1[W - 1 + t];
            *(LAS unsigned*)(Ap + (4 * sq + t) * PT2 + cp * 4) = cvtpk(s0 * (1.f / W) - e0[W - 1 + t], s1 * (1.f / W) - e1[W - 1 + t]);
            s0 -= e0[t]; s1 -= e1[t]; }
    }
}
__device__ __forceinline__ void pool_unit_mfma(Frame& F, int tile, int gi) {
    LAS unsigned char* Ap = F.lds;
    LAS unsigned char* Wt = F.lds + 33792;
    const int m0 = tile * 64, hh = F.lane >> 5, l31 = F.lane & 31;
    __syncthreads();
    if (m0 < NPR) {
        if (gi == 0) pool_stage_prompt<2>(F, Ap, m0, gi); else if (gi == 1) pool_stage_prompt<4>(F, Ap, m0, gi);
        else if (gi == 2) pool_stage_prompt<8>(F, Ap, m0, gi); else pool_stage_prompt<16>(F, Ap, m0, gi);
    } else {
        if (gi == 0) pool_stage_sample<2>(F, Ap, m0, gi); else if (gi == 1) pool_stage_sample<4>(F, Ap, m0, gi);
        else if (gi == 2) pool_stage_sample<8>(F, Ap, m0, gi); else pool_stage_sample<16>(F, Ap, m0, gi);
    }
    const int ti = F.wave >> 2, di = F.wave & 3;
    for (int dh = 0; dh < 2; ++dh) {
        if (dh) __syncthreads();
        { const bf16* wg = F.PWT() + (size_t)(gi * 256 + dh * 128) * 256;
#pragma unroll
          for (int j = 0; j < 8; ++j) { const int idx = F.tid + NTHR * j, d = idx >> 5, seg = idx & 31; *(LAS v4u*)(Wt + d * PT2 + seg * 16) = *(const v4u*)(wg + d * 256 + seg * 8); } }
        __syncthreads();
        f32x16 acc;
#pragma unroll
        for (int i = 0; i < 16; ++i) acc[i] = 0.f;
#pragma unroll
        for (int ks = 0; ks < 16; ++ks) acc = mfma32(*(const LAS s16x8*)(Ap + (32 * ti + l31) * PT2 + ks * 32 + hh * 16), *(const LAS s16x8*)(Wt + (32 * di + l31) * PT2 + ks * 32 + hh * 16), acc);
        const int d = gi * 256 + dh * 128 + 32 * di + l31; const float sc = F.pool_scale()[d];
#pragma unroll
        for (int i = 0; i < 16; ++i) { const size_t row = (size_t)(m0 + 32 * ti + (i & 3) + 8 * (i >> 2) + 4 * hh); const float gate = bf2f(F.PROJ()[row * PLD + C_GATE + d]);
            F.MIX()[row * DMIX + d] = (bf16)f2bf(acc[i] * sc * silu_f(gate)); }
    }
}
__device__ __forceinline__ void sample_unit(Frame& F, int sb, int g) {
    LAS float* T = (LAS float*)F.lds;
    LAS float* dts = T + 2560; LAS float* dec = dts + 24; LAS float* ys = dec + 24; LAS float* red = ys + 1536;
    const int row0 = NPR + sb * 4, p = F.tid >> 3, nq = F.tid & 7;
    f32x4 S[3][4];
#pragma unroll
    for (int r = 0; r < 2; ++r) { const f32x4* sp = (const f32x4*)(F.state_ssm() + ((size_t)(sb * NHEAD + 6 * g + r) * HDIM + p) * DSTATE + nq * 16);
#pragma unroll
        for (int q = 0; q < 4; ++q) S[r][q] = sp[q]; }
    __syncthreads();
    if (F.tid < 320) { const int c = 2 * F.tid;
        const int xch = c < 128 ? 3072 + g * 128 + c : (c < 256 ? 4096 + g * 128 + (c - 128) : g * 384 + (c - 256));
        f32x2 hv[3], w[4]; unsigned raw[4];
#pragma unroll
        for (int i = 0; i < 3; ++i) hv[i] = *(const f32x2*)(F.state_conv() + (size_t)(sb * 3 + i) * DCONV + xch);
#pragma unroll
        for (int t = 0; t < 4; ++t) raw[t] = *(const unsigned*)(F.PROJ() + (size_t)(row0 + t) * PLD + C_XBC + xch);
#pragma unroll
        for (int k = 0; k < 4; ++k) w[k] = *(const f32x2*)(F.conv_w() + k * DCONV + xch);
        const f32x2 bb = *(const f32x2*)(F.conv_b() + xch);
        float e0[7], e1[7];
#pragma unroll
        for (int i = 0; i < 3; ++i) { e0[i] = hv[i].x; e1[i] = hv[i].y; }
#pragma unroll
        for (int t = 0; t < 4; ++t) { e0[3 + t] = bflo(raw[t]); e1[3 + t] = bfhi(raw[t]); }
#pragma unroll
        for (int t = 0; t < 4; ++t) { float a0 = bb.x, a1 = bb.y;
#pragma unroll
            for (int k = 0; k < 4; ++k) { a0 += e0[t + k] * w[k].x; a1 += e1[t + k] * w[k].y; }
            T[t * 640 + c] = silu_f(a0); T[t * 640 + c + 1] = silu_f(a1); } }
    if (F.tid < 24) { const int r = F.tid >> 2, t = F.tid & 3, h = 6 * g + r; const float dt = softplus_f(F.DTRAW()[(size_t)(row0 + t) * 64 + h] + F.dt_bias()[h]);
        dts[F.tid] = dt; dec[F.tid] = __expf(-dt * __expf(F.a_log()[h])); }
    __syncthreads();
#pragma unroll
    for (int r = 0; r < 6; ++r) { const int h = 6 * g + r, cur = r % 3; const float dsk = F.d_skip()[h];
        if (r + 2 < 6) { const f32x4* sp = (const f32x4*)(F.state_ssm() + ((size_t)(sb * NHEAD + h + 2) * HDIM + p) * DSTATE + nq * 16);
#pragma unroll
            for (int q = 0; q < 4; ++q) S[(r + 2) % 3][q] = sp[q]; }
#pragma unroll
        for (int t = 0; t < 4; ++t) { const LAS float* row = T + t * 640; const float x = row[256 + r * 64 + p], d = dec[r * 4 + t], dtx = dts[r * 4 + t] * x; float acc = 0.f;
#pragma unroll
            for (int q = 0; q < 4; ++q) { const f32x4 bv = *(const LAS f32x4*)(row + nq * 16 + 4 * q), cv = *(const LAS f32x4*)(row + 128 + nq * 16 + 4 * q);
                S[cur][q] = S[cur][q] * d + bv * dtx; const f32x4 pr = cv * S[cur][q]; acc += (pr.x + pr.y) + (pr.z + pr.w); }
            acc += __shfl_xor(acc, 1); acc += __shfl_xor(acc, 2); acc += __shfl_xor(acc, 4);
            if (nq == 0) ys[t * 384 + r * 64 + p] = acc + dsk * x; }
        f32x4* so = (f32x4*)(F.out() + O_SSM_S + ((size_t)(sb * NHEAD + h) * HDIM + p) * DSTATE + nq * 16);
#pragma unroll
        for (int q = 0; q < 4; ++q) so[q] = S[cur][q]; }
    __syncthreads();
    { const int t = F.tid >> 7, j = F.tid & 127; float v[3]; float ss = 0.f;
#pragma unroll
      for (int k = 0; k < 3; ++k) { const int idx = j + 128 * k; const float z = bf2f(F.PROJ()[(size_t)(row0 + t) * PLD + C_Z + g * 384 + idx]); v[k] = ys[t * 384 + idx] * silu_f(z); ss += v[k] * v[k]; }
      ss = wave_sum(ss); if (F.lane == 0) red[F.wave] = ss;
      __syncthreads();
      const float rstd = 1.f / sqrtf((red[2 * t] + red[2 * t + 1]) * (1.f / 384.f) + EPS);
#pragma unroll
      for (int k = 0; k < 3; ++k) { const int idx = j + 128 * k; F.MIX()[(size_t)(row0 + t) * DMIX + DPOOL + g * 384 + idx] = (bf16)f2bf(v[k] * rstd * F.ssm_norm_g()[g * 384 + idx]); } }
}

__device__ __forceinline__ void copy_seg_bf16(const bf16* src, float* dst, int lane) {
    const v4u a = *((const v4u*)src + 2 * lane), b = *((const v4u*)src + 2 * lane + 1); f32x4* d = (f32x4*)dst + 4 * lane;
    d[0] = (f32x4){bflo(a.x), bfhi(a.x), bflo(a.y), bfhi(a.y)}; d[1] = (f32x4){bflo(a.z), bfhi(a.z), bflo(a.w), bfhi(a.w)};
    d[2] = (f32x4){bflo(b.x), bfhi(b.x), bflo(b.y), bfhi(b.y)}; d[3] = (f32x4){bflo(b.z), bfhi(b.z), bflo(b.w), bfhi(b.w)};
}
__device__ __forceinline__ void p2_copies(Frame& F) {
    const int gw = F.bid * NWAVES + F.wave, NGW = F.G * NWAVES;
    constexpr int NPP = 4 * 15, NPS = 128 * 15, NCP = 4 * 3 * 5, NCS = 128 * 3 * 5;
    for (int task = gw; task < NPP + NPS + NCP + NCS; task += NGW) {
        int t = task;
        if (t < NPP) { const int b = t / 15, r = t - b * 15; copy_seg_bf16(F.PROJ() + (size_t)(b * 2048 + 2033 + r) * PLD, F.out() + O_POOL_P + (size_t)t * DPOOL, F.lane); continue; }
        t -= NPP;
        if (t < NPS) { const int b = t / 15, r = t - b * 15; float* dst = F.out() + O_POOL_S + (size_t)t * DPOOL;
            if (r < 11) { const f32x4* sp = (const f32x4*)(F.state_pool() + (size_t)(b * 15 + r + 4) * DPOOL) + 4 * F.lane; f32x4* d = (f32x4*)dst + 4 * F.lane; d[0] = sp[0]; d[1] = sp[1]; d[2] = sp[2]; d[3] = sp[3]; }
            else copy_seg_bf16(F.PROJ() + (size_t)(NPR + b * 4 + r - 11) * PLD, dst, F.lane);
            continue; }
        t -= NPS;
        if (t < NCP) { const int row = t / 5, sg = t - row * 5, b = row / 3, r = row - b * 3;
            copy_seg_bf16(F.PROJ() + (size_t)(b * 2048 + 2045 + r) * PLD + C_XBC + sg * 1024, F.out() + O_CONV_P + (size_t)row * DCONV + sg * 1024, F.lane); continue; }
        t -= NCP;
        { const int row = t / 5, sg = t - row * 5, b = row / 3, r = row - b * 3;
          copy_seg_bf16(F.PROJ() + (size_t)(NPR + b * 4 + 1 + r) * PLD + C_XBC + sg * 1024, F.out() + O_CONV_S + (size_t)row * DCONV + sg * 1024, F.lane); }
    }
}

__device__ __forceinline__ void p3_gate_norm(Frame& F) {
    const int gw = F.bid * NWAVES + F.wave, NGW = F.G * NWAVES;
    for (int task = gw; task < NSM * NGRP; task += NGW) {
        const int m = NPR + (task >> 3), g = task & 7; float v[6]; float ss = 0.f;
#pragma unroll
        for (int k = 0; k < 6; ++k) { const int idx = g * 384 + F.lane + 64 * k; const float y = F.YBUF()[(size_t)m * DSSM + idx], z = bf2f(F.PROJ()[(size_t)m * PLD + C_Z + idx]);
            v[k] = y * silu_f(z); ss += v[k] * v[k]; }
        const float r = 1.f / sqrtf(wave_sum(ss) * (1.f / 384.f) + EPS);
#pragma unroll
        for (int k = 0; k < 6; ++k) { const int idx = g * 384 + F.lane + 64 * k; F.MIX()[(size_t)m * DMIX + DPOOL + idx] = (bf16)f2bf(v[k] * r * F.ssm_norm_g()[idx]); }
    }
}
__device__ __forceinline__ void p5_final_norm(Frame& F) {
    const int gw = F.bid * NWAVES + F.wave, NGW = F.G * NWAVES;
    for (int m = gw; m < MROWS; m += NGW) {
        GAS f32x4* yr = (GAS f32x4*)(F.out() + O_Y + (size_t)m * DMODEL) + F.lane; const GAS f32x4* gr = (const GAS f32x4*)F.final_g() + F.lane;
        f32x4 v[8]; float s = 0.f;
        if (m < NPR) {
#pragma unroll
            for (int j = 0; j < 8; ++j) v[j] = yr[64 * j];
        } else {
            const GAS f32x4* xr = (const GAS f32x4*)(F.x_sample() + (size_t)(m - NPR) * DMODEL) + F.lane;
#pragma unroll
            for (int j = 0; j < 8; ++j) v[j] = xr[64 * j];
#pragma unroll 4
            for (int sl = 0; sl < 16; ++sl) { const GAS f32x4* pr = (const GAS f32x4*)(F.YBUF() + (size_t)sl * (512 * 2048) + (size_t)(m - NPR) * DMODEL) + F.lane;
#pragma unroll
                for (int j = 0; j < 8; ++j) v[j] += pr[64 * j]; }
        }
#pragma unroll
        for (int j = 0; j < 8; ++j) s += (v[j].x * v[j].x + v[j].y * v[j].y) + (v[j].z * v[j].z + v[j].w * v[j].w);
        const float r = 1.f / sqrtf(wave_sum(s) * (1.f / DMODEL) + EPS);
#pragma unroll
        for (int j = 0; j < 8; ++j) { const f32x4 g = gr[64 * j]; yr[64 * j] = (f32x4){v[j].x * r * g.x, v[j].y * r * g.y, v[j].z * r * g.z, v[j].w * r * g.w}; }
    }
}

constexpr int N_PHASES = 10;
__global__ void __launch_bounds__(NTHR, 2) fwd(Args args) {
    extern __shared__ __attribute__((aligned(16))) unsigned char lds_raw[];
    Frame F{(LAS unsigned char*)lds_raw, (int)threadIdx.x, (int)(threadIdx.x & 63), __builtin_amdgcn_readfirstlane((int)(threadIdx.x >> 6)), (int)gridDim.x, (int)blockIdx.x, args};
    unsigned char* ws = args.ws;
    for (int u = F.tid; u < (LDS_BYTES - LDSCTL_OFF) / 4; u += NTHR) ((LAS unsigned*)(F.lds + LDSCTL_OFF))[u] = 0u;
    __syncthreads();
    const int lo = args.ph_lo, hi = args.ph_hi;
    XcdBarrier bar; bar.bar = (unsigned*)(ws + WS_CTL) + CW_BAR; bar.x = 0; bar.st = nullptr;
    if (hi - lo > 1) bar = xcd_barrier_post((unsigned*)(ws + WS_CTL) + CW_BAR, (volatile LAS unsigned*)(F.lds + MISC_OFF) + 8);
#define IN(k) (lo <= (k) && (k) < hi)
#define BOTH(k) (IN(k) && IN((k) + 1))
#ifndef PHMASK
#define PHMASK 0x3ff
#endif
    if ((PHMASK & 1) && IN(0)) { p0_prologue(F); if (BOTH(0)) xcd_barrier(bar); }
    if ((PHMASK & 2) && IN(1)) {
        pg8::Gemm g{F.XN(), F.WinT(), MROWS, NPROJ_PAD, DMODEL}; pg8::StaticOrder S; S.init(MROWS, NPROJ_PAD, DMODEL, F.G, F.bid);
        pg8::EpiProj E{F.PROJ(), F.DTRAW()};
        pg8::gemm_phase<pg8::EpiProj, pg8::StaticOrder, true, true>(F.lds, g, S, E);
        if (BOTH(1)) xcd_barrier(bar);
    }
    if ((PHMASK & 4) && IN(2)) { for (int u = F.bid; u < 512; u += F.G) p2a_unit(F, u >> 7, (u >> 3) & 15, u & 7); }
    if ((PHMASK & 8) && IN(3)) { for (int u = F.bid; u < 1024; u += F.G) sample_unit(F, u >> 3, u & 7); }
    if ((PHMASK & 16) && IN(4)) { for (int u = F.bid; u < 544; u += F.G) pool_unit_mfma(F, u >> 2, u & 3); }
    if ((PHMASK & 32) && IN(5)) { p2_copies(F); if (BOTH(5)) xcd_barrier(bar); }
    if ((PHMASK & 64) && IN(6)) { p2b_scan(F); if (BOTH(6)) xcd_barrier(bar); }
    if ((PHMASK & 128) && IN(7)) { for (int u = F.bid; u < 512; u += F.G) p2c_unit(F, u >> 7, (u >> 3) & 15, u & 7); if (BOTH(7)) xcd_barrier(bar); }
    if ((PHMASK & 256) && IN(8)) {
        pg8::Gemm g{F.MIX(), F.WoutT(), MROWS, DMODEL, DMIX}; pg8::OutOrder S{F.bid};
        pg8::EpiOut2 E{F.x_prompt(), F.out(), F.YBUF()};
        pg8::gemm_phase<pg8::EpiOut2, pg8::OutOrder, true, true>(F.lds, g, S, E);
        if (BOTH(8)) xcd_barrier(bar);
    }
    if ((PHMASK & 512) && IN(9)) { p5_final_norm(F); }
#undef IN
#undef BOTH
}

#ifndef N_LAUNCHES
#define N_LAUNCHES 1
#endif
extern "C" void kernel_launch(void* const* d_in, const int* in_sizes, int n_in, void* d_out, int out_size, void* d_ws, size_t ws_size, hipStream_t stream) {
    static int grid = 0;
    if (grid == 0) {
        if (n_in != 17 || out_size != 73785344 || ws_size < WS_END) { fprintf(stderr, "kernel_launch: unexpected shapes: n_in %d out %d ws %zu\n", n_in, out_size, ws_size); grid = -1; return; }
        int dev = 0, cus = 0, per_cu = 0;
        if (hipGetDevice(&dev) != hipSuccess || hipDeviceGetAttribute(&cus, hipDeviceAttributeMultiprocessorCount, dev) != hipSuccess) { fprintf(stderr, "kernel_launch: device query failed\n"); grid = -1; return; }
        if (hipFuncSetAttribute((const void*)fwd, hipFuncAttributeMaxDynamicSharedMemorySize, LDS_BYTES) != hipSuccess) { fprintf(stderr, "kernel_launch: hipFuncSetAttribute failed\n"); grid = -1; return; }
        if (hipOccupancyMaxActiveBlocksPerMultiprocessor(&per_cu, (const void*)fwd, NTHR, LDS_BYTES) != hipSuccess || per_cu < 1) { fprintf(stderr, "kernel_launch: occupancy query says %d blocks per CU\n", per_cu); }
        (void)hipGetLastError();
        grid = cus;
    }
    if (grid < 0) return;
    (void)hipMemsetAsync((char*)d_ws + WS_CTL, 0, CTL_ZERO_BYTES, stream);
    Args a{};
    for (int i = 0; i < 17; ++i) a.in[i] = (const float*)d_in[i];
    a.out = (float*)d_out; a.ws = (unsigned char*)d_ws;
    if (N_LAUNCHES == 1) {
        a.ph_lo = 0; a.ph_hi = N_PHASES;
        void* kargs[] = {&a};
        hipError_t e = hipLaunchCooperativeKernel((const void*)fwd, dim3(grid), dim3(NTHR), kargs, LDS_BYTES, stream);
        if (e != hipSuccess) fprintf(stderr, "kernel_launch: cooperative launch failed: %s\n", hipGetErrorString(e));
#ifdef PROBE_PHASE
        a.ph_lo = PROBE_PHASE; a.ph_hi = PROBE_PHASE + 1; hipLaunchKernelGGL(fwd, dim3(grid), dim3(NTHR), LDS_BYTES, stream, a);
#ifdef PROBE_PHASE2
        a.ph_lo = PROBE_PHASE2; a.ph_hi = PROBE_PHASE2 + 1; hipLaunchKernelGGL(fwd, dim3(grid), dim3(NTHR), LDS_BYTES, stream, a);
#endif
#endif
    } else {
        for (int li = 0; li < N_PHASES; ++li) { a.ph_lo = li; a.ph_hi = li + 1; hipLaunchKernelGGL(fwd, dim3(grid), dim3(NTHR), LDS_BYTES, stream, a); }
    }
}
```

```cpp
#include <hip/hip_runtime.h>
#include <cstdio>
#include <cstdint>
namespace pg8 {
#define PG8_LAS __attribute__((address_space(3)))
typedef unsigned short bf16_t;
typedef short bf16x8 __attribute__((ext_vector_type(8)));
typedef float f32x4 __attribute__((ext_vector_type(4)));
typedef unsigned u32x4 __attribute__((ext_vector_type(4)));
constexpr int BM = 256, BK = 64, HALF = 128, HTB = HALF * BK * 2  , STAGE_BYTES = 8 * HTB, NXCD = 8, WGM = 8;

__host__ __device__ __forceinline__ int lds_byte(int r, int c) { const int st = (r >> 4) * 2 + (c >> 5), rr = r & 15, cc = c & 31, ob = rr * 64 + cc * 2; return st * 1024 + (ob ^ (((ob >> 9) & 1) << 5)); }
__host__ __device__ __forceinline__ void stage_rc(int b, int& R, int& C) { const int st = b / 1024, sb = b % 1024, swz = sb ^ (((sb >> 9) & 1) << 5); R = (st >> 1) * 16 + swz / 64; C = (st & 1) * 32 + (swz % 64) / 2; }
__host__ __device__ __forceinline__ int perm32(int rho) { const int n = rho >> 4, i = rho & 15; return 8 * (i >> 2) + 4 * n + (i & 3); }

struct Unit { int pm, pn, k0, nt; };
struct Gemm { const bf16_t* A; const bf16_t* Bt; int M, N, K; };

struct StaticOrder {
    int nM, nN, nwg, G, c, ntk;
    __host__ __device__ void init(int M, int N, int K, int G_, int c_) { nM = M / BM; nN = N / BM; nwg = nM * nN; G = G_; c = c_; ntk = K / BK; }
    __host__ __device__ bool next(int i, Unit& u) const {
        const long L = (long)i * G + c; if (L >= nwg) return false;
        int wgid = (int)L; { const int q = nwg / NXCD, r = nwg % NXCD, xcd = wgid % NXCD, off = wgid / NXCD; wgid = (xcd < r ? xcd * (q + 1) : r * (q + 1) + (xcd - r) * q) + off; }
        const int nig = WGM * nN, gid = wgid / nig, fm = gid * WGM, gsz = (nM - fm) < WGM ? (nM - fm) : WGM;
        u.pm = fm + ((wgid % nig) % gsz); u.pn = (wgid % nig) / gsz; u.k0 = 0; u.nt = ntk; return true;
    }
    __device__ __forceinline__ void a_ready(const Unit&) const {}
    __device__ __forceinline__ void done(const Unit&) const {}
};

__device__ __forceinline__ unsigned cvt_pk_bf16(float lo, float hi) { unsigned r; asm volatile("v_cvt_pk_bf16_f32 %0, %1, %2" : "=v"(r) : "v"(lo), "v"(hi)); return r; }

struct EpiProj {
    static constexpr bool PERM = true, AFTER_DRAIN = false;
    bf16_t* P; float* dtraw;
    __device__ __forceinline__ void operator()(const f32x4 (&acc)[2][2][4][2], const Unit& u, int wr, int wc, int fr, int fq) const {
        const int row0 = u.pm * BM + wr * 64 + fr;
        if (u.pn < 40) {
            const int col0 = u.pn * BM + wc * 32 + 8 * fq;
#pragma unroll
            for (int ai = 0; ai < 2; ++ai)
#pragma unroll
                for (int m = 0; m < 4; ++m) { bf16_t* rowp = P + (size_t)(row0 + ai * HALF + m * 16) * 10240 + col0;
#pragma unroll
                    for (int bj = 0; bj < 2; ++bj) { const f32x4 v0 = acc[ai][bj][m][0], v1 = acc[ai][bj][m][1];
                        u32x4 w; w.x = cvt_pk_bf16(v0[0], v0[1]); w.y = cvt_pk_bf16(v0[2], v0[3]); w.z = cvt_pk_bf16(v1[0], v1[1]); w.w = cvt_pk_bf16(v1[2], v1[3]);
                        *(u32x4*)(rowp + bj * HALF) = w; } }
        } else if (wc < 2) {
#pragma unroll
            for (int ai = 0; ai < 2; ++ai)
#pragma unroll
                for (int m = 0; m < 4; ++m) { float* rp = dtraw + (size_t)(row0 + ai * HALF + m * 16) * 64 + wc * 32 + 8 * fq;
                    *(f32x4*)rp = acc[ai][0][m][0]; *(f32x4*)(rp + 4) = acc[ai][0][m][1]; }
        }
    }
};
struct EpiOut {
    static constexpr bool PERM = false, AFTER_DRAIN = false;
    const float* xp; const float* xs; float* out;
    __device__ __forceinline__ void operator()(const f32x4 (&acc)[2][2][4][2], const Unit& u, int wr, int wc, int fr, int fq) const {
        const int row0 = u.pm * BM + wr * 64 + fr, col0 = u.pn * BM + wc * 32 + 4 * fq;
        const float* xb = (u.pm < 32) ? xp : xs - (size_t)8192 * 2048;
#pragma unroll
        for (int ai = 0; ai < 2; ++ai)
#pragma unroll
            for (int m = 0; m < 4; ++m) { const size_t ro = (size_t)(row0 + ai * HALF + m * 16) * 2048 + col0;
#pragma unroll
                for (int bj = 0; bj < 2; ++bj)
#pragma unroll
                    for (int n = 0; n < 2; ++n) { const f32x4 xv = *(const f32x4*)(xb + ro + bj * HALF + n * 16);
                        *(f32x4*)(out + ro + bj * HALF + n * 16) = xv + acc[ai][bj][m][n]; } }
    }
};

struct EpiOut2 {
    static constexpr bool PERM = false, AFTER_DRAIN = false;
    const float* xp; float* out; float* slab;
    __device__ __forceinline__ void operator()(const f32x4 (&acc)[2][2][4][2], const Unit& u, int wr, int wc, int fr, int fq) const {
        const int row0 = u.pm * BM + wr * 64 + fr, col0 = u.pn * BM + wc * 32 + 4 * fq;
        if (u.pm < 32) {
#pragma unroll
            for (int ai = 0; ai < 2; ++ai)
#pragma unroll
                for (int m = 0; m < 4; ++m) { const size_t ro = (size_t)(row0 + ai * HALF + m * 16) * 2048 + col0;
#pragma unroll
                    for (int bj = 0; bj < 2; ++bj)
#pragma unroll
                        for (int n = 0; n < 2; ++n) { const f32x4 xv = *(const f32x4*)(xp + ro + bj * HALF + n * 16);
                            *(f32x4*)(out + ro + bj * HALF + n * 16) = xv + acc[ai][bj][m][n]; } }
        } else {
            float* sl = slab + (size_t)(u.k0 >> 8) * (512 * 2048) - (size_t)8192 * 2048;
#pragma unroll
            for (int ai = 0; ai < 2; ++ai)
#pragma unroll
                for (int m = 0; m < 4; ++m) { const size_t ro = (size_t)(row0 + ai * HALF + m * 16) * 2048 + col0;
#pragma unroll
                    for (int bj = 0; bj < 2; ++bj)
#pragma unroll
                        for (int n = 0; n < 2; ++n) *(f32x4*)(sl + ro + bj * HALF + n * 16) = acc[ai][bj][m][n]; }
        }
    }
};
struct OutOrder {
    int c;
    __device__ __forceinline__ bool next(int i, Unit& u) const {
        if (i == 0) { const int x = c & 7, j = c >> 3; u.pm = 4 * x + (j & 3); u.pn = j >> 2; u.k0 = 0; u.nt = 64; return true; }
        if (i == 1) { const int tile = c >> 4, sl = c & 15; u.pm = 32 + (tile >> 3); u.pn = tile & 7; u.k0 = sl * 256; u.nt = 4; return true; }
        return false;
    }
    __device__ __forceinline__ void a_ready(const Unit&) const {}
    __device__ __forceinline__ void done(const Unit&) const {}
};

template <class Epi, class Sched, bool ALIGN_EPI = false, bool SP2 = false>
__device__ __forceinline__ void gemm_phase(PG8_LAS unsigned char* lds, const Gemm g, const Sched& S, const Epi& E) {
    const int tid = threadIdx.x, wid = __builtin_amdgcn_readfirstlane(tid >> 6), lane = tid & 63, wr = wid >> 2, wc = wid & 3, fr = lane & 15, fq = lane >> 4;
    const int K = g.K;
    unsigned voffA[2], voffB[2];
#pragma unroll
    for (int i = 0; i < 2; ++i) { int R, C; stage_rc(tid * 16 + i * 8192, R, C); const int Rb = Epi::PERM ? ((R & ~31) + perm32(R & 31)) : R;
        voffA[i] = (unsigned)(R * K + C) * 2u; voffB[i] = (unsigned)(Rb * K + C) * 2u; }
    const size_t kstep = (size_t)(BK * 2);
    const size_t hstep = (size_t)HALF * K * 2;
    const size_t tstep = 2 * hstep;
    const unsigned ldsw = (unsigned)wid * 1024u;
    const int aoff = lds_byte(wr * 64 + fr, fq * 8), boff = lds_byte(wc * 32 + fr, fq * 8);
#define PG8_SA(b, h) (((b) * 2 + (h)) * HTB)
#define PG8_SB(b, h) ((4 + (b) * 2 + (h)) * HTB)
#define PG8_STAGE(bufoff, gbase, voff) do { _Pragma("unroll") for (int _i = 0; _i < 2; ++_i) \
        __builtin_amdgcn_global_load_lds((const unsigned*)((const char*)(gbase) + (voff)[_i]), (PG8_LAS unsigned*)(lds + (bufoff) + ldsw + _i * 8192), 16, 0, 0); } while (0)
#define PG8_LDA(dst, b, h) do { _Pragma("unroll") for (int m = 0; m < 4; ++m) _Pragma("unroll") for (int k = 0; k < 2; ++k) dst[m][k] = *(const PG8_LAS bf16x8*)(lds + PG8_SA(b, h) + aoff + m * 2048 + k * 1024); } while (0)
#define PG8_LDB(dst, b, h) do { _Pragma("unroll") for (int n = 0; n < 2; ++n) _Pragma("unroll") for (int k = 0; k < 2; ++k) dst[n][k] = *(const PG8_LAS bf16x8*)(lds + PG8_SB(b, h) + boff + n * 2048 + k * 1024); } while (0)
#define PG8_MMA(ai, bj, At, Bt) do { __builtin_amdgcn_s_setprio(1); _Pragma("unroll") for (int m = 0; m < 4; ++m) _Pragma("unroll") for (int n = 0; n < 2; ++n) _Pragma("unroll") for (int k = 0; k < 2; ++k) \
        acc[ai][bj][m][n] = __builtin_amdgcn_mfma_f32_16x16x32_bf16(Bt[n][k], At[m][k], acc[ai][bj][m][n], 0, 0, 0); __builtin_amdgcn_s_setprio(0); } while (0)
#define PG8_WAIT_V(n) asm volatile("s_waitcnt vmcnt(" #n ")" ::: "memory")
#define PG8_WAIT_L(n) asm volatile("s_waitcnt lgkmcnt(" #n ")" ::: "memory")
#define PG8_BAR __builtin_amdgcn_s_barrier()
#define PG8_SCHED __builtin_amdgcn_sched_barrier(0)
    Unit cur, nxt; int ui = 0;
    if (!S.next(0, cur)) return;
    f32x4 acc[2][2][4][2];
#pragma unroll
    for (int a = 0; a < 2; ++a)
#pragma unroll
        for (int b = 0; b < 2; ++b)
#pragma unroll
            for (int m = 0; m < 4; ++m)
#pragma unroll
                for (int n = 0; n < 2; ++n) acc[a][b][m][n] = (f32x4){0.f, 0.f, 0.f, 0.f};
    bf16x8 At[4][2], B0[2][2], B1[2][2];
    const char* cA = (const char*)g.A + (size_t)cur.pm * tstep + (size_t)cur.k0 * 2; const char* cB = (const char*)g.Bt + (size_t)cur.pn * tstep + (size_t)cur.k0 * 2;
    S.a_ready(cur);
    if constexpr (SP2) {
        PG8_STAGE(PG8_SB(0, 0), cB, voffB); PG8_STAGE(PG8_SB(0, 1), cB + hstep, voffB); PG8_STAGE(PG8_SA(0, 0), cA, voffA); PG8_STAGE(PG8_SA(0, 1), cA + hstep, voffA);
        if (wr == 1) PG8_BAR;
        PG8_WAIT_V(2); PG8_BAR;
        PG8_STAGE(PG8_SB(1, 0), cB + kstep, voffB); PG8_STAGE(PG8_SA(1, 0), cA + kstep, voffA); PG8_STAGE(PG8_SB(1, 1), cB + hstep + kstep, voffB);
        PG8_WAIT_V(6); PG8_BAR;
    } else {
        PG8_STAGE(PG8_SB(0, 0), cB, voffB); PG8_STAGE(PG8_SA(0, 0), cA, voffA); PG8_STAGE(PG8_SB(0, 1), cB + hstep, voffB); PG8_STAGE(PG8_SA(0, 1), cA + hstep, voffA);
        if (wr == 1) PG8_BAR;
        PG8_WAIT_V(4); PG8_BAR;
        PG8_STAGE(PG8_SB(1, 0), cB + kstep, voffB); PG8_STAGE(PG8_SA(1, 0), cA + kstep, voffA); PG8_STAGE(PG8_SB(1, 1), cB + hstep + kstep, voffB);
        PG8_WAIT_V(6); PG8_BAR;
    }
    for (;;) {
        const bool has_next = S.next(ui + 1, nxt);
        const char* nA = has_next ? (const char*)g.A + (size_t)nxt.pm * tstep + (size_t)nxt.k0 * 2 : cA; const char* nB = has_next ? (const char*)g.Bt + (size_t)nxt.pn * tstep + (size_t)nxt.k0 * 2 : cB;
        const int nt = cur.nt;
        for (int t = 0; t < nt; t += 2) {
            const bool last = (t == nt - 2);
            const char* a1 = cA + (size_t)(t + 1) * kstep;
            const char* a2 = last ? nA : cA + (size_t)(t + 2) * kstep; const char* b2 = last ? nB : cB + (size_t)(t + 2) * kstep;
            const char* a3 = a2 + kstep; const char* b3 = b2 + kstep;
            if (last && has_next) S.a_ready(nxt);
            if constexpr (SP2) {
            PG8_LDB(B0, 0, 0); PG8_LDB(B1, 0, 1); PG8_SCHED; PG8_LDA(At, 0, 0); PG8_STAGE(PG8_SA(1, 1), a1 + hstep, voffA);
            PG8_WAIT_V(8); PG8_WAIT_L(0); PG8_BAR; PG8_MMA(0, 0, At, B0); PG8_MMA(0, 1, At, B1); PG8_BAR; PG8_SCHED;
            PG8_LDA(At, 0, 1); PG8_STAGE(PG8_SB(0, 0), b2, voffB); PG8_STAGE(PG8_SB(0, 1), b2 + hstep, voffB); PG8_STAGE(PG8_SA(0, 0), a2, voffA);
            PG8_WAIT_V(8); PG8_WAIT_L(0); PG8_BAR; PG8_MMA(1, 0, At, B0); PG8_MMA(1, 1, At, B1); PG8_BAR; PG8_SCHED;
            PG8_LDB(B0, 1, 0); PG8_LDB(B1, 1, 1); PG8_SCHED; PG8_LDA(At, 1, 0); PG8_STAGE(PG8_SA(0, 1), a2 + hstep, voffA);
            PG8_WAIT_V(8); PG8_WAIT_L(0); PG8_BAR; PG8_MMA(0, 0, At, B0); PG8_MMA(0, 1, At, B1); PG8_BAR; PG8_SCHED;
            PG8_LDA(At, 1, 1); PG8_STAGE(PG8_SB(1, 0), b3, voffB); PG8_STAGE(PG8_SB(1, 1), b3 + hstep, voffB); PG8_STAGE(PG8_SA(1, 0), a3, voffA);
            PG8_WAIT_V(8); PG8_WAIT_L(0); PG8_BAR; PG8_MMA(1, 0, At, B0); PG8_MMA(1, 1, At, B1); PG8_BAR; PG8_SCHED;
            } else {
            PG8_LDB(B0, 0, 0); PG8_SCHED; PG8_LDA(At, 0, 0); PG8_STAGE(PG8_SA(1, 1), a1 + hstep, voffA);
            PG8_WAIT_L(8); PG8_BAR; PG8_WAIT_L(0); PG8_MMA(0, 0, At, B0); PG8_BAR; PG8_SCHED;
            PG8_LDB(B1, 0, 1); PG8_STAGE(PG8_SB(0, 0), b2, voffB);
            PG8_BAR; PG8_WAIT_L(0); PG8_MMA(0, 1, At, B1); PG8_BAR;
            PG8_LDA(At, 0, 1); PG8_STAGE(PG8_SA(0, 0), a2, voffA);
            PG8_BAR; PG8_WAIT_L(0); PG8_MMA(1, 0, At, B0); PG8_BAR; PG8_SCHED;
            PG8_STAGE(PG8_SB(0, 1), b2 + hstep, voffB);
            PG8_WAIT_V(6); PG8_BAR; PG8_MMA(1, 1, At, B1); PG8_BAR;
            PG8_LDB(B0, 1, 0); PG8_SCHED; PG8_LDA(At, 1, 0); PG8_STAGE(PG8_SA(0, 1), a2 + hstep, voffA);
            PG8_WAIT_L(8); PG8_BAR; PG8_WAIT_L(0); PG8_MMA(0, 0, At, B0); PG8_BAR; PG8_SCHED;
            PG8_LDB(B1, 1, 1); PG8_STAGE(PG8_SB(1, 0), b3, voffB);
            PG8_BAR; PG8_WAIT_L(0); PG8_MMA(0, 1, At, B1); PG8_BAR;
            PG8_LDA(At, 1, 1); PG8_STAGE(PG8_SA(1, 0), a3, voffA);
            PG8_BAR; PG8_WAIT_L(0); PG8_MMA(1, 0, At, B0); PG8_BAR; PG8_SCHED;
            PG8_STAGE(PG8_SB(1, 1), b3 + hstep, voffB);
            PG8_WAIT_V(6); PG8_BAR; PG8_MMA(1, 1, At, B1); PG8_BAR;
            }
        }
        if constexpr (ALIGN_EPI) { if (wr == 0) PG8_BAR; }
        if constexpr (!Epi::AFTER_DRAIN) { E(acc, cur, wr, wc, fr, fq); S.done(cur); }
        if (!has_next) break;
#pragma unroll
        for (int a = 0; a < 2; ++a)
#pragma unroll
            for (int b = 0; b < 2; ++b)
#pragma unroll
                for (int m = 0; m < 4; ++m)
#pragma unroll
                    for (int n = 0; n < 2; ++n) acc[a][b][m][n] = (f32x4){0.f, 0.f, 0.f, 0.f};
        cur = nxt; cA = nA; cB = nB; ++ui;
        if constexpr (ALIGN_EPI) { if (wr == 1) PG8_BAR; }
    }
    PG8_WAIT_V(0);
    if constexpr (!ALIGN_EPI) { if (wr == 0) PG8_BAR; }
    PG8_BAR;
    if constexpr (Epi::AFTER_DRAIN) { E.fused(acc, cur, wr, wc, fr, fq, lds, wid, lane); S.done(cur); }
#undef PG8_SA
#undef PG8_SB
#undef PG8_STAGE
#undef PG8_LDA
#undef PG8_LDB
#undef PG8_MMA
#undef PG8_WAIT_V
#undef PG8_WAIT_L
#undef PG8_BAR
#undef PG8_SCHED
}

}

constexpr int DMODEL = 2048, NPR = 8192  , NSM = 512  , MROWS = NPR + NSM;
constexpr int DPOOL = 1024, DSSM = 3072, DCONV = 5120, NHEAD = 48, HDIM = 64, NGRP = 8, DSTATE = 128, DMIX = 4096;
constexpr int NPROJ = 10288, PLD = 10240  , NPROJ_PAD = 10496  ;
constexpr int C_GATE = 1024, C_Z = 2048, C_XBC = 5120;
constexpr float EPS = 1e-5f;
constexpr size_t O_Y = 0, O_POOL_P = 17825792, O_CONV_P = 17887232, O_SSM_P = 17948672, O_POOL_S = 19521536, O_CONV_S = 21487616, O_SSM_S = 23453696;
constexpr size_t MiB = 1u << 20;
constexpr size_t WS_CTL = 0, CTL_ZERO_BYTES = 1 * MiB;
constexpr size_t WS_XN = 2 * MiB;
constexpr size_t WS_WINT = 36 * MiB;
constexpr size_t WS_WOUTT = 78 * MiB;
constexpr size_t WS_PROJ = 96 * MiB;
constexpr size_t WS_DTRAW = 268 * MiB;
constexpr size_t WS_MIX = 272 * MiB;
constexpr size_t WS_YBUF = 344 * MiB;
constexpr size_t WS_ST = 448 * MiB;
constexpr size_t WS_SIN = 544 * MiB;
constexpr size_t WS_CHDEC = 592 * MiB;
constexpr size_t WS_PWT = 593 * MiB;
constexpr size_t WS_END = 594 * MiB;
constexpr int CW_BAR = 4096;
constexpr int NWAVES = 8, NTHR = 512;
constexpr int RING_BYTES = 131072, LDSCTL_OFF = RING_BYTES, MISC_OFF = LDSCTL_OFF + 320, LDS_BYTES = 147456;

#define GAS __attribute__((address_space(1)))
#define LAS __attribute__((address_space(3)))
typedef unsigned short bf16;
typedef unsigned v4u __attribute__((ext_vector_type(4)));
typedef float f32x4 __attribute__((ext_vector_type(4)));
#define LDS_WAIT() asm volatile("s_waitcnt lgkmcnt(0)" ::: "memory")
#define VM_WAIT() asm volatile("s_waitcnt vmcnt(0)" ::: "memory")
__device__ __forceinline__ unsigned f2bf(float f) { unsigned u = __builtin_bit_cast(unsigned, f); return (u + 0x7fffu + ((u >> 16) & 1u)) >> 16; }
__device__ __forceinline__ unsigned pk2(float lo, float hi) { return f2bf(lo) | (f2bf(hi) << 16); }
__device__ __forceinline__ float bf2f(bf16 v) { return __builtin_bit_cast(float, (unsigned)v << 16); }
__device__ __forceinline__ float silu_f(float x) { return x * __builtin_amdgcn_rcpf(1.f + __expf(-x)); }
__device__ __forceinline__ float softplus_f(float x) { return fmaxf(x, 0.f) + log1pf(__expf(-fabsf(x))); }
__device__ __forceinline__ float wave_sum(float v) {
#pragma unroll
    for (int o = 1; o < 64; o <<= 1) v += __shfl_xor(v, o);
    return v;
}

#define XB_TMO      128
#define XB_XCNT(j)  (256  + 64 * (j))
#define XB_XSUB(j)  (1280 + 64 * (j))
#define XB_XGEN(j)  (2304 + 64 * (j))
#define XB_TOP      3328
#define XB_TOPGEN   3392
#define XCD_BAR_WORDS 3456
#define XB_SPIN_CAP (1u << 18)

__device__ __forceinline__ unsigned xb_ld(unsigned* p)              { return __hip_atomic_load(p, __ATOMIC_RELAXED, __HIP_MEMORY_SCOPE_AGENT); }
__device__ __forceinline__ unsigned xb_add(unsigned* p, unsigned v) { return __hip_atomic_fetch_add(p, v, __ATOMIC_RELAXED, __HIP_MEMORY_SCOPE_AGENT); }
__device__ __forceinline__ unsigned xb_xcc_id() { return (unsigned)__builtin_amdgcn_s_getreg((3 << 11) | 20) & 0xFu; }
#define XB_SPIN(cond, bar) do { unsigned _sp = 0; while (cond) { __builtin_amdgcn_s_sleep(1); \
    if ((++_sp & 255u) == 0u) { if (xb_ld(&(bar)[XB_TMO])) break; if (_sp > XB_SPIN_CAP) { atomicAdd(&(bar)[XB_TMO], 1u); break; } } } } while (0)

struct XcdBarrier {
    unsigned* bar; unsigned x;
    volatile LAS unsigned* st;
};

__device__ __forceinline__ XcdBarrier xcd_barrier_post(unsigned* bar, volatile LAS unsigned* st) {
    XcdBarrier b; b.bar = bar; b.x = xb_xcc_id(); b.st = st;
    if (threadIdx.x == 0) (void)xb_add(&bar[XB_XCNT(b.x)], 1u);
    return b;
}
__device__ __forceinline__ void xcd_barrier_complete(unsigned* bar, unsigned x, unsigned& nloc, unsigned& nx) {
    const unsigned G = gridDim.x * gridDim.y * gridDim.z;
    unsigned sum, cnt, mine, sp = 0u;
    for (;;) {
        sum = 0u; cnt = 0u; mine = 0u;
#pragma unroll
        for (unsigned j = 0; j < 16; ++j) { const unsigned c = xb_ld(&bar[XB_XCNT(j)]); sum += c; cnt += (c > 0u) ? 1u : 0u; mine = (j == x) ? c : mine; }
        if (sum == G) break;
        __builtin_amdgcn_s_sleep(1);
        if ((++sp & 255u) == 0u) { if (xb_ld(&bar[XB_TMO])) break; if (sp > XB_SPIN_CAP) { atomicAdd(&bar[XB_TMO], 1u); break; } }
    }
    nloc = mine > 0u ? mine : 1u; nx = cnt > 0u ? cnt : 1u;
}

__device__ __forceinline__ void xcd_barrier(const XcdBarrier& b) {
    asm volatile("s_waitcnt vmcnt(0)" ::: "memory");
    __syncthreads();
    if (threadIdx.x == 0) {
        unsigned* bar = b.bar;
        __builtin_amdgcn_s_waitcnt(0);
        unsigned nloc = b.st[0], nx = b.st[1];
        if (nloc == 0u) { xcd_barrier_complete(bar, b.x, nloc, nx); b.st[0] = nloc; b.st[1] = nx; }
        const unsigned old = xb_add(&bar[XB_XSUB(b.x)], 1u);
        const unsigned gen = old / nloc;
        if (old + 1u == (gen + 1u) * nloc) {
            __builtin_amdgcn_fence(__ATOMIC_RELEASE, "agent");
            asm volatile("s_waitcnt vmcnt(0)" ::: "memory");
            const unsigned og = xb_add(&bar[XB_TOP], 1u);
            const unsigned tg = og / nx;
            if (og + 1u == (tg + 1u) * nx) xb_add(&bar[XB_TOPGEN], 1u);
            else XB_SPIN(xb_ld(&bar[XB_TOPGEN]) == tg, bar);
            __builtin_amdgcn_fence(__ATOMIC_ACQUIRE, "agent");
            xb_add(&bar[XB_XGEN(b.x)], 1u);
            asm volatile("s_waitcnt vmcnt(0)" ::: "memory");
        } else {
            XB_SPIN(xb_ld(&bar[XB_XGEN(b.x)]) == gen, bar);
            __builtin_amdgcn_fence(__ATOMIC_ACQUIRE, "agent");
            asm volatile("s_waitcnt vmcnt(0)" ::: "memory");
        }
    }
    __syncthreads();
}


struct Args { const float* in[17]; float* out; unsigned char* ws; int ph_lo, ph_hi; };
struct Frame {
    LAS unsigned char* lds;
    int tid, lane, wave, G, bid;
    const Args& A;
    __device__ __forceinline__ const float* x_prompt() const { return A.in[0]; }
    __device__ __forceinline__ const float* x_sample() const { return A.in[1]; }
    __device__ __forceinline__ const float* state_pool() const { return A.in[2]; }
    __device__ __forceinline__ const float* state_conv() const { return A.in[3]; }
    __device__ __forceinline__ const float* state_ssm() const { return A.in[4]; }
    __device__ __forceinline__ const float* norm_g() const { return A.in[5]; }
    __device__ __forceinline__ const float* w_in() const { return A.in[6]; }
    __device__ __forceinline__ const float* conv_w() const { return A.in[7]; }
    __device__ __forceinline__ const float* conv_b() const { return A.in[8]; }
    __device__ __forceinline__ const float* dt_bias() const { return A.in[9]; }
    __device__ __forceinline__ const float* a_log() const { return A.in[10]; }
    __device__ __forceinline__ const float* d_skip() const { return A.in[11]; }
    __device__ __forceinline__ const float* ssm_norm_g() const { return A.in[12]; }
    __device__ __forceinline__ const float* pool_w() const { return A.in[13]; }
    __device__ __forceinline__ const float* pool_scale() const { return A.in[14]; }
    __device__ __forceinline__ const float* w_out() const { return A.in[15]; }
    __device__ __forceinline__ const float* final_g() const { return A.in[16]; }
    __device__ __forceinline__ bf16* XN() const { return (bf16*)(A.ws + WS_XN); }
    __device__ __forceinline__ bf16* WinT() const { return (bf16*)(A.ws + WS_WINT); }
    __device__ __forceinline__ bf16* WoutT() const { return (bf16*)(A.ws + WS_WOUTT); }
    __device__ __forceinline__ bf16* PROJ() const { return (bf16*)(A.ws + WS_PROJ); }
    __device__ __forceinline__ bf16* MIX() const { return (bf16*)(A.ws + WS_MIX); }
    __device__ __forceinline__ bf16* SIN() const { return (bf16*)(A.ws + WS_SIN); }
    __device__ __forceinline__ bf16* PWT() const { return (bf16*)(A.ws + WS_PWT); }
    __device__ __forceinline__ float* DTRAW() const { return (float*)(A.ws + WS_DTRAW); }
    __device__ __forceinline__ float* YBUF() const { return (float*)(A.ws + WS_YBUF); }
    __device__ __forceinline__ float* ST() const { return (float*)(A.ws + WS_ST); }
    __device__ __forceinline__ float* CHDEC() const { return (float*)(A.ws + WS_CHDEC); }
    __device__ __forceinline__ float* out() const { return A.out; }
};

__device__ __forceinline__ void p0_transpose_item(const float* W, int K, int N, bf16* WT, LAS float* scr, int item, int lane) {
    const int nblk = (N + 31) / 32, kb = item / nblk, nb = item % nblk, k0 = 64 * kb, n0 = 32 * nb;
    const bool ok = (n0 + (lane & 31)) < N;
    float tv[32];
#pragma unroll
    for (int i = 0; i < 32; ++i) { const int kk = 2 * i + (lane >> 5); tv[i] = ok ? W[(size_t)(k0 + kk) * N + n0 + (lane & 31)] : 0.f; }
#pragma unroll
    for (int i = 0; i < 32; ++i) { const int kk = 2 * i + (lane >> 5); scr[kk * 33 + (lane & 31)] = tv[i]; }
    LDS_WAIT(); asm volatile("" ::: "memory");
    const int c = lane & 7;
#pragma unroll
    for (int j = 0; j < 4; ++j) { const int n = (lane >> 3) + 8 * j; const LAS float* s = scr + (8 * c) * 33 + n;
        v4u o; o.x = pk2(s[0 * 33], s[1 * 33]); o.y = pk2(s[2 * 33], s[3 * 33]); o.z = pk2(s[4 * 33], s[5 * 33]); o.w = pk2(s[6 * 33], s[7 * 33]);
        *(GAS v4u*)(WT + (size_t)(n0 + n) * K + k0 + 8 * c) = o; }
    LDS_WAIT(); asm volatile("" ::: "memory");
}
__device__ __forceinline__ void p0_prologue(Frame& F) {
    LAS float* scr = (LAS float*)(F.lds + F.wave * 16384);
    const int gw = F.bid * NWAVES + F.wave, NGW = F.G * NWAVES;
    constexpr int I_IN = (DMODEL / 64) * ((NPROJ + 31) / 32), I_OUT = (DMIX / 64) * (DMODEL / 32);
    for (int it = gw; it < I_IN + I_OUT + 128; it += NGW) {
        if (it < I_IN) p0_transpose_item(F.w_in(), DMODEL, NPROJ, F.WinT(), scr, it, F.lane);
        else if (it < I_IN + I_OUT) p0_transpose_item(F.w_out(), DMIX, DMODEL, F.WoutT(), scr, it - I_IN, F.lane);
        else { const int j = it - I_IN - I_OUT; p0_transpose_item(F.pool_w() + (size_t)(j >> 5) * 65536, 256, 256, F.PWT() + (size_t)(j >> 5) * 65536, scr, j & 31, F.lane); }
    }
    { const size_t z0 = (size_t)10304 * DMODEL * 2, z1 = (size_t)NPROJ_PAD * DMODEL * 2; GAS v4u* zp = (GAS v4u*)((unsigned char*)F.WinT() + z0);
      const size_t nz = (z1 - z0) / 16; for (size_t i = (size_t)F.bid * NTHR + F.tid; i < nz; i += (size_t)F.G * NTHR) zp[i] = (v4u){0u, 0u, 0u, 0u}; }
    for (int m = gw; m < MROWS; m += NGW) {
        const float* xrow = (m < NPR) ? F.x_prompt() + (size_t)m * DMODEL : F.x_sample() + (size_t)(m - NPR) * DMODEL;
        const GAS f32x4* xr = (const GAS f32x4*)xrow + F.lane; const GAS f32x4* gr = (const GAS f32x4*)F.norm_g() + F.lane;
        f32x4 v[8]; float s = 0.f;
#pragma unroll
        for (int j = 0; j < 8; ++j) { v[j] = xr[64 * j]; s += (v[j].x * v[j].x + v[j].y * v[j].y) + (v[j].z * v[j].z + v[j].w * v[j].w); }
        const float r = 1.f / sqrtf(wave_sum(s) * (1.f / DMODEL) + EPS);
        GAS unsigned long long* o8 = (GAS unsigned long long*)(F.XN() + (size_t)m * DMODEL) + F.lane;
#pragma unroll
        for (int j = 0; j < 8; ++j) { const f32x4 g = gr[64 * j]; o8[64 * j] = (unsigned long long)pk2(v[j].x * r * g.x, v[j].y * r * g.y) | ((unsigned long long)pk2(v[j].z * r * g.z, v[j].w * r * g.w) << 32); }
    }
}

__device__ __forceinline__ void pool_unit(Frame& F, int tile, int gi) {
    LAS float* pooled = (LAS float*)F.lds;
    const int w = 2 << gi, m0 = tile * 32, c = F.tid & 255, th = F.tid >> 8, ch = gi * 256 + c;
    for (int i = 0; i < 16; ++i) {
        const int t = th * 16 + i, m = m0 + t; const bool prompt = m < NPR;
        int b, tq, cnt; if (prompt) { b = m >> 11; tq = m & 2047; cnt = min(w, tq + 1); } else { const int ms = m - NPR; b = ms >> 2; tq = ms & 3; cnt = w; }
        float sum = 0.f;
        for (int j = 0; j < w; ++j) { const int tt = tq - j; float v;
            if (tt >= 0) v = bf2f(F.PROJ()[(size_t)(m - j) * PLD + ch]); else v = prompt ? 0.f : F.state_pool()[(size_t)(b * 15 + 15 + tt) * DPOOL + ch];
            sum += v; }
        const float u0 = bf2f(F.PROJ()[(size_t)m * PLD + ch]);
        pooled[t * 256 + c] = sum / (float)cnt - u0;
    }
    __syncthreads();
    float acc[16];
#pragma unroll
    for (int i = 0; i < 16; ++i) acc[i] = 0.f;
    const float* W = F.pool_w() + (size_t)gi * 65536 + c;
    for (int c4 = 0; c4 < 64; ++c4) {
        const float w0 = W[(size_t)(4 * c4 + 0) * 256], w1 = W[(size_t)(4 * c4 + 1) * 256], w2 = W[(size_t)(4 * c4 + 2) * 256], w3 = W[(size_t)(4 * c4 + 3) * 256];
#pragma unroll
        for (int i = 0; i < 16; ++i) { const f32x4 p4 = *(const LAS f32x4*)(pooled + (th * 16 + i) * 256 + 4 * c4); acc[i] += (p4.x * w0 + p4.y * w1) + (p4.z * w2 + p4.w * w3); }
    }
    const float sc = F.pool_scale()[ch];
#pragma unroll
    for (int i = 0; i < 16; ++i) { const int m = m0 + th * 16 + i; const float gate = bf2f(F.PROJ()[(size_t)m * PLD + C_GATE + ch]);
        F.MIX()[(size_t)m * DMIX + ch] = (bf16)f2bf(acc[i] * sc * silu_f(gate)); }
    __syncthreads();
}

__device__ __forceinline__ void ssd_unit(Frame& F, int seq, int h) {
    const bool prompt = seq < 4; const int L = prompt ? 2048 : 4, sb = seq - 4, row0 = prompt ? seq * 2048 : NPR + sb * 4, g = h / 6;
    const int p = F.tid >> 3, nq = F.tid & 7;
    LAS float* T = (LAS float*)F.lds;
    LAS float* dts = T + 32 * 320; LAS float* dec = dts + 32;
    float S[16];
    if (prompt) {
#pragma unroll
        for (int j = 0; j < 16; ++j) S[j] = 0.f;
    } else { const f32x4* sp = (const f32x4*)(F.state_ssm() + ((size_t)(sb * NHEAD + h) * HDIM + p) * DSTATE + nq * 16);
#pragma unroll
        for (int q = 0; q < 4; ++q) { const f32x4 v = sp[q]; S[4 * q] = v.x; S[4 * q + 1] = v.y; S[4 * q + 2] = v.z; S[4 * q + 3] = v.w; } }
    const float a = -__expf(F.a_log()[h]), dtb = F.dt_bias()[h], dsk = F.d_skip()[h];
    for (int t0 = 0; t0 < L; t0 += 32) {
        const int nt = min(32, L - t0);
        __syncthreads();
        for (int e = F.tid; e < nt * 320; e += NTHR) {
            const int t = e / 320, c = e - t * 320;
            const int xch = c < 64 ? h * 64 + c : (c < 192 ? 3072 + g * 128 + (c - 64) : 4096 + g * 128 + (c - 192));
            float acc = F.conv_b()[xch];
#pragma unroll
            for (int k = 0; k < 4; ++k) { const int tt = t0 + t + k - 3; float v;
                if (tt >= 0) v = bf2f(F.PROJ()[(size_t)(row0 + tt) * PLD + C_XBC + xch]); else v = prompt ? 0.f : F.state_conv()[(size_t)(sb * 3 + 3 + tt) * DCONV + xch];
                acc += v * F.conv_w()[k * DCONV + xch]; }
            T[e] = silu_f(acc);
        }
        for (int t = F.tid; t < nt; t += NTHR) { const float dt = softplus_f(F.DTRAW()[(size_t)(row0 + t0 + t) * 64 + h] + dtb); dts[t] = dt; dec[t] = __expf(dt * a); }
        __syncthreads();
        for (int t = 0; t < nt; ++t) {
            const LAS float* r = T + t * 320;
            const float x = r[p], d = dec[t], dtx = dts[t] * x; float acc = 0.f;
#pragma unroll
            for (int q = 0; q < 4; ++q) { const f32x4 bv = *(const LAS f32x4*)(r + 64 + nq * 16 + 4 * q), cv = *(const LAS f32x4*)(r + 192 + nq * 16 + 4 * q);
                S[4 * q] = d * S[4 * q] + dtx * bv.x; S[4 * q + 1] = d * S[4 * q + 1] + dtx * bv.y; S[4 * q + 2] = d * S[4 * q + 2] + dtx * bv.z; S[4 * q + 3] = d * S[4 * q + 3] + dtx * bv.w;
                acc += (cv.x * S[4 * q] + cv.y * S[4 * q + 1]) + (cv.z * S[4 * q + 2] + cv.w * S[4 * q + 3]); }
            acc += __shfl_xor(acc, 1); acc += __shfl_xor(acc, 2); acc += __shfl_xor(acc, 4);
            if (nq == 0) F.YBUF()[(size_t)(row0 + t0 + t) * DSSM + h * 64 + p] = acc + dsk * x;
        }
    }
    float* so = F.out() + (prompt ? O_SSM_P + ((size_t)(seq * NHEAD + h) * HDIM + p) * DSTATE : O_SSM_S + ((size_t)(sb * NHEAD + h) * HDIM + p) * DSTATE) + nq * 16;
#pragma unroll
    for (int q = 0; q < 4; ++q) *(f32x4*)(so + 4 * q) = (f32x4){S[4 * q], S[4 * q + 1], S[4 * q + 2], S[4 * q + 3]};
    __syncthreads();
}


typedef short s16x8 __attribute__((ext_vector_type(8)));
typedef float f32x16 __attribute__((ext_vector_type(16)));
typedef unsigned u32x2 __attribute__((ext_vector_type(2)));
typedef float f32x2 __attribute__((ext_vector_type(2)));
constexpr int PT = 272;
__device__ __forceinline__ unsigned cvtpk(float lo, float hi) { return pg8::cvt_pk_bf16(lo, hi); }
__device__ __forceinline__ float bflo(unsigned w) { return __builtin_bit_cast(float, w << 16); }
__device__ __forceinline__ float bfhi(unsigned w) { return __builtin_bit_cast(float, w & 0xffff0000u); }
__device__ __forceinline__ f32x16 mfma32(s16x8 a, s16x8 b, f32x16 c) { return __builtin_amdgcn_mfma_f32_32x32x16_bf16(a, b, c, 0, 0, 0); }
__device__ __forceinline__ s16x8 ldfrag(const LAS unsigned char* img, int row, int ks, int hh) { return *(const LAS s16x8*)(img + row * PT + ks * 32 + hh * 16); }
__device__ __forceinline__ void conv_load(const Frame& F, int seq_row0, int t0, int xch, unsigned (&raw)[11]) {
    const bf16* base = F.PROJ() + (size_t)seq_row0 * PLD + C_XBC + xch;
#pragma unroll
    for (int i = 0; i < 11; ++i) { const int t = t0 - 3 + i; raw[i] = (t >= 0) ? *(const unsigned*)(base + (size_t)t * PLD) : 0u; }
}
__device__ __forceinline__ void conv_fin(const Frame& F, int xch, const unsigned (&raw)[11], float (&o0)[8], float (&o1)[8]) {
    f32x2 w[4];
#pragma unroll
    for (int k = 0; k < 4; ++k) w[k] = *(const f32x2*)(F.conv_w() + k * DCONV + xch);
    const f32x2 bb = *(const f32x2*)(F.conv_b() + xch);
#pragma unroll
    for (int o = 0; o < 8; ++o) { float a0 = bb.x, a1 = bb.y;
#pragma unroll
        for (int k = 0; k < 4; ++k) { a0 += bflo(raw[o + k]) * w[k].x; a1 += bfhi(raw[o + k]) * w[k].y; }
        o0[o] = silu_f(a0); o1[o] = silu_f(a1); }
}
__device__ __forceinline__ void conv8x2(const Frame& F, int seq_row0, int t0, int xch, float (&o0)[8], float (&o1)[8]) { unsigned raw[11]; conv_load(F, seq_row0, t0, xch, raw); conv_fin(F, xch, raw, o0, o1); }
__device__ __forceinline__ v4u pack8(const float (&o)[8]) { v4u r; r.x = cvtpk(o[0], o[1]); r.y = cvtpk(o[2], o[3]); r.z = cvtpk(o[4], o[5]); r.w = cvtpk(o[6], o[7]); return r; }
__device__ __forceinline__ void chunk_dt(const Frame& F, int row0, int g, LAS float* dtl, LAS float* Ac) {
    if (F.wave < 6) {
        const int h = 6 * g + F.wave; const float a = -__expf(F.a_log()[h]), bias = F.dt_bias()[h]; const int l0 = 2 * F.lane;
        const float d0 = softplus_f(F.DTRAW()[(size_t)(row0 + l0) * 64 + h] + bias), d1 = softplus_f(F.DTRAW()[(size_t)(row0 + l0 + 1) * 64 + h] + bias);
        const float e0 = d0 * a, e1 = d1 * a; float s = e0 + e1;
#pragma unroll
        for (int o = 1; o < 64; o <<= 1) { const float u = __shfl_up(s, o); if (F.lane >= o) s += u; }
        dtl[F.wave * 128 + l0] = d0; dtl[F.wave * 128 + l0 + 1] = d1; Ac[F.wave * 128 + l0] = s - e1; Ac[F.wave * 128 + l0 + 1] = s;
    }
}
__device__ __forceinline__ void p2a_unit(Frame& F, int b, int c, int g) {
    LAS unsigned char* XwT = F.lds;
    LAS unsigned char* BT = F.lds + 52224;
    LAS float* dtl = (LAS float*)(F.lds + 87040); LAS float* Ac = (LAS float*)(F.lds + 90112);
    const int seq_row0 = b * 2048, tok0 = c * 128, row0 = seq_row0 + tok0, hh = F.lane >> 5, l31 = F.lane & 31;
    __syncthreads();
    chunk_dt(F, row0, g, dtl, Ac);
    { unsigned raw[2][11];
#pragma unroll
      for (int j = 0; j < 2; ++j) { const int it = F.tid + NTHR * j, cp = it & 63, to = it >> 6; conv_load(F, seq_row0, tok0 + 8 * to, 3072 + g * 128 + 2 * cp, raw[j]); }
#pragma unroll
      for (int j = 0; j < 2; ++j) { const int it = F.tid + NTHR * j, cp = it & 63, to = it >> 6; float o0[8], o1[8];
        conv_fin(F, 3072 + g * 128 + 2 * cp, raw[j], o0, o1);
        *(LAS v4u*)(BT + (2 * cp) * PT + to * 16) = pack8(o0); *(LAS v4u*)(BT + (2 * cp + 1) * PT + to * 16) = pack8(o1); } }
    __syncthreads();
    if (F.tid < 6) F.CHDEC()[(size_t)(b * 16 + c) * NHEAD + 6 * g + F.tid] = __expf(Ac[F.tid * 128 + 127]);
    for (int half = 0; half < 2; ++half) {
        if (half) __syncthreads();
        unsigned raw[3][11];
#pragma unroll
        for (int j = 0; j < 3; ++j) { const int it = F.tid + NTHR * j, cp = it % 96, to = it / 96, ch = 2 * cp, rl = ch >> 6, p = ch & 63, r = 3 * half + rl;
            conv_load(F, seq_row0, tok0 + 8 * to, (6 * g + r) * 64 + p, raw[j]); }
#pragma unroll
        for (int j = 0; j < 3; ++j) { const int it = F.tid + NTHR * j, cp = it % 96, to = it / 96, ch = 2 * cp, rl = ch >> 6, p = ch & 63, r = 3 * half + rl; float o0[8], o1[8];
            conv_fin(F, (6 * g + r) * 64 + p, raw[j], o0, o1);
            const float aend = Ac[r * 128 + 127];
#pragma unroll
            for (int o = 0; o < 8; ++o) { const float wl = __expf(aend - Ac[r * 128 + 8 * to + o]) * dtl[r * 128 + 8 * to + o]; o0[o] *= wl; o1[o] *= wl; }
            *(LAS v4u*)(XwT + (rl * 64 + p) * PT + to * 16) = pack8(o0); *(LAS v4u*)(XwT + (rl * 64 + p + 1) * PT + to * 16) = pack8(o1); }
        __syncthreads();
        const int pi = F.wave >> 2, ni = F.wave & 3;
        for (int rl = 0; rl < 3; ++rl) {
            f32x16 acc;
#pragma unroll
            for (int i = 0; i < 16; ++i) acc[i] = 0.f;
#pragma unroll
            for (int ks = 0; ks < 8; ++ks) acc = mfma32(ldfrag(XwT, rl * 64 + 32 * pi + l31, ks, hh), ldfrag(BT, 32 * ni + l31, ks, hh), acc);
            const int h = 6 * g + 3 * half + rl;
            float* so = F.ST() + ((size_t)((b * 16 + c) * NHEAD + h) * HDIM) * DSTATE + 32 * ni + l31;
#pragma unroll
            for (int i = 0; i < 16; ++i) { const int p = 32 * pi + (i & 3) + 8 * (i >> 2) + 4 * hh; so[(size_t)p * DSTATE] = acc[i]; }
        }
    }
}
__device__ __forceinline__ void p2b_scan(Frame& F) {
    const int gt = F.bid * NTHR + F.tid, GT = F.G * NTHR;
    for (int i = gt; i < 4 * NHEAD * 2048; i += GT) {
        const int b = i / (NHEAD * 2048), rem = i - b * (NHEAD * 2048), h = rem >> 11, e = rem & 2047;
        f32x4 st[16];
#pragma unroll
        for (int c = 0; c < 16; ++c) st[c] = *((const f32x4*)F.ST() + ((size_t)((b * 16 + c) * NHEAD + h) * 2048 + e));
        f32x4 s = (f32x4){0.f, 0.f, 0.f, 0.f};
#pragma unroll
        for (int c = 0; c < 16; ++c) {
            u32x2 pk; pk.x = cvtpk(s.x, s.y); pk.y = cvtpk(s.z, s.w);
            *((u32x2*)F.SIN() + ((size_t)((b * 16 + c) * NHEAD + h) * 2048 + e)) = pk;
            const float d = F.CHDEC()[(size_t)(b * 16 + c) * NHEAD + h];
            s = s * d + st[c];
        }
        *((f32x4*)(F.out() + O_SSM_P) + ((size_t)(b * NHEAD + h) * 2048 + e)) = s;
    }
}
__device__ __forceinline__ void p2c_unit(Frame& F, int b, int c, int g) {
    LAS unsigned char* Cn = F.lds;
    LAS unsigned char* Bn = F.lds + 34816;
    LAS unsigned char* XT = F.lds + 69632;
    LAS float* dtl = (LAS float*)(F.lds + 87040); LAS float* Ac = (LAS float*)(F.lds + 90112);
    LAS float* part = (LAS float*)(F.lds + 93184);
    const int seq_row0 = b * 2048, tok0 = c * 128, row0 = seq_row0 + tok0, hh = F.lane >> 5, l31 = F.lane & 31;
    const int li = F.wave >> 1, sh = F.wave & 1, pj = F.wave & 1, l = 32 * li + l31;
    const int xcp = F.tid & 31, xto = F.tid >> 5;
    const bf16* zrow = F.PROJ() + (size_t)(row0 + l) * PLD + C_Z + 32 * pj + 4 * hh;
    const bf16* sing = F.SIN() + ((size_t)((b * 16 + c) * NHEAD) * HDIM + 32 * pj + l31) * DSTATE + 8 * hh;
    __syncthreads();
    chunk_dt(F, row0, g, dtl, Ac);
    { unsigned raw[4][11];
#pragma unroll
      for (int j = 0; j < 4; ++j) { const int it = F.tid + NTHR * j, isC = it >> 10, cp = it & 63, to = (it >> 6) & 15; conv_load(F, seq_row0, tok0 + 8 * to, 3072 + isC * 1024 + g * 128 + 2 * cp, raw[j]); }
#pragma unroll
      for (int j = 0; j < 4; ++j) { const int it = F.tid + NTHR * j, isC = it >> 10, cp = it & 63, to = (it >> 6) & 15; float o0[8], o1[8];
        conv_fin(F, 3072 + isC * 1024 + g * 128 + 2 * cp, raw[j], o0, o1);
        LAS unsigned char* img = (isC ? Cn : Bn) + (8 * to) * PT + cp * 4;
#pragma unroll
        for (int o = 0; o < 8; ++o) *(LAS unsigned*)(img + o * PT) = cvtpk(o0[o], o1[o]); } }
    unsigned rawx[11];
    conv_load(F, seq_row0, tok0 + 8 * xto, (6 * g) * 64 + 2 * xcp, rawx);
    __syncthreads();
    f32x16 gt0, gt1;
#pragma unroll
    for (int i = 0; i < 16; ++i) { gt0[i] = 0.f; gt1[i] = 0.f; }
    if (2 * sh <= li) {
#pragma unroll
        for (int ks = 0; ks < 8; ++ks) gt0 = mfma32(ldfrag(Bn, 64 * sh + l31, ks, hh), ldfrag(Cn, l, ks, hh), gt0);
    }
    if (2 * sh + 1 <= li) {
#pragma unroll
        for (int ks = 0; ks < 8; ++ks) gt1 = mfma32(ldfrag(Bn, 64 * sh + 32 + l31, ks, hh), ldfrag(Cn, l, ks, hh), gt1);
    }
    float ss = 0.f;
    bf16* mrow = F.MIX() + (size_t)(row0 + l) * DMIX + DPOOL + 32 * pj + 4 * hh;
#pragma unroll 1
    for (int r = 0; r < 6; ++r) {
        const int h = 6 * g + r; const float dsk = F.d_skip()[h];
        __syncthreads();
        v4u sinc[8]; u32x2 zc[4];
#pragma unroll
        for (int ks = 0; ks < 8; ++ks) sinc[ks] = *(const v4u*)(sing + (size_t)h * HDIM * DSTATE + 16 * ks);
#pragma unroll
        for (int q = 0; q < 4; ++q) zc[q] = *(const u32x2*)(zrow + h * 64 + 8 * q);
        { float o0[8], o1[8]; conv_fin(F, h * 64 + 2 * xcp, rawx, o0, o1);
          *(LAS v4u*)(XT + (2 * xcp) * PT + xto * 16) = pack8(o0); *(LAS v4u*)(XT + (2 * xcp + 1) * PT + xto * 16) = pack8(o1); }
        { const float Al = Ac[r * 128 + l];
#pragma unroll
          for (int tsel = 0; tsel < 2; ++tsel) { const int si = 2 * sh + tsel;
            if (si <= li) {
#pragma unroll
                for (int q = 0; q < 4; ++q) { const int s0 = 32 * si + 8 * q + 4 * hh;
                    const f32x4 As4 = *(const LAS f32x4*)(Ac + r * 128 + s0), dt4 = *(const LAS f32x4*)(dtl + r * 128 + s0); float v[4];
#pragma unroll
                    for (int j = 0; j < 4; ++j) { const float gv = tsel ? gt1[4 * q + j] : gt0[4 * q + j]; const float e = __expf(fminf(Al - As4[j], 0.f));
                        v[j] = (s0 + j <= l) ? gv * e * dt4[j] : 0.f; v[j] += (s0 + j == l) ? dsk : 0.f; }
                    u32x2 pk; pk.x = cvtpk(v[0], v[1]); pk.y = cvtpk(v[2], v[3]);
                    *(LAS u32x2*)(Bn + l * PT + s0 * 2) = pk; } } } }
        if (r < 5) conv_load(F, seq_row0, tok0 + 8 * xto, (h + 1) * 64 + 2 * xcp, rawx);
        __syncthreads();
        f32x16 acc;
#pragma unroll
        for (int i = 0; i < 16; ++i) acc[i] = 0.f;
#pragma unroll
        for (int ks = 0; ks < 8; ++ks) acc = mfma32(__builtin_bit_cast(s16x8, sinc[ks]), ldfrag(Cn, l, ks, hh), acc);
        { const float ea = __expf(Ac[r * 128 + l]);
#pragma unroll
          for (int i = 0; i < 16; ++i) acc[i] *= ea; }
        for (int ks = 0; ks < 2 * (li + 1); ++ks) acc = mfma32(ldfrag(XT, 32 * pj + l31, ks, hh), ldfrag(Bn, l, ks, hh), acc);
#pragma unroll
        for (int q = 0; q < 4; ++q) { const float z0 = bflo(zc[q].x), z1 = bfhi(zc[q].x), z2 = bflo(zc[q].y), z3 = bfhi(zc[q].y);
            const float y0 = acc[4 * q] * silu_f(z0), y1 = acc[4 * q + 1] * silu_f(z1), y2 = acc[4 * q + 2] * silu_f(z2), y3 = acc[4 * q + 3] * silu_f(z3);
            ss += (y0 * y0 + y1 * y1) + (y2 * y2 + y3 * y3); u32x2 o; o.x = cvtpk(y0, y1); o.y = cvtpk(y2, y3); *(u32x2*)(mrow + h * 64 + 8 * q) = o; }
    }
    part[l * 4 + pj * 2 + hh] = ss;
    __syncthreads();
    const f32x4 pv = *(const LAS f32x4*)(part + l * 4);
    const float rstd = 1.f / sqrtf(((pv.x + pv.y) + (pv.z + pv.w)) * (1.f / 384.f) + EPS);
    VM_WAIT();
#pragma unroll 1
    for (int r = 0; r < 6; ++r) { const int h = 6 * g + r;
#pragma unroll
        for (int q = 0; q < 4; ++q) { const f32x4 ng = *(const f32x4*)(F.ssm_norm_g() + h * 64 + 32 * pj + 4 * hh + 8 * q); const u32x2 yv = *(const u32x2*)(mrow + h * 64 + 8 * q);
            u32x2 o; o.x = cvtpk(bflo(yv.x) * rstd * ng.x, bfhi(yv.x) * rstd * ng.y); o.y = cvtpk(bflo(yv.y) * rstd * ng.z, bfhi(yv.y) * rstd * ng.w);
            *(u32x2*)(mrow + h * 64 + 8 * q) = o; } }
}
constexpr int PT2 = 528;
template <int W> __device__ __forceinline__ void pool_stage_prompt(const Frame& F, LAS unsigned char* Ap, int m0, int gi) {
    for (int it = F.tid; it < 1024; it += NTHR) { const int cp = it & 127, to = it >> 7, mrow = m0 + 8 * to, tseq = mrow & 2047;
        const bf16* base = F.PROJ() + (size_t)mrow * PLD + gi * 256 + 2 * cp;
        unsigned raw[W + 7];
#pragma unroll
        for (int i = 0; i < W + 7; ++i) { const int dt = i - (W - 1); raw[i] = (tseq + dt >= 0) ? *(const unsigned*)(base + (ptrdiff_t)dt * PLD) : 0u; }
        float s0 = 0.f, s1 = 0.f;
#pragma unroll
        for (int i = 0; i < W - 1; ++i) { s0 += bflo(raw[i]); s1 += bfhi(raw[i]); }
#pragma unroll
        for (int o = 0; o < 8; ++o) { const float u0 = bflo(raw[o + W - 1]), u1 = bfhi(raw[o + W - 1]); s0 += u0; s1 += u1;
            const float inv = 1.f / (float)min(W, tseq + o + 1);
            *(LAS unsigned*)(Ap + (8 * to + o) * PT2 + cp * 4) = cvtpk(s0 * inv - u0, s1 * inv - u1);
            s0 -= bflo(raw[o]); s1 -= bfhi(raw[o]); }
    }
}
template <int W> __device__ __forceinline__ void pool_stage_sample(const Frame& F, LAS unsigned char* Ap, int m0, int gi) {
    for (int it = F.tid; it < 2048; it += NTHR) { const int cp = it & 127, sq = it >> 7, b = (m0 - NPR) / 4 + sq, ch = gi * 256 + 2 * cp;
        f32x2 hv[W - 1]; unsigned raw[4];
#pragma unroll
        for (int i = 0; i < W - 1; ++i) hv[i] = *(const f32x2*)(F.state_pool() + (size_t)(b * 15 + 15 - (W - 1) + i) * DPOOL + ch);
#pragma unroll
        for (int t = 0; t < 4; ++t) raw[t] = *(const unsigned*)(F.PROJ() + (size_t)(NPR + 4 * b + t) * PLD + ch);
        float e0[W + 3], e1[W + 3];
#pragma unroll
        for (int i = 0; i < W - 1; ++i) { e0[i] = hv[i].x; e1[i] = hv[i].y; }
#pragma unroll
        for (int t = 0; t < 4; ++t) { e0[W - 1 + t] = bflo(raw[t]); e1[W - 1 + t] = bfhi(raw[t]); }
        float s0 = 0.f, s1 = 0.f;
#pragma unroll
        for (int i = 0; i < W - 1; ++i) { s0 += e0[i]; s1 += e1[i]; }
#pragma unroll
        for (int t = 0; t < 4; ++t) { s0 += e0[W - 1 + t]; s1 += e1[W - 1 + t];
            *(LAS unsigned*)(Ap + (4 * sq + t) * PT2 + cp * 4) = cvtpk(s0 * (1.f / W) - e0[W - 1 + t], s1 * (1.f / W) - e1[W - 1 + t]);
            s0 -= e0[t]; s1 -= e1[t]; }
    }
}
__device__ __forceinline__ void pool_unit_mfma(Frame& F, int tile, int gi) {
    LAS unsigned char* Ap = F.lds;
    LAS unsigned char* Wt = F.lds + 33792;
    const int m0 = tile * 64, hh = F.lane >> 5, l31 = F.lane & 31;
    __syncthreads();
    if (m0 < NPR) {
        if (gi == 0) pool_stage_prompt<2>(F, Ap, m0, gi); else if (gi == 1) pool_stage_prompt<4>(F, Ap, m0, gi);
        else if (gi == 2) pool_stage_prompt<8>(F, Ap, m0, gi); else pool_stage_prompt<16>(F, Ap, m0, gi);
    } else {
        if (gi == 0) pool_stage_sample<2>(F, Ap, m0, gi); else if (gi == 1) pool_stage_sample<4>(F, Ap, m0, gi);
        else if (gi == 2) pool_stage_sample<8>(F, Ap, m0, gi); else pool_stage_sample<16>(F, Ap, m0, gi);
    }
    const int ti = F.wave >> 2, di = F.wave & 3;
    for (int dh = 0; dh < 2; ++dh) {
        if (dh) __syncthreads();
        { const bf16* wg = F.PWT() + (size_t)(gi * 256 + dh * 128) * 256;
#pragma unroll
          for (int j = 0; j < 8; ++j) { const int idx = F.tid + NTHR * j, d = idx >> 5, seg = idx & 31; *(LAS v4u*)(Wt + d * PT2 + seg * 16) = *(const v4u*)(wg + d * 256 + seg * 8); } }
        __syncthreads();
        f32x16 acc;
#pragma unroll
        for (int i = 0; i < 16; ++i) acc[i] = 0.f;
#pragma unroll
        for (int ks = 0; ks < 16; ++ks) acc = mfma32(*(const LAS s16x8*)(Ap + (32 * ti + l31) * PT2 + ks * 32 + hh * 16), *(const LAS s16x8*)(Wt + (32 * di + l31) * PT2 + ks * 32 + hh * 16), acc);
        const int d = gi * 256 + dh * 128 + 32 * di + l31; const float sc = F.pool_scale()[d];
#pragma unroll
        for (int i = 0; i < 16; ++i) { const size_t row = (size_t)(m0 + 32 * ti + (i & 3) + 8 * (i >> 2) + 4 * hh); const float gate = bf2f(F.PROJ()[row * PLD + C_GATE + d]);
            F.MIX()[row * DMIX + d] = (bf16)f2bf(acc[i] * sc * silu_f(gate)); }
    }
}
__device__ __forceinline__ void sample_unit(Frame& F, int pair, int g) {
    LAS float* T = (LAS float*)F.lds;
    LAS float* dts = T + 5120; LAS float* dec = dts + 48; LAS float* ys = dec + 48;
    const int sb0 = 2 * pair, row0 = NPR + sb0 * 4, p = F.tid >> 3, nq = F.tid & 7;
    const float* sbase = F.state_ssm() + ((size_t)(sb0 * NHEAD + 6 * g) * HDIM + p) * DSTATE + nq * 4;
    float* obase = F.out() + O_SSM_S + ((size_t)(sb0 * NHEAD + 6 * g) * HDIM + p) * DSTATE + nq * 4;
#define TASK_OFF(k) ((size_t)(((k) / 6) * NHEAD + ((k) % 6)) * HDIM * DSTATE)
    f32x4 S[3][4];
#pragma unroll
    for (int k = 0; k < 2; ++k) {
#pragma unroll
        for (int q = 0; q < 4; ++q) S[k][q] = *((const f32x4*)(sbase + TASK_OFF(k)) + 8 * q); }
    f32x2 hv[2][3], cw[2][4], cb[2]; unsigned raw[2][4]; int cidx[2], tok[2];
#pragma unroll
    for (int j = 0; j < 2; ++j) { const int it = F.tid + NTHR * j; const bool on = it < 640; const int sq = (on && it >= 320) ? 1 : 0, c = on ? 2 * (it - 320 * sq) : 0;
        const int xch = c < 128 ? 3072 + g * 128 + c : (c < 256 ? 4096 + g * 128 + (c - 128) : g * 384 + (c - 256));
        cidx[j] = on ? c : -1; tok[j] = 4 * sq;
#pragma unroll
        for (int i = 0; i < 3; ++i) hv[j][i] = *(const f32x2*)(F.state_conv() + (size_t)((sb0 + sq) * 3 + i) * DCONV + xch);
#pragma unroll
        for (int t = 0; t < 4; ++t) raw[j][t] = *(const unsigned*)(F.PROJ() + (size_t)(row0 + 4 * sq + t) * PLD + C_XBC + xch);
#pragma unroll
        for (int k = 0; k < 4; ++k) cw[j][k] = *(const f32x2*)(F.conv_w() + k * DCONV + xch);
        cb[j] = *(const f32x2*)(F.conv_b() + xch); }
    bf16 zr[6];
#pragma unroll
    for (int k = 0; k < 6; ++k) zr[k] = F.PROJ()[(size_t)(row0 + F.wave) * PLD + C_Z + g * 384 + F.lane + 64 * k];
    __syncthreads();
#pragma unroll
    for (int j = 0; j < 2; ++j) if (cidx[j] >= 0) { float e0[7], e1[7];
#pragma unroll
        for (int i = 0; i < 3; ++i) { e0[i] = hv[j][i].x; e1[i] = hv[j][i].y; }
#pragma unroll
        for (int t = 0; t < 4; ++t) { e0[3 + t] = bflo(raw[j][t]); e1[3 + t] = bfhi(raw[j][t]); }
#pragma unroll
        for (int t = 0; t < 4; ++t) { float a0 = cb[j].x, a1 = cb[j].y;
#pragma unroll
            for (int k = 0; k < 4; ++k) { a0 += e0[t + k] * cw[j][k].x; a1 += e1[t + k] * cw[j][k].y; }
            T[(tok[j] + t) * 640 + cidx[j]] = silu_f(a0); T[(tok[j] + t) * 640 + cidx[j] + 1] = silu_f(a1); } }
    if (F.tid < 48) { const int k = F.tid >> 2, t = F.tid & 3, sq = k / 6, h = 6 * g + (k - 6 * sq); const float dt = softplus_f(F.DTRAW()[(size_t)(row0 + 4 * sq + t) * 64 + h] + F.dt_bias()[h]);
        dts[F.tid] = dt; dec[F.tid] = __expf(-dt * __expf(F.a_log()[h])); }
    __syncthreads();
#pragma unroll
    for (int k = 0; k < 12; ++k) { const int sq = k / 6, r = k % 6, h = 6 * g + r, cur = k % 3; const float dsk = F.d_skip()[h];
        if (k + 2 < 12) {
#pragma unroll
            for (int q = 0; q < 4; ++q) S[(k + 2) % 3][q] = *((const f32x4*)(sbase + TASK_OFF(k + 2)) + 8 * q); }
#pragma unroll
        for (int t = 0; t < 4; ++t) { const LAS float* row = T + (4 * sq + t) * 640; const float x = row[256 + r * 64 + p], d = dec[k * 4 + t], dtx = dts[k * 4 + t] * x; float acc = 0.f;
#pragma unroll
            for (int q = 0; q < 4; ++q) { const f32x4 bv = *(const LAS f32x4*)(row + nq * 4 + 32 * q), cv = *(const LAS f32x4*)(row + 128 + nq * 4 + 32 * q);
                S[cur][q] = S[cur][q] * d + bv * dtx; const f32x4 pr = cv * S[cur][q]; acc += (pr.x + pr.y) + (pr.z + pr.w); }
            acc += __shfl_xor(acc, 1); acc += __shfl_xor(acc, 2); acc += __shfl_xor(acc, 4);
            if (nq == 0) ys[(4 * sq + t) * 384 + r * 64 + p] = acc + dsk * x; }
#pragma unroll
        for (int q = 0; q < 4; ++q) *((f32x4*)(obase + TASK_OFF(k)) + 8 * q) = S[cur][q]; }
#undef TASK_OFF
    __syncthreads();
    { float v[6]; float ss = 0.f;
#pragma unroll
      for (int k = 0; k < 6; ++k) { const int idx = F.lane + 64 * k; v[k] = ys[F.wave * 384 + idx] * silu_f(bf2f(zr[k])); ss += v[k] * v[k]; }
      const float rstd = 1.f / sqrtf(wave_sum(ss) * (1.f / 384.f) + EPS);
#pragma unroll
      for (int k = 0; k < 6; ++k) { const int idx = F.lane + 64 * k; F.MIX()[(size_t)(row0 + F.wave) * DMIX + DPOOL + g * 384 + idx] = (bf16)f2bf(v[k] * rstd * F.ssm_norm_g()[g * 384 + idx]); } }
}
__device__ __forceinline__ void copy_seg_bf16(const bf16* src, float* dst, int lane) {
    const v4u a = *((const v4u*)src + 2 * lane), b = *((const v4u*)src + 2 * lane + 1); f32x4* d = (f32x4*)dst + 4 * lane;
    d[0] = (f32x4){bflo(a.x), bfhi(a.x), bflo(a.y), bfhi(a.y)}; d[1] = (f32x4){bflo(a.z), bfhi(a.z), bflo(a.w), bfhi(a.w)};
    d[2] = (f32x4){bflo(b.x), bfhi(b.x), bflo(b.y), bfhi(b.y)}; d[3] = (f32x4){bflo(b.z), bfhi(b.z), bflo(b.w), bfhi(b.w)};
}
__device__ __forceinline__ void p2_copies(Frame& F) {
    const int gw = F.bid * NWAVES + F.wave, NGW = F.G * NWAVES;
    constexpr int NPP = 4 * 15, NPS = 128 * 15, NCP = 4 * 3 * 5, NCS = 128 * 3 * 5;
    for (int task = gw; task < NPP + NPS + NCP + NCS; task += NGW) {
        int t = task;
        if (t < NPP) { const int b = t / 15, r = t - b * 15; copy_seg_bf16(F.PROJ() + (size_t)(b * 2048 + 2033 + r) * PLD, F.out() + O_POOL_P + (size_t)t * DPOOL, F.lane); continue; }
        t -= NPP;
        if (t < NPS) { const int b = t / 15, r = t - b * 15; float* dst = F.out() + O_POOL_S + (size_t)t * DPOOL;
            if (r < 11) { const f32x4* sp = (const f32x4*)(F.state_pool() + (size_t)(b * 15 + r + 4) * DPOOL) + 4 * F.lane; f32x4* d = (f32x4*)dst + 4 * F.lane; d[0] = sp[0]; d[1] = sp[1]; d[2] = sp[2]; d[3] = sp[3]; }
            else copy_seg_bf16(F.PROJ() + (size_t)(NPR + b * 4 + r - 11) * PLD, dst, F.lane);
            continue; }
        t -= NPS;
        if (t < NCP) { const int row = t / 5, sg = t - row * 5, b = row / 3, r = row - b * 3;
            copy_seg_bf16(F.PROJ() + (size_t)(b * 2048 + 2045 + r) * PLD + C_XBC + sg * 1024, F.out() + O_CONV_P + (size_t)row * DCONV + sg * 1024, F.lane); continue; }
        t -= NCP;
        { const int row = t / 5, sg = t - row * 5, b = row / 3, r = row - b * 3;
          copy_seg_bf16(F.PROJ() + (size_t)(NPR + b * 4 + 1 + r) * PLD + C_XBC + sg * 1024, F.out() + O_CONV_S + (size_t)row * DCONV + sg * 1024, F.lane); }
    }
}

__device__ __forceinline__ void p3_gate_norm(Frame& F) {
    const int gw = F.bid * NWAVES + F.wave, NGW = F.G * NWAVES;
    for (int task = gw; task < NSM * NGRP; task += NGW) {
        const int m = NPR + (task >> 3), g = task & 7; float v[6]; float ss = 0.f;
#pragma unroll
        for (int k = 0; k < 6; ++k) { const int idx = g * 384 + F.lane + 64 * k; const float y = F.YBUF()[(size_t)m * DSSM + idx], z = bf2f(F.PROJ()[(size_t)m * PLD + C_Z + idx]);
            v[k] = y * silu_f(z); ss += v[k] * v[k]; }
        const float r = 1.f / sqrtf(wave_sum(ss) * (1.f / 384.f) + EPS);
#pragma unroll
        for (int k = 0; k < 6; ++k) { const int idx = g * 384 + F.lane + 64 * k; F.MIX()[(size_t)m * DMIX + DPOOL + idx] = (bf16)f2bf(v[k] * r * F.ssm_norm_g()[idx]); }
    }
}
__device__ __forceinline__ void p5_final_norm(Frame& F) {
    const int gw = F.bid * NWAVES + F.wave, NGW = F.G * NWAVES;
    for (int m = gw; m < MROWS; m += NGW) {
        GAS f32x4* yr = (GAS f32x4*)(F.out() + O_Y + (size_t)m * DMODEL) + F.lane; const GAS f32x4* gr = (const GAS f32x4*)F.final_g() + F.lane;
        f32x4 v[8]; float s = 0.f;
        if (m < NPR) {
#pragma unroll
            for (int j = 0; j < 8; ++j) v[j] = yr[64 * j];
        } else {
            const GAS f32x4* xr = (const GAS f32x4*)(F.x_sample() + (size_t)(m - NPR) * DMODEL) + F.lane;
#pragma unroll
            for (int j = 0; j < 8; ++j) v[j] = xr[64 * j];
#pragma unroll 4
            for (int sl = 0; sl < 16; ++sl) { const GAS f32x4* pr = (const GAS f32x4*)(F.YBUF() + (size_t)sl * (512 * 2048) + (size_t)(m - NPR) * DMODEL) + F.lane;
#pragma unroll
                for (int j = 0; j < 8; ++j) v[j] += pr[64 * j]; }
        }
#pragma unroll
        for (int j = 0; j < 8; ++j) s += (v[j].x * v[j].x + v[j].y * v[j].y) + (v[j].z * v[j].z + v[j].w * v[j].w);
        const float r = 1.f / sqrtf(wave_sum(s) * (1.f / DMODEL) + EPS);
#pragma unroll
        for (int j = 0; j < 8; ++j) { const f32x4 g = gr[64 * j]; yr[64 * j] = (f32x4){v[j].x * r * g.x, v[j].y * r * g.y, v[j].z * r * g.z, v[j].w * r * g.w}; }
    }
}

constexpr int N_PHASES = 10;
__global__ void __launch_bounds__(NTHR, 2) fwd(Args args) {
    extern __shared__ __attribute__((aligned(16))) unsigned char lds_raw[];
    Frame F{(LAS unsigned char*)lds_raw, (int)threadIdx.x, (int)(threadIdx.x & 63), __builtin_amdgcn_readfirstlane((int)(threadIdx.x >> 6)), (int)gridDim.x, (int)blockIdx.x, args};
    unsigned char* ws = args.ws;
    for (int u = F.tid; u < (LDS_BYTES - LDSCTL_OFF) / 4; u += NTHR) ((LAS unsigned*)(F.lds + LDSCTL_OFF))[u] = 0u;
    __syncthreads();
    const int lo = args.ph_lo, hi = args.ph_hi;
    XcdBarrier bar; bar.bar = (unsigned*)(ws + WS_CTL) + CW_BAR; bar.x = 0; bar.st = nullptr;
    if (hi - lo > 1) bar = xcd_barrier_post((unsigned*)(ws + WS_CTL) + CW_BAR, (volatile LAS unsigned*)(F.lds + MISC_OFF) + 8);
#define IN(k) (lo <= (k) && (k) < hi)
#define BOTH(k) (IN(k) && IN((k) + 1))
#ifndef PHMASK
#define PHMASK 0x3ff
#endif
    if ((PHMASK & 1) && IN(0)) { p0_prologue(F); if (BOTH(0)) xcd_barrier(bar); }
    if ((PHMASK & 2) && IN(1)) {
        pg8::Gemm g{F.XN(), F.WinT(), MROWS, NPROJ_PAD, DMODEL}; pg8::StaticOrder S; S.init(MROWS, NPROJ_PAD, DMODEL, F.G, F.bid);
        pg8::EpiProj E{F.PROJ(), F.DTRAW()};
        pg8::gemm_phase<pg8::EpiProj, pg8::StaticOrder, true, true>(F.lds, g, S, E);
        if (BOTH(1)) xcd_barrier(bar);
    }
    const bool sfirst = (F.bid >> 3) & 1;
    if ((PHMASK & 8) && IN(3) && sfirst) { for (int u = F.bid; u < 512; u += F.G) sample_unit(F, u >> 3, u & 7); }
    if ((PHMASK & 4) && IN(2)) { for (int u = F.bid; u < 512; u += F.G) p2a_unit(F, u >> 7, (u >> 3) & 15, u & 7); }
    if ((PHMASK & 16) && IN(4)) { for (int u = F.bid; u < 544; u += F.G) pool_unit_mfma(F, u >> 2, u & 3); }
    if ((PHMASK & 8) && IN(3) && !sfirst) { for (int u = F.bid; u < 512; u += F.G) sample_unit(F, u >> 3, u & 7); }
    if ((PHMASK & 32) && IN(5)) { p2_copies(F); if (BOTH(5)) xcd_barrier(bar); }
    if ((PHMASK & 64) && IN(6)) { p2b_scan(F); if (BOTH(6)) xcd_barrier(bar); }
    if ((PHMASK & 128) && IN(7)) { for (int u = F.bid; u < 512; u += F.G) p2c_unit(F, u >> 7, (u >> 3) & 15, u & 7); if (BOTH(7)) xcd_barrier(bar); }
    if ((PHMASK & 256) && IN(8)) {
        pg8::Gemm g{F.MIX(), F.WoutT(), MROWS, DMODEL, DMIX}; pg8::OutOrder S{F.bid};
        pg8::EpiOut2 E{F.x_prompt(), F.out(), F.YBUF()};
        pg8::gemm_phase<pg8::EpiOut2, pg8::OutOrder, true, true>(F.lds, g, S, E);
        if (BOTH(8)) xcd_barrier(bar);
    }
    if ((PHMASK & 512) && IN(9)) { p5_final_norm(F); }
#undef IN
#undef BOTH
}

#ifndef N_LAUNCHES
#define N_LAUNCHES 1
#endif
extern "C" void kernel_launch(void* const* d_in, const int* in_sizes, int n_in, void* d_out, int out_size, void* d_ws, size_t ws_size, hipStream_t stream) {
    static int grid = 0;
    if (grid == 0) {
        if (n_in != 17 || out_size != 73785344 || ws_size < WS_END) { fprintf(stderr, "kernel_launch: unexpected shapes: n_in %d out %d ws %zu\n", n_in, out_size, ws_size); grid = -1; return; }
        int dev = 0, cus = 0, per_cu = 0;
        if (hipGetDevice(&dev) != hipSuccess || hipDeviceGetAttribute(&cus, hipDeviceAttributeMultiprocessorCount, dev) != hipSuccess) { fprintf(stderr, "kernel_launch: device query failed\n"); grid = -1; return; }
        if (hipFuncSetAttribute((const void*)fwd, hipFuncAttributeMaxDynamicSharedMemorySize, LDS_BYTES) != hipSuccess) { fprintf(stderr, "kernel_launch: hipFuncSetAttribute failed\n"); grid = -1; return; }
        if (hipOccupancyMaxActiveBlocksPerMultiprocessor(&per_cu, (const void*)fwd, NTHR, LDS_BYTES) != hipSuccess || per_cu < 1) { fprintf(stderr, "kernel_launch: occupancy query says %d blocks per CU\n", per_cu); }
        (void)hipGetLastError();
        grid = cus;
    }
    if (grid < 0) return;
    (void)hipMemsetAsync((char*)d_ws + WS_CTL, 0, CTL_ZERO_BYTES, stream);
    Args a{};
    for (int i = 0; i < 17; ++i) a.in[i] = (const float*)d_in[i];
    a.out = (float*)d_out; a.ws = (unsigned char*)d_ws;
    if (N_LAUNCHES == 1) {
        a.ph_lo = 0; a.ph_hi = N_PHASES;
        void* kargs[] = {&a};
        hipError_t e = hipLaunchCooperativeKernel((const void*)fwd, dim3(grid), dim3(NTHR), kargs, LDS_BYTES, stream);
        if (e != hipSuccess) fprintf(stderr, "kernel_launch: cooperative launch failed: %s\n", hipGetErrorString(e));
#ifdef PROBE_PHASE
        a.ph_lo = PROBE_PHASE; a.ph_hi = PROBE_PHASE + 1; hipLaunchKernelGGL(fwd, dim3(grid), dim3(NTHR), LDS_BYTES, stream, a);
#ifdef PROBE_PHASE2
        a.ph_lo = PROBE_PHASE2; a.ph_hi = PROBE_PHASE2 + 1; hipLaunchKernelGGL(fwd, dim3(grid), dim3(NTHR), LDS_BYTES, stream, a);
#endif
#endif
    } else {
        for (int li = 0; li < N_PHASES; ++li) { a.ph_lo = li; a.ph_hi = li + 1; hipLaunchKernelGGL(fwd, dim3(grid), dim3(NTHR), LDS_BYTES, stream, a); }
    }
}
```

```cpp
#include <hip/hip_runtime.h>
#include <cstdio>
#include <cstdint>
namespace pg8 {
#define PG8_LAS __attribute__((address_space(3)))
typedef unsigned short bf16_t;
typedef short bf16x8 __attribute__((ext_vector_type(8)));
typedef float f32x4 __attribute__((ext_vector_type(4)));
typedef unsigned u32x4 __attribute__((ext_vector_type(4)));
constexpr int BM = 256, BK = 64, HALF = 128, HTB = HALF * BK * 2  , STAGE_BYTES = 8 * HTB, NXCD = 8, WGM = 8;

__host__ __device__ __forceinline__ int lds_byte(int r, int c) { const int st = (r >> 4) * 2 + (c >> 5), rr = r & 15, cc = c & 31, ob = rr * 64 + cc * 2; return st * 1024 + (ob ^ (((ob >> 9) & 1) << 5)); }
__host__ __device__ __forceinline__ void stage_rc(int b, int& R, int& C) { const int st = b / 1024, sb = b % 1024, swz = sb ^ (((sb >> 9) & 1) << 5); R = (st >> 1) * 16 + swz / 64; C = (st & 1) * 32 + (swz % 64) / 2; }
__host__ __device__ __forceinline__ int perm32(int rho) { const int n = rho >> 4, i = rho & 15; return 8 * (i >> 2) + 4 * n + (i & 3); }

struct Unit { int pm, pn, k0, nt; };
struct Gemm { const bf16_t* A; const bf16_t* Bt; int M, N, K; };

struct StaticOrder {
    int nM, nN, nwg, G, c, ntk;
    __host__ __device__ void init(int M, int N, int K, int G_, int c_) { nM = M / BM; nN = N / BM; nwg = nM * nN; G = G_; c = c_; ntk = K / BK; }
    __host__ __device__ bool next(int i, Unit& u) const {
        const long L = (long)i * G + c; if (L >= nwg) return false;
        int wgid = (int)L; { const int q = nwg / NXCD, r = nwg % NXCD, xcd = wgid % NXCD, off = wgid / NXCD; wgid = (xcd < r ? xcd * (q + 1) : r * (q + 1) + (xcd - r) * q) + off; }
        const int nig = WGM * nN, gid = wgid / nig, fm = gid * WGM, gsz = (nM - fm) < WGM ? (nM - fm) : WGM;
        u.pm = fm + ((wgid % nig) % gsz); u.pn = (wgid % nig) / gsz; u.k0 = 0; u.nt = ntk; return true;
    }
    __device__ __forceinline__ void a_ready(const Unit&) const {}
    __device__ __forceinline__ void done(const Unit&) const {}
};

__device__ __forceinline__ unsigned cvt_pk_bf16(float lo, float hi) { unsigned r; asm volatile("v_cvt_pk_bf16_f32 %0, %1, %2" : "=v"(r) : "v"(lo), "v"(hi)); return r; }

struct EpiProj {
    static constexpr bool PERM = true, AFTER_DRAIN = false;
    bf16_t* P; float* dtraw; bf16_t* ZT;
    __device__ __forceinline__ void operator()(const f32x4 (&acc)[2][2][4][2], const Unit& u, int wr, int wc, int fr, int fq) const {
        const int row0 = u.pm * BM + wr * 64 + fr;
        if (u.pn < 40) {
            const int col0 = u.pn * BM + wc * 32 + 8 * fq;
            const bool zt = (u.pm < 32) && (u.pn >= 8) && (u.pn < 20);
#pragma unroll
            for (int ai = 0; ai < 2; ++ai)
#pragma unroll
                for (int m = 0; m < 4; ++m) { const int row = row0 + ai * HALF + m * 16; bf16_t* rowp = P + (size_t)row * 10240 + col0;
#pragma unroll
                    for (int bj = 0; bj < 2; ++bj) { const f32x4 v0 = acc[ai][bj][m][0], v1 = acc[ai][bj][m][1];
                        u32x4 w; w.x = cvt_pk_bf16(v0[0], v0[1]); w.y = cvt_pk_bf16(v0[2], v0[3]); w.z = cvt_pk_bf16(v1[0], v1[1]); w.w = cvt_pk_bf16(v1[2], v1[3]);
                        if (!zt) *(u32x4*)(rowp + bj * HALF) = w;
                        else { const int zc = col0 + bj * HALF - 2048, g = zc / 384, rr = (zc - g * 384) >> 6, pc = zc & 63;
                            const int uu = (row >> 11) * 128 + ((row >> 7) & 15) * 8 + g, l = row & 127;
                            unsigned long long* zp = (unsigned long long*)ZT + ((((size_t)(uu * 6 + rr) * 8 + ((l >> 5) * 2 + (pc >> 5))) * 4 + ((pc & 31) >> 3)) * 64 + (l & 31));
                            zp[0] = (unsigned long long)w.x | ((unsigned long long)w.y << 32); zp[32] = (unsigned long long)w.z | ((unsigned long long)w.w << 32); } } }
        } else if (wc < 2) {
#pragma unroll
            for (int ai = 0; ai < 2; ++ai)
#pragma unroll
                for (int m = 0; m < 4; ++m) { float* rp = dtraw + (size_t)(row0 + ai * HALF + m * 16) * 64 + wc * 32 + 8 * fq;
                    *(f32x4*)rp = acc[ai][0][m][0]; *(f32x4*)(rp + 4) = acc[ai][0][m][1]; }
        }
    }
};
struct EpiOut {
    static constexpr bool PERM = false, AFTER_DRAIN = false;
    const float* xp; const float* xs; float* out;
    __device__ __forceinline__ void operator()(const f32x4 (&acc)[2][2][4][2], const Unit& u, int wr, int wc, int fr, int fq) const {
        const int row0 = u.pm * BM + wr * 64 + fr, col0 = u.pn * BM + wc * 32 + 4 * fq;
        const float* xb = (u.pm < 32) ? xp : xs - (size_t)8192 * 2048;
#pragma unroll
        for (int ai = 0; ai < 2; ++ai)
#pragma unroll
            for (int m = 0; m < 4; ++m) { const size_t ro = (size_t)(row0 + ai * HALF + m * 16) * 2048 + col0;
#pragma unroll
                for (int bj = 0; bj < 2; ++bj)
#pragma unroll
                    for (int n = 0; n < 2; ++n) { const f32x4 xv = *(const f32x4*)(xb + ro + bj * HALF + n * 16);
                        *(f32x4*)(out + ro + bj * HALF + n * 16) = xv + acc[ai][bj][m][n]; } }
    }
};

struct EpiOut2 {
    static constexpr bool PERM = false, AFTER_DRAIN = false;
    const float* xp; float* out; float* slab;
    __device__ __forceinline__ void operator()(const f32x4 (&acc)[2][2][4][2], const Unit& u, int wr, int wc, int fr, int fq) const {
        const int row0 = u.pm * BM + wr * 64 + fr, col0 = u.pn * BM + wc * 32 + 4 * fq;
        if (u.pm < 32) {
#pragma unroll
            for (int ai = 0; ai < 2; ++ai)
#pragma unroll
                for (int m = 0; m < 4; ++m) { const size_t ro = (size_t)(row0 + ai * HALF + m * 16) * 2048 + col0;
#pragma unroll
                    for (int bj = 0; bj < 2; ++bj)
#pragma unroll
                        for (int n = 0; n < 2; ++n) { const f32x4 xv = *(const f32x4*)(xp + ro + bj * HALF + n * 16);
                            *(f32x4*)(out + ro + bj * HALF + n * 16) = xv + acc[ai][bj][m][n]; } }
        } else {
            float* sl = slab + (size_t)(u.k0 >> 8) * (512 * 2048) - (size_t)8192 * 2048;
#pragma unroll
            for (int ai = 0; ai < 2; ++ai)
#pragma unroll
                for (int m = 0; m < 4; ++m) { const size_t ro = (size_t)(row0 + ai * HALF + m * 16) * 2048 + col0;
#pragma unroll
                    for (int bj = 0; bj < 2; ++bj)
#pragma unroll
                        for (int n = 0; n < 2; ++n) *(f32x4*)(sl + ro + bj * HALF + n * 16) = acc[ai][bj][m][n]; }
        }
    }
};
struct OutOrder {
    int c;
    __device__ __forceinline__ bool next(int i, Unit& u) const {
        if (i == 0) { const int x = c & 7, j = c >> 3; u.pm = 4 * x + (j & 3); u.pn = j >> 2; u.k0 = 0; u.nt = 64; return true; }
        if (i == 1) { const int tile = c >> 4, sl = c & 15; u.pm = 32 + (tile >> 3); u.pn = tile & 7; u.k0 = sl * 256; u.nt = 4; return true; }
        return false;
    }
    __device__ __forceinline__ void a_ready(const Unit&) const {}
    __device__ __forceinline__ void done(const Unit&) const {}
};

template <class Epi, class Sched, bool ALIGN_EPI = false, bool SP2 = false>
__device__ __forceinline__ void gemm_phase(PG8_LAS unsigned char* lds, const Gemm g, const Sched& S, const Epi& E) {
    const int tid = threadIdx.x, wid = __builtin_amdgcn_readfirstlane(tid >> 6), lane = tid & 63, wr = wid >> 2, wc = wid & 3, fr = lane & 15, fq = lane >> 4;
    const int K = g.K;
    unsigned voffA[2], voffB[2];
#pragma unroll
    for (int i = 0; i < 2; ++i) { int R, C; stage_rc(tid * 16 + i * 8192, R, C); const int Rb = Epi::PERM ? ((R & ~31) + perm32(R & 31)) : R;
        voffA[i] = (unsigned)(R * K + C) * 2u; voffB[i] = (unsigned)(Rb * K + C) * 2u; }
    const size_t kstep = (size_t)(BK * 2);
    const size_t hstep = (size_t)HALF * K * 2;
    const size_t tstep = 2 * hstep;
    const unsigned ldsw = (unsigned)wid * 1024u;
    const int aoff = lds_byte(wr * 64 + fr, fq * 8), boff = lds_byte(wc * 32 + fr, fq * 8);
#define PG8_SA(b, h) (((b) * 2 + (h)) * HTB)
#define PG8_SB(b, h) ((4 + (b) * 2 + (h)) * HTB)
#define PG8_STAGE(bufoff, gbase, voff) do { _Pragma("unroll") for (int _i = 0; _i < 2; ++_i) \
        __builtin_amdgcn_global_load_lds((const unsigned*)((const char*)(gbase) + (voff)[_i]), (PG8_LAS unsigned*)(lds + (bufoff) + ldsw + _i * 8192), 16, 0, 0); } while (0)
#define PG8_LDA(dst, b, h) do { _Pragma("unroll") for (int m = 0; m < 4; ++m) _Pragma("unroll") for (int k = 0; k < 2; ++k) dst[m][k] = *(const PG8_LAS bf16x8*)(lds + PG8_SA(b, h) + aoff + m * 2048 + k * 1024); } while (0)
#define PG8_LDB(dst, b, h) do { _Pragma("unroll") for (int n = 0; n < 2; ++n) _Pragma("unroll") for (int k = 0; k < 2; ++k) dst[n][k] = *(const PG8_LAS bf16x8*)(lds + PG8_SB(b, h) + boff + n * 2048 + k * 1024); } while (0)
#define PG8_MMA(ai, bj, At, Bt) do { __builtin_amdgcn_s_setprio(1); _Pragma("unroll") for (int m = 0; m < 4; ++m) _Pragma("unroll") for (int n = 0; n < 2; ++n) _Pragma("unroll") for (int k = 0; k < 2; ++k) \
        acc[ai][bj][m][n] = __builtin_amdgcn_mfma_f32_16x16x32_bf16(Bt[n][k], At[m][k], acc[ai][bj][m][n], 0, 0, 0); __builtin_amdgcn_s_setprio(0); } while (0)
#define PG8_WAIT_V(n) asm volatile("s_waitcnt vmcnt(" #n ")" ::: "memory")
#define PG8_WAIT_L(n) asm volatile("s_waitcnt lgkmcnt(" #n ")" ::: "memory")
#define PG8_BAR __builtin_amdgcn_s_barrier()
#define PG8_SCHED __builtin_amdgcn_sched_barrier(0)
    Unit cur, nxt; int ui = 0;
    if (!S.next(0, cur)) return;
    f32x4 acc[2][2][4][2];
#pragma unroll
    for (int a = 0; a < 2; ++a)
#pragma unroll
        for (int b = 0; b < 2; ++b)
#pragma unroll
            for (int m = 0; m < 4; ++m)
#pragma unroll
                for (int n = 0; n < 2; ++n) acc[a][b][m][n] = (f32x4){0.f, 0.f, 0.f, 0.f};
    bf16x8 At[4][2], B0[2][2], B1[2][2];
    const char* cA = (const char*)g.A + (size_t)cur.pm * tstep + (size_t)cur.k0 * 2; const char* cB = (const char*)g.Bt + (size_t)cur.pn * tstep + (size_t)cur.k0 * 2;
    S.a_ready(cur);
    if constexpr (SP2) {
        PG8_STAGE(PG8_SB(0, 0), cB, voffB); PG8_STAGE(PG8_SB(0, 1), cB + hstep, voffB); PG8_STAGE(PG8_SA(0, 0), cA, voffA); PG8_STAGE(PG8_SA(0, 1), cA + hstep, voffA);
        if (wr == 1) PG8_BAR;
        PG8_WAIT_V(2); PG8_BAR;
        PG8_STAGE(PG8_SB(1, 0), cB + kstep, voffB); PG8_STAGE(PG8_SA(1, 0), cA + kstep, voffA); PG8_STAGE(PG8_SB(1, 1), cB + hstep + kstep, voffB);
        PG8_WAIT_V(6); PG8_BAR;
    } else {
        PG8_STAGE(PG8_SB(0, 0), cB, voffB); PG8_STAGE(PG8_SA(0, 0), cA, voffA); PG8_STAGE(PG8_SB(0, 1), cB + hstep, voffB); PG8_STAGE(PG8_SA(0, 1), cA + hstep, voffA);
        if (wr == 1) PG8_BAR;
        PG8_WAIT_V(4); PG8_BAR;
        PG8_STAGE(PG8_SB(1, 0), cB + kstep, voffB); PG8_STAGE(PG8_SA(1, 0), cA + kstep, voffA); PG8_STAGE(PG8_SB(1, 1), cB + hstep + kstep, voffB);
        PG8_WAIT_V(6); PG8_BAR;
    }
    for (;;) {
        const bool has_next = S.next(ui + 1, nxt);
        const char* nA = has_next ? (const char*)g.A + (size_t)nxt.pm * tstep + (size_t)nxt.k0 * 2 : cA; const char* nB = has_next ? (const char*)g.Bt + (size_t)nxt.pn * tstep + (size_t)nxt.k0 * 2 : cB;
        const int nt = cur.nt;
        for (int t = 0; t < nt; t += 2) {
            const bool last = (t == nt - 2);
            const char* a1 = cA + (size_t)(t + 1) * kstep;
            const char* a2 = last ? nA : cA + (size_t)(t + 2) * kstep; const char* b2 = last ? nB : cB + (size_t)(t + 2) * kstep;
            const char* a3 = a2 + kstep; const char* b3 = b2 + kstep;
            if (last && has_next) S.a_ready(nxt);
            if constexpr (SP2) {
            PG8_LDB(B0, 0, 0); PG8_LDB(B1, 0, 1); PG8_SCHED; PG8_LDA(At, 0, 0); PG8_STAGE(PG8_SA(1, 1), a1 + hstep, voffA);
            PG8_WAIT_V(8); PG8_WAIT_L(0); PG8_BAR; PG8_MMA(0, 0, At, B0); PG8_MMA(0, 1, At, B1); PG8_BAR; PG8_SCHED;
            PG8_LDA(At, 0, 1); PG8_STAGE(PG8_SB(0, 0), b2, voffB); PG8_STAGE(PG8_SB(0, 1), b2 + hstep, voffB); PG8_STAGE(PG8_SA(0, 0), a2, voffA);
            PG8_WAIT_V(8); PG8_WAIT_L(0); PG8_BAR; PG8_MMA(1, 0, At, B0); PG8_MMA(1, 1, At, B1); PG8_BAR; PG8_SCHED;
            PG8_LDB(B0, 1, 0); PG8_LDB(B1, 1, 1); PG8_SCHED; PG8_LDA(At, 1, 0); PG8_STAGE(PG8_SA(0, 1), a2 + hstep, voffA);
            PG8_WAIT_V(8); PG8_WAIT_L(0); PG8_BAR; PG8_MMA(0, 0, At, B0); PG8_MMA(0, 1, At, B1); PG8_BAR; PG8_SCHED;
            PG8_LDA(At, 1, 1); PG8_STAGE(PG8_SB(1, 0), b3, voffB); PG8_STAGE(PG8_SB(1, 1), b3 + hstep, voffB); PG8_STAGE(PG8_SA(1, 0), a3, voffA);
            PG8_WAIT_V(8); PG8_WAIT_L(0); PG8_BAR; PG8_MMA(1, 0, At, B0); PG8_MMA(1, 1, At, B1); PG8_BAR; PG8_SCHED;
            } else {
            PG8_LDB(B0, 0, 0); PG8_SCHED; PG8_LDA(At, 0, 0); PG8_STAGE(PG8_SA(1, 1), a1 + hstep, voffA);
            PG8_WAIT_L(8); PG8_BAR; PG8_WAIT_L(0); PG8_MMA(0, 0, At, B0); PG8_BAR; PG8_SCHED;
            PG8_LDB(B1, 0, 1); PG8_STAGE(PG8_SB(0, 0), b2, voffB);
            PG8_BAR; PG8_WAIT_L(0); PG8_MMA(0, 1, At, B1); PG8_BAR;
            PG8_LDA(At, 0, 1); PG8_STAGE(PG8_SA(0, 0), a2, voffA);
            PG8_BAR; PG8_WAIT_L(0); PG8_MMA(1, 0, At, B0); PG8_BAR; PG8_SCHED;
            PG8_STAGE(PG8_SB(0, 1), b2 + hstep, voffB);
            PG8_WAIT_V(6); PG8_BAR; PG8_MMA(1, 1, At, B1); PG8_BAR;
            PG8_LDB(B0, 1, 0); PG8_SCHED; PG8_LDA(At, 1, 0); PG8_STAGE(PG8_SA(0, 1), a2 + hstep, voffA);
            PG8_WAIT_L(8); PG8_BAR; PG8_WAIT_L(0); PG8_MMA(0, 0, At, B0); PG8_BAR; PG8_SCHED;
            PG8_LDB(B1, 1, 1); PG8_STAGE(PG8_SB(1, 0), b3, voffB);
            PG8_BAR; PG8_WAIT_L(0); PG8_MMA(0, 1, At, B1); PG8_BAR;
            PG8_LDA(At, 1, 1); PG8_STAGE(PG8_SA(1, 0), a3, voffA);
            PG8_BAR; PG8_WAIT_L(0); PG8_MMA(1, 0, At, B0); PG8_BAR; PG8_SCHED;
            PG8_STAGE(PG8_SB(1, 1), b3 + hstep, voffB);
            PG8_WAIT_V(6); PG8_BAR; PG8_MMA(1, 1, At, B1); PG8_BAR;
            }
        }
        if constexpr (ALIGN_EPI) { if (wr == 0) PG8_BAR; }
        if constexpr (!Epi::AFTER_DRAIN) { E(acc, cur, wr, wc, fr, fq); S.done(cur); }
        if (!has_next) break;
#pragma unroll
        for (int a = 0; a < 2; ++a)
#pragma unroll
            for (int b = 0; b < 2; ++b)
#pragma unroll
                for (int m = 0; m < 4; ++m)
#pragma unroll
                    for (int n = 0; n < 2; ++n) acc[a][b][m][n] = (f32x4){0.f, 0.f, 0.f, 0.f};
        cur = nxt; cA = nA; cB = nB; ++ui;
        if constexpr (ALIGN_EPI) { if (wr == 1) PG8_BAR; }
    }
    PG8_WAIT_V(0);
    if constexpr (!ALIGN_EPI) { if (wr == 0) PG8_BAR; }
    PG8_BAR;
    if constexpr (Epi::AFTER_DRAIN) { E.fused(acc, cur, wr, wc, fr, fq, lds, wid, lane); S.done(cur); }
#undef PG8_SA
#undef PG8_SB
#undef PG8_STAGE
#undef PG8_LDA
#undef PG8_LDB
#undef PG8_MMA
#undef PG8_WAIT_V
#undef PG8_WAIT_L
#undef PG8_BAR
#undef PG8_SCHED
}

}

constexpr int DMODEL = 2048, NPR = 8192  , NSM = 512  , MROWS = NPR + NSM;
constexpr int DPOOL = 1024, DSSM = 3072, DCONV = 5120, NHEAD = 48, HDIM = 64, NGRP = 8, DSTATE = 128, DMIX = 4096;
constexpr int NPROJ = 10288, PLD = 10240  , NPROJ_PAD = 10496  ;
constexpr int C_GATE = 1024, C_Z = 2048, C_XBC = 5120;
constexpr float EPS = 1e-5f;
constexpr size_t O_Y = 0, O_POOL_P = 17825792, O_CONV_P = 17887232, O_SSM_P = 17948672, O_POOL_S = 19521536, O_CONV_S = 21487616, O_SSM_S = 23453696;
constexpr size_t MiB = 1u << 20;
constexpr size_t WS_CTL = 0, CTL_ZERO_BYTES = 1 * MiB;
constexpr size_t WS_XN = 2 * MiB;
constexpr size_t WS_WINT = 36 * MiB;
constexpr size_t WS_WOUTT = 78 * MiB;
constexpr size_t WS_PROJ = 96 * MiB;
constexpr size_t WS_DTRAW = 268 * MiB;
constexpr size_t WS_MIX = 272 * MiB;
constexpr size_t WS_YBUF = 344 * MiB;
constexpr size_t WS_ST = 448 * MiB;
constexpr size_t WS_SIN = 544 * MiB;
constexpr size_t WS_CHDEC = 592 * MiB;
constexpr size_t WS_PWT = 593 * MiB;
constexpr size_t WS_YD = 600 * MiB;
constexpr size_t WS_CC = 650 * MiB;
constexpr size_t WS_EA = 668 * MiB;
constexpr size_t WS_ZT = 672 * MiB;
constexpr size_t WS_END = 720 * MiB;
constexpr int CW_BAR = 4096;
constexpr int NWAVES = 8, NTHR = 512;
constexpr int RING_BYTES = 155648, LDSCTL_OFF = RING_BYTES, MISC_OFF = LDSCTL_OFF + 320, LDS_BYTES = 157696;

#define GAS __attribute__((address_space(1)))
#define LAS __attribute__((address_space(3)))
typedef unsigned short bf16;
typedef unsigned v4u __attribute__((ext_vector_type(4)));
typedef float f32x4 __attribute__((ext_vector_type(4)));
#define LDS_WAIT() asm volatile("s_waitcnt lgkmcnt(0)" ::: "memory")
#define VM_WAIT() asm volatile("s_waitcnt vmcnt(0)" ::: "memory")
__device__ __forceinline__ unsigned f2bf(float f) { unsigned u = __builtin_bit_cast(unsigned, f); return (u + 0x7fffu + ((u >> 16) & 1u)) >> 16; }
__device__ __forceinline__ unsigned pk2(float lo, float hi) { return f2bf(lo) | (f2bf(hi) << 16); }
__device__ __forceinline__ float bf2f(bf16 v) { return __builtin_bit_cast(float, (unsigned)v << 16); }
__device__ __forceinline__ float silu_f(float x) { return x * __builtin_amdgcn_rcpf(1.f + __expf(-x)); }
__device__ __forceinline__ float softplus_f(float x) { return fmaxf(x, 0.f) + log1pf(__expf(-fabsf(x))); }
__device__ __forceinline__ float wave_sum(float v) {
#pragma unroll
    for (int o = 1; o < 64; o <<= 1) v += __shfl_xor(v, o);
    return v;
}

#define XB_TMO      128
#define XB_XCNT(j)  (256  + 64 * (j))
#define XB_XSUB(j)  (1280 + 64 * (j))
#define XB_XGEN(j)  (2304 + 64 * (j))
#define XB_TOP      3328
#define XB_TOPGEN   3392
#define XCD_BAR_WORDS 3456
#define XB_SPIN_CAP (1u << 18)

__device__ __forceinline__ unsigned xb_ld(unsigned* p)              { return __hip_atomic_load(p, __ATOMIC_RELAXED, __HIP_MEMORY_SCOPE_AGENT); }
__device__ __forceinline__ unsigned xb_add(unsigned* p, unsigned v) { return __hip_atomic_fetch_add(p, v, __ATOMIC_RELAXED, __HIP_MEMORY_SCOPE_AGENT); }
__device__ __forceinline__ unsigned xb_xcc_id() { return (unsigned)__builtin_amdgcn_s_getreg((3 << 11) | 20) & 0xFu; }
#define XB_SPIN(cond, bar) do { unsigned _sp = 0; while (cond) { __builtin_amdgcn_s_sleep(1); \
    if ((++_sp & 255u) == 0u) { if (xb_ld(&(bar)[XB_TMO])) break; if (_sp > XB_SPIN_CAP) { atomicAdd(&(bar)[XB_TMO], 1u); break; } } } } while (0)

struct XcdBarrier {
    unsigned* bar; unsigned x;
    volatile LAS unsigned* st;
};

__device__ __forceinline__ XcdBarrier xcd_barrier_post(unsigned* bar, volatile LAS unsigned* st) {
    XcdBarrier b; b.bar = bar; b.x = xb_xcc_id(); b.st = st;
    if (threadIdx.x == 0) (void)xb_add(&bar[XB_XCNT(b.x)], 1u);
    return b;
}
__device__ __forceinline__ void xcd_barrier_complete(unsigned* bar, unsigned x, unsigned& nloc, unsigned& nx) {
    const unsigned G = gridDim.x * gridDim.y * gridDim.z;
    unsigned sum, cnt, mine, sp = 0u;
    for (;;) {
        sum = 0u; cnt = 0u; mine = 0u;
#pragma unroll
        for (unsigned j = 0; j < 16; ++j) { const unsigned c = xb_ld(&bar[XB_XCNT(j)]); sum += c; cnt += (c > 0u) ? 1u : 0u; mine = (j == x) ? c : mine; }
        if (sum == G) break;
        __builtin_amdgcn_s_sleep(1);
        if ((++sp & 255u) == 0u) { if (xb_ld(&bar[XB_TMO])) break; if (sp > XB_SPIN_CAP) { atomicAdd(&bar[XB_TMO], 1u); break; } }
    }
    nloc = mine > 0u ? mine : 1u; nx = cnt > 0u ? cnt : 1u;
}

__device__ __forceinline__ void xcd_barrier(const XcdBarrier& b) {
    asm volatile("s_waitcnt vmcnt(0)" ::: "memory");
    __syncthreads();
    if (threadIdx.x == 0) {
        unsigned* bar = b.bar;
        __builtin_amdgcn_s_waitcnt(0);
        unsigned nloc = b.st[0], nx = b.st[1];
        if (nloc == 0u) { xcd_barrier_complete(bar, b.x, nloc, nx); b.st[0] = nloc; b.st[1] = nx; }
        const unsigned old = xb_add(&bar[XB_XSUB(b.x)], 1u);
        const unsigned gen = old / nloc;
        if (old + 1u == (gen + 1u) * nloc) {
            __builtin_amdgcn_fence(__ATOMIC_RELEASE, "agent");
            asm volatile("s_waitcnt vmcnt(0)" ::: "memory");
            const unsigned og = xb_add(&bar[XB_TOP], 1u);
            const unsigned tg = og / nx;
            if (og + 1u == (tg + 1u) * nx) xb_add(&bar[XB_TOPGEN], 1u);
            else XB_SPIN(xb_ld(&bar[XB_TOPGEN]) == tg, bar);
            __builtin_amdgcn_fence(__ATOMIC_ACQUIRE, "agent");
            xb_add(&bar[XB_XGEN(b.x)], 1u);
            asm volatile("s_waitcnt vmcnt(0)" ::: "memory");
        } else {
            XB_SPIN(xb_ld(&bar[XB_XGEN(b.x)]) == gen, bar);
            __builtin_amdgcn_fence(__ATOMIC_ACQUIRE, "agent");
            asm volatile("s_waitcnt vmcnt(0)" ::: "memory");
        }
    }
    __syncthreads();
}


struct Args { const float* in[17]; float* out; unsigned char* ws; int ph_lo, ph_hi; };
struct Frame {
    LAS unsigned char* lds;
    int tid, lane, wave, G, bid;
    const Args& A;
    __device__ __forceinline__ const float* x_prompt() const { return A.in[0]; }
    __device__ __forceinline__ const float* x_sample() const { return A.in[1]; }
    __device__ __forceinline__ const float* state_pool() const { return A.in[2]; }
    __device__ __forceinline__ const float* state_conv() const { return A.in[3]; }
    __device__ __forceinline__ const float* state_ssm() const { return A.in[4]; }
    __device__ __forceinline__ const float* norm_g() const { return A.in[5]; }
    __device__ __forceinline__ const float* w_in() const { return A.in[6]; }
    __device__ __forceinline__ const float* conv_w() const { return A.in[7]; }
    __device__ __forceinline__ const float* conv_b() const { return A.in[8]; }
    __device__ __forceinline__ const float* dt_bias() const { return A.in[9]; }
    __device__ __forceinline__ const float* a_log() const { return A.in[10]; }
    __device__ __forceinline__ const float* d_skip() const { return A.in[11]; }
    __device__ __forceinline__ const float* ssm_norm_g() const { return A.in[12]; }
    __device__ __forceinline__ const float* pool_w() const { return A.in[13]; }
    __device__ __forceinline__ const float* pool_scale() const { return A.in[14]; }
    __device__ __forceinline__ const float* w_out() const { return A.in[15]; }
    __device__ __forceinline__ const float* final_g() const { return A.in[16]; }
    __device__ __forceinline__ bf16* XN() const { return (bf16*)(A.ws + WS_XN); }
    __device__ __forceinline__ bf16* WinT() const { return (bf16*)(A.ws + WS_WINT); }
    __device__ __forceinline__ bf16* WoutT() const { return (bf16*)(A.ws + WS_WOUTT); }
    __device__ __forceinline__ bf16* PROJ() const { return (bf16*)(A.ws + WS_PROJ); }
    __device__ __forceinline__ bf16* MIX() const { return (bf16*)(A.ws + WS_MIX); }
    __device__ __forceinline__ bf16* SIN() const { return (bf16*)(A.ws + WS_SIN); }
    __device__ __forceinline__ bf16* PWT() const { return (bf16*)(A.ws + WS_PWT); }
    __device__ __forceinline__ float* DTRAW() const { return (float*)(A.ws + WS_DTRAW); }
    __device__ __forceinline__ float* YBUF() const { return (float*)(A.ws + WS_YBUF); }
    __device__ __forceinline__ float* ST() const { return (float*)(A.ws + WS_ST); }
    __device__ __forceinline__ float* CHDEC() const { return (float*)(A.ws + WS_CHDEC); }
    __device__ __forceinline__ bf16* YD() const { return (bf16*)(A.ws + WS_YD); }
    __device__ __forceinline__ bf16* CC() const { return (bf16*)(A.ws + WS_CC); }
    __device__ __forceinline__ bf16* ZT() const { return (bf16*)(A.ws + WS_ZT); }
    __device__ __forceinline__ float* EA() const { return (float*)(A.ws + WS_EA); }
    __device__ __forceinline__ float* out() const { return A.out; }
};

struct TrItem { const float* W; bf16* WT; int K, N, item; };
__device__ __forceinline__ void p0_tr_load(const TrItem& t, int lane, float (&tv)[32]) {
    const int nblk = (t.N + 31) / 32, kb = t.item / nblk, nb = t.item % nblk, k0 = 64 * kb, n0 = 32 * nb;
    const bool ok = (n0 + (lane & 31)) < t.N;
#pragma unroll
    for (int i = 0; i < 32; ++i) { const int kk = 2 * i + (lane >> 5); tv[i] = ok ? t.W[(size_t)(k0 + kk) * t.N + n0 + (lane & 31)] : 0.f; }
}
__device__ __forceinline__ void p0_tr_finish(const TrItem& t, int lane, const float (&tv)[32], LAS float* scr) {
    const int nblk = (t.N + 31) / 32, kb = t.item / nblk, nb = t.item % nblk, k0 = 64 * kb, n0 = 32 * nb;
#pragma unroll
    for (int i = 0; i < 32; ++i) { const int kk = 2 * i + (lane >> 5); scr[kk * 33 + (lane & 31)] = tv[i]; }
    LDS_WAIT(); asm volatile("" ::: "memory");
    const int c = lane & 7;
#pragma unroll
    for (int j = 0; j < 4; ++j) { const int n = (lane >> 3) + 8 * j; const LAS float* s = scr + (8 * c) * 33 + n;
        v4u o; o.x = pk2(s[0 * 33], s[1 * 33]); o.y = pk2(s[2 * 33], s[3 * 33]); o.z = pk2(s[4 * 33], s[5 * 33]); o.w = pk2(s[6 * 33], s[7 * 33]);
        *(GAS v4u*)(t.WT + (size_t)(n0 + n) * t.K + k0 + 8 * c) = o; }
    LDS_WAIT(); asm volatile("" ::: "memory");
}
__device__ __forceinline__ TrItem p0_item(const Frame& F, int it) {
    constexpr int I_IN = (DMODEL / 64) * ((NPROJ + 31) / 32), I_OUT = (DMIX / 64) * (DMODEL / 32);
    if (it < I_IN) return TrItem{F.w_in(), F.WinT(), DMODEL, NPROJ, it};
    if (it < I_IN + I_OUT) return TrItem{F.w_out(), F.WoutT(), DMIX, DMODEL, it - I_IN};
    const int j = it - I_IN - I_OUT; return TrItem{F.pool_w() + (size_t)(j >> 5) * 65536, F.PWT() + (size_t)(j >> 5) * 65536, 256, 256, j & 31};
}
__device__ __forceinline__ void p0_prologue(Frame& F) {
    LAS float* scr = (LAS float*)(F.lds + F.wave * 16384);
    const int gw = F.bid * NWAVES + F.wave, NGW = F.G * NWAVES;
    constexpr int NIT = (DMODEL / 64) * ((NPROJ + 31) / 32) + (DMIX / 64) * (DMODEL / 32) + 128;
    { float ta[32], tb[32]; int it = gw;
      if (it < NIT) p0_tr_load(p0_item(F, it), F.lane, ta);
      while (it < NIT) {
          if (it + NGW < NIT) p0_tr_load(p0_item(F, it + NGW), F.lane, tb);
          p0_tr_finish(p0_item(F, it), F.lane, ta, scr); it += NGW;
          if (it >= NIT) break;
          if (it + NGW < NIT) p0_tr_load(p0_item(F, it + NGW), F.lane, ta);
          p0_tr_finish(p0_item(F, it), F.lane, tb, scr); it += NGW;
      } }
    { const size_t z0 = (size_t)10304 * DMODEL * 2, z1 = (size_t)NPROJ_PAD * DMODEL * 2; GAS v4u* zp = (GAS v4u*)((unsigned char*)F.WinT() + z0);
      const size_t nz = (z1 - z0) / 16; for (size_t i = (size_t)F.bid * NTHR + F.tid; i < nz; i += (size_t)F.G * NTHR) zp[i] = (v4u){0u, 0u, 0u, 0u}; }
    { const GAS f32x4* gr = (const GAS f32x4*)F.norm_g() + F.lane; f32x4 va[8], vb[8]; int m = gw;
#define XROW(mm) ((const GAS f32x4*)(((mm) < NPR) ? F.x_prompt() + (size_t)(mm) * DMODEL : F.x_sample() + (size_t)((mm) - NPR) * DMODEL) + F.lane)
#define XLOAD(mm, v) do { const GAS f32x4* xr_ = XROW(mm); _Pragma("unroll") for (int j = 0; j < 8; ++j) v[j] = xr_[64 * j]; } while (0)
#define XFIN(mm, v) do { float s_ = 0.f; _Pragma("unroll") for (int j = 0; j < 8; ++j) s_ += (v[j].x * v[j].x + v[j].y * v[j].y) + (v[j].z * v[j].z + v[j].w * v[j].w); \
        const float r_ = 1.f / sqrtf(wave_sum(s_) * (1.f / DMODEL) + EPS); GAS unsigned long long* o8_ = (GAS unsigned long long*)(F.XN() + (size_t)(mm) * DMODEL) + F.lane; \
        _Pragma("unroll") for (int j = 0; j < 8; ++j) { const f32x4 g_ = gr[64 * j]; o8_[64 * j] = (unsigned long long)pk2(v[j].x * r_ * g_.x, v[j].y * r_ * g_.y) | ((unsigned long long)pk2(v[j].z * r_ * g_.z, v[j].w * r_ * g_.w) << 32); } } while (0)
      if (m < MROWS) XLOAD(m, va);
      while (m < MROWS) {
          if (m + NGW < MROWS) XLOAD(m + NGW, vb);
          XFIN(m, va); m += NGW;
          if (m >= MROWS) break;
          if (m + NGW < MROWS) XLOAD(m + NGW, va);
          XFIN(m, vb); m += NGW;
      }
#undef XROW
#undef XLOAD
#undef XFIN
    }
}

__device__ __forceinline__ void pool_unit(Frame& F, int tile, int gi) {
    LAS float* pooled = (LAS float*)F.lds;
    const int w = 2 << gi, m0 = tile * 32, c = F.tid & 255, th = F.tid >> 8, ch = gi * 256 + c;
    for (int i = 0; i < 16; ++i) {
        const int t = th * 16 + i, m = m0 + t; const bool prompt = m < NPR;
        int b, tq, cnt; if (prompt) { b = m >> 11; tq = m & 2047; cnt = min(w, tq + 1); } else { const int ms = m - NPR; b = ms >> 2; tq = ms & 3; cnt = w; }
        float sum = 0.f;
        for (int j = 0; j < w; ++j) { const int tt = tq - j; float v;
            if (tt >= 0) v = bf2f(F.PROJ()[(size_t)(m - j) * PLD + ch]); else v = prompt ? 0.f : F.state_pool()[(size_t)(b * 15 + 15 + tt) * DPOOL + ch];
            sum += v; }
        const float u0 = bf2f(F.PROJ()[(size_t)m * PLD + ch]);
        pooled[t * 256 + c] = sum / (float)cnt - u0;
    }
    __syncthreads();
    float acc[16];
#pragma unroll
    for (int i = 0; i < 16; ++i) acc[i] = 0.f;
    const float* W = F.pool_w() + (size_t)gi * 65536 + c;
    for (int c4 = 0; c4 < 64; ++c4) {
        const float w0 = W[(size_t)(4 * c4 + 0) * 256], w1 = W[(size_t)(4 * c4 + 1) * 256], w2 = W[(size_t)(4 * c4 + 2) * 256], w3 = W[(size_t)(4 * c4 + 3) * 256];
#pragma unroll
        for (int i = 0; i < 16; ++i) { const f32x4 p4 = *(const LAS f32x4*)(pooled + (th * 16 + i) * 256 + 4 * c4); acc[i] += (p4.x * w0 + p4.y * w1) + (p4.z * w2 + p4.w * w3); }
    }
    const float sc = F.pool_scale()[ch];
#pragma unroll
    for (int i = 0; i < 16; ++i) { const int m = m0 + th * 16 + i; const float gate = bf2f(F.PROJ()[(size_t)m * PLD + C_GATE + ch]);
        F.MIX()[(size_t)m * DMIX + ch] = (bf16)f2bf(acc[i] * sc * silu_f(gate)); }
    __syncthreads();
}

__device__ __forceinline__ void ssd_unit(Frame& F, int seq, int h) {
    const bool prompt = seq < 4; const int L = prompt ? 2048 : 4, sb = seq - 4, row0 = prompt ? seq * 2048 : NPR + sb * 4, g = h / 6;
    const int p = F.tid >> 3, nq = F.tid & 7;
    LAS float* T = (LAS float*)F.lds;
    LAS float* dts = T + 32 * 320; LAS float* dec = dts + 32;
    float S[16];
    if (prompt) {
#pragma unroll
        for (int j = 0; j < 16; ++j) S[j] = 0.f;
    } else { const f32x4* sp = (const f32x4*)(F.state_ssm() + ((size_t)(sb * NHEAD + h) * HDIM + p) * DSTATE + nq * 16);
#pragma unroll
        for (int q = 0; q < 4; ++q) { const f32x4 v = sp[q]; S[4 * q] = v.x; S[4 * q + 1] = v.y; S[4 * q + 2] = v.z; S[4 * q + 3] = v.w; } }
    const float a = -__expf(F.a_log()[h]), dtb = F.dt_bias()[h], dsk = F.d_skip()[h];
    for (int t0 = 0; t0 < L; t0 += 32) {
        const int nt = min(32, L - t0);
        __syncthreads();
        for (int e = F.tid; e < nt * 320; e += NTHR) {
            const int t = e / 320, c = e - t * 320;
            const int xch = c < 64 ? h * 64 + c : (c < 192 ? 3072 + g * 128 + (c - 64) : 4096 + g * 128 + (c - 192));
            float acc = F.conv_b()[xch];
#pragma unroll
            for (int k = 0; k < 4; ++k) { const int tt = t0 + t + k - 3; float v;
                if (tt >= 0) v = bf2f(F.PROJ()[(size_t)(row0 + tt) * PLD + C_XBC + xch]); else v = prompt ? 0.f : F.state_conv()[(size_t)(sb * 3 + 3 + tt) * DCONV + xch];
                acc += v * F.conv_w()[k * DCONV + xch]; }
            T[e] = silu_f(acc);
        }
        for (int t = F.tid; t < nt; t += NTHR) { const float dt = softplus_f(F.DTRAW()[(size_t)(row0 + t0 + t) * 64 + h] + dtb); dts[t] = dt; dec[t] = __expf(dt * a); }
        __syncthreads();
        for (int t = 0; t < nt; ++t) {
            const LAS float* r = T + t * 320;
            const float x = r[p], d = dec[t], dtx = dts[t] * x; float acc = 0.f;
#pragma unroll
            for (int q = 0; q < 4; ++q) { const f32x4 bv = *(const LAS f32x4*)(r + 64 + nq * 16 + 4 * q), cv = *(const LAS f32x4*)(r + 192 + nq * 16 + 4 * q);
                S[4 * q] = d * S[4 * q] + dtx * bv.x; S[4 * q + 1] = d * S[4 * q + 1] + dtx * bv.y; S[4 * q + 2] = d * S[4 * q + 2] + dtx * bv.z; S[4 * q + 3] = d * S[4 * q + 3] + dtx * bv.w;
                acc += (cv.x * S[4 * q] + cv.y * S[4 * q + 1]) + (cv.z * S[4 * q + 2] + cv.w * S[4 * q + 3]); }
            acc += __shfl_xor(acc, 1); acc += __shfl_xor(acc, 2); acc += __shfl_xor(acc, 4);
            if (nq == 0) F.YBUF()[(size_t)(row0 + t0 + t) * DSSM + h * 64 + p] = acc + dsk * x;
        }
    }
    float* so = F.out() + (prompt ? O_SSM_P + ((size_t)(seq * NHEAD + h) * HDIM + p) * DSTATE : O_SSM_S + ((size_t)(sb * NHEAD + h) * HDIM + p) * DSTATE) + nq * 16;
#pragma unroll
    for (int q = 0; q < 4; ++q) *(f32x4*)(so + 4 * q) = (f32x4){S[4 * q], S[4 * q + 1], S[4 * q + 2], S[4 * q + 3]};
    __syncthreads();
}


typedef short s16x8 __attribute__((ext_vector_type(8)));
typedef float f32x16 __attribute__((ext_vector_type(16)));
typedef unsigned u32x2 __attribute__((ext_vector_type(2)));
typedef float f32x2 __attribute__((ext_vector_type(2)));
constexpr int PT = 272;
__device__ __forceinline__ unsigned cvtpk(float lo, float hi) { return pg8::cvt_pk_bf16(lo, hi); }
__device__ __forceinline__ float bflo(unsigned w) { return __builtin_bit_cast(float, w << 16); }
__device__ __forceinline__ float bfhi(unsigned w) { return __builtin_bit_cast(float, w & 0xffff0000u); }
__device__ __forceinline__ f32x16 mfma32(s16x8 a, s16x8 b, f32x16 c) { return __builtin_amdgcn_mfma_f32_32x32x16_bf16(a, b, c, 0, 0, 0); }
__device__ __forceinline__ s16x8 ldfrag(const LAS unsigned char* img, int row, int ks, int hh) { return *(const LAS s16x8*)(img + row * PT + ks * 32 + hh * 16); }
__device__ __forceinline__ void conv_load(const Frame& F, int seq_row0, int t0, int xch, unsigned (&raw)[11]) {
    const bf16* base = F.PROJ() + (size_t)seq_row0 * PLD + C_XBC + xch;
#pragma unroll
    for (int i = 0; i < 11; ++i) { const int t = t0 - 3 + i; raw[i] = (t >= 0) ? *(const unsigned*)(base + (size_t)t * PLD) : 0u; }
}
__device__ __forceinline__ void conv_fin(const Frame& F, int xch, const unsigned (&raw)[11], float (&o0)[8], float (&o1)[8]) {
    f32x2 w[4];
#pragma unroll
    for (int k = 0; k < 4; ++k) w[k] = *(const f32x2*)(F.conv_w() + k * DCONV + xch);
    const f32x2 bb = *(const f32x2*)(F.conv_b() + xch);
#pragma unroll
    for (int o = 0; o < 8; ++o) { float a0 = bb.x, a1 = bb.y;
#pragma unroll
        for (int k = 0; k < 4; ++k) { a0 += bflo(raw[o + k]) * w[k].x; a1 += bfhi(raw[o + k]) * w[k].y; }
        o0[o] = silu_f(a0); o1[o] = silu_f(a1); }
}
__device__ __forceinline__ void conv8x2(const Frame& F, int seq_row0, int t0, int xch, float (&o0)[8], float (&o1)[8]) { unsigned raw[11]; conv_load(F, seq_row0, t0, xch, raw); conv_fin(F, xch, raw, o0, o1); }
__device__ __forceinline__ v4u pack8(const float (&o)[8]) { v4u r; r.x = cvtpk(o[0], o[1]); r.y = cvtpk(o[2], o[3]); r.z = cvtpk(o[4], o[5]); r.w = cvtpk(o[6], o[7]); return r; }
__device__ __forceinline__ void chunk_dt(const Frame& F, int row0, int g, LAS float* dtl, LAS float* Ac) {
    if (F.wave < 6) {
        const int h = 6 * g + F.wave; const float a = -__expf(F.a_log()[h]), bias = F.dt_bias()[h]; const int l0 = 2 * F.lane;
        const float d0 = softplus_f(F.DTRAW()[(size_t)(row0 + l0) * 64 + h] + bias), d1 = softplus_f(F.DTRAW()[(size_t)(row0 + l0 + 1) * 64 + h] + bias);
        const float e0 = d0 * a, e1 = d1 * a; float s = e0 + e1;
#pragma unroll
        for (int o = 1; o < 64; o <<= 1) { const float u = __shfl_up(s, o); if (F.lane >= o) s += u; }
        dtl[F.wave * 128 + l0] = d0; dtl[F.wave * 128 + l0 + 1] = d1; Ac[F.wave * 128 + l0] = s - e1; Ac[F.wave * 128 + l0 + 1] = s;
    }
}
__device__ __forceinline__ void px_unit(Frame& F, int b, int c, int g) {
    LAS unsigned char* Cn = F.lds;
    LAS unsigned char* Bn = F.lds + 34816;
    LAS unsigned char* BT = F.lds + 69632;
    LAS unsigned char* XT = F.lds + 104448;
    LAS unsigned char* XwT = F.lds + 121856;
    LAS float* dtl = (LAS float*)(F.lds + 139264); LAS float* Ac = (LAS float*)(F.lds + 142336);
    const int seq_row0 = b * 2048, tok0 = c * 128, row0 = seq_row0 + tok0, hh = F.lane >> 5, l31 = F.lane & 31;
    const int li = F.wave >> 1, sh = F.wave & 1, pj = F.wave & 1, l = 32 * li + l31, pi = F.wave >> 2, ni = F.wave & 3;
    const int xcp = F.tid & 31, xto = F.tid >> 5;
    __syncthreads();
    chunk_dt(F, row0, g, dtl, Ac);
    { unsigned raw[4][11];
#pragma unroll
      for (int j = 0; j < 4; ++j) { const int it = F.tid + NTHR * j, isC = it >> 10, cp = it & 63, to = (it >> 6) & 15; conv_load(F, seq_row0, tok0 + 8 * to, 3072 + isC * 1024 + g * 128 + 2 * cp, raw[j]); }
#pragma unroll
      for (int j = 0; j < 4; ++j) { const int it = F.tid + NTHR * j, isC = it >> 10, cp = it & 63, to = (it >> 6) & 15; float o0[8], o1[8];
        conv_fin(F, 3072 + isC * 1024 + g * 128 + 2 * cp, raw[j], o0, o1);
        LAS unsigned char* img = (isC ? Cn : Bn) + (8 * to) * PT + cp * 4;
        if (isC) { bf16* cg = F.CC() + (size_t)(row0 + 8 * to) * 1024 + g * 128 + 2 * cp;
#pragma unroll
            for (int o = 0; o < 8; ++o) { const unsigned w = cvtpk(o0[o], o1[o]); *(LAS unsigned*)(img + o * PT) = w; *(unsigned*)(cg + (size_t)o * 1024) = w; }
        } else {
#pragma unroll
            for (int o = 0; o < 8; ++o) *(LAS unsigned*)(img + o * PT) = cvtpk(o0[o], o1[o]);
            *(LAS v4u*)(BT + (2 * cp) * PT + to * 16) = pack8(o0); *(LAS v4u*)(BT + (2 * cp + 1) * PT + to * 16) = pack8(o1); } } }
    unsigned rawx[11];
    conv_load(F, seq_row0, tok0 + 8 * xto, (6 * g) * 64 + 2 * xcp, rawx);
    __syncthreads();
    if (F.tid < 6) F.CHDEC()[(size_t)(b * 16 + c) * NHEAD + 6 * g + F.tid] = __expf(Ac[F.tid * 128 + 127]);
    for (int i = F.tid; i < 768; i += NTHR) { const int r = i >> 7, t = i & 127; F.EA()[(size_t)(row0 + t) * NHEAD + 6 * g + r] = __expf(Ac[i]); }
    f32x16 gt0, gt1;
#pragma unroll
    for (int i = 0; i < 16; ++i) { gt0[i] = 0.f; gt1[i] = 0.f; }
    if (2 * sh <= li) {
#pragma unroll
        for (int ks = 0; ks < 8; ++ks) gt0 = mfma32(ldfrag(Bn, 64 * sh + l31, ks, hh), ldfrag(Cn, l, ks, hh), gt0);
    }
    if (2 * sh + 1 <= li) {
#pragma unroll
        for (int ks = 0; ks < 8; ++ks) gt1 = mfma32(ldfrag(Bn, 64 * sh + 32 + l31, ks, hh), ldfrag(Cn, l, ks, hh), gt1);
    }
    unsigned long long* ydt = (unsigned long long*)F.YD() + ((size_t)((b * 128 + c * 8 + g) * 6) * 8 + F.wave) * 256 + F.lane;
#pragma unroll 1
    for (int r = 0; r < 6; ++r) {
        const int h = 6 * g + r; const float dsk = F.d_skip()[h];
        __syncthreads();
        { float o0[8], o1[8]; conv_fin(F, h * 64 + 2 * xcp, rawx, o0, o1);
          *(LAS v4u*)(XT + (2 * xcp) * PT + xto * 16) = pack8(o0); *(LAS v4u*)(XT + (2 * xcp + 1) * PT + xto * 16) = pack8(o1);
          const float aend = Ac[r * 128 + 127];
#pragma unroll
          for (int o = 0; o < 8; ++o) { const float wl = __expf(aend - Ac[r * 128 + 8 * xto + o]) * dtl[r * 128 + 8 * xto + o]; o0[o] *= wl; o1[o] *= wl; }
          *(LAS v4u*)(XwT + (2 * xcp) * PT + xto * 16) = pack8(o0); *(LAS v4u*)(XwT + (2 * xcp + 1) * PT + xto * 16) = pack8(o1); }
        { const float Al = Ac[r * 128 + l];
#pragma unroll
          for (int tsel = 0; tsel < 2; ++tsel) { const int si = 2 * sh + tsel;
            if (si <= li) {
#pragma unroll
                for (int q = 0; q < 4; ++q) { const int s0 = 32 * si + 8 * q + 4 * hh;
                    const f32x4 As4 = *(const LAS f32x4*)(Ac + r * 128 + s0), dt4 = *(const LAS f32x4*)(dtl + r * 128 + s0); float v[4];
#pragma unroll
                    for (int j = 0; j < 4; ++j) { const float gv = tsel ? gt1[4 * q + j] : gt0[4 * q + j]; const float e = __expf(fminf(Al - As4[j], 0.f));
                        v[j] = (s0 + j <= l) ? gv * e * dt4[j] : 0.f; v[j] += (s0 + j == l) ? dsk : 0.f; }
                    u32x2 pk; pk.x = cvtpk(v[0], v[1]); pk.y = cvtpk(v[2], v[3]);
                    *(LAS u32x2*)(Bn + l * PT + s0 * 2) = pk; } } } }
        if (r < 5) conv_load(F, seq_row0, tok0 + 8 * xto, (h + 1) * 64 + 2 * xcp, rawx);
        __syncthreads();
        { f32x16 acc;
#pragma unroll
          for (int i = 0; i < 16; ++i) acc[i] = 0.f;
          for (int ks = 0; ks < 2 * (li + 1); ++ks) acc = mfma32(ldfrag(XT, 32 * pj + l31, ks, hh), ldfrag(Bn, l, ks, hh), acc);
#pragma unroll
          for (int q = 0; q < 4; ++q) ydt[(size_t)r * 2048 + q * 64] = (unsigned long long)cvtpk(acc[4 * q], acc[4 * q + 1]) | ((unsigned long long)cvtpk(acc[4 * q + 2], acc[4 * q + 3]) << 32); }
        { f32x16 acc;
#pragma unroll
          for (int i = 0; i < 16; ++i) acc[i] = 0.f;
#pragma unroll
          for (int ks = 0; ks < 8; ++ks) acc = mfma32(ldfrag(BT, 32 * ni + l31, ks, hh), ldfrag(XwT, 32 * pi + l31, ks, hh), acc);
          float* so = F.ST() + ((size_t)((b * 16 + c) * NHEAD + h) * HDIM + 32 * pi + l31) * DSTATE + 32 * ni + 4 * hh;
#pragma unroll
          for (int q = 0; q < 4; ++q) *(f32x4*)(so + 8 * q) = (f32x4){acc[4 * q], acc[4 * q + 1], acc[4 * q + 2], acc[4 * q + 3]}; }
    }
}
__device__ __forceinline__ void p2b_scan(Frame& F) {
    const int gt = F.bid * NTHR + F.tid, GT = F.G * NTHR;
    for (int i = gt; i < 4 * NHEAD * 2048; i += GT) {
        const int b = i / (NHEAD * 2048), rem = i - b * (NHEAD * 2048), h = rem >> 11, e = rem & 2047;
        f32x4 st[16];
#pragma unroll
        for (int c = 0; c < 16; ++c) st[c] = *((const f32x4*)F.ST() + ((size_t)((b * 16 + c) * NHEAD + h) * 2048 + e));
        f32x4 s = (f32x4){0.f, 0.f, 0.f, 0.f};
#pragma unroll
        for (int c = 0; c < 16; ++c) {
            u32x2 pk; pk.x = cvtpk(s.x, s.y); pk.y = cvtpk(s.z, s.w);
            *((u32x2*)F.SIN() + ((size_t)((b * 16 + c) * NHEAD + h) * 2048 + e)) = pk;
            const float d = F.CHDEC()[(size_t)(b * 16 + c) * NHEAD + h];
            s = s * d + st[c];
        }
        *((f32x4*)(F.out() + O_SSM_P) + ((size_t)(b * NHEAD + h) * 2048 + e)) = s;
    }
}
constexpr int PZY = 784;
__device__ __forceinline__ void pz_unit(Frame& F, int b, int c, int g) {
    LAS unsigned char* YZ = F.lds;
    LAS float* part = (LAS float*)(F.lds + 100352);
    const int row0 = b * 2048 + c * 128, hh = F.lane >> 5, l31 = F.lane & 31, li = F.wave >> 1, pj = F.wave & 1, l = 32 * li + l31, uu = b * 128 + c * 8 + g;
    const bf16* sing = F.SIN() + ((size_t)((b * 16 + c) * NHEAD) * HDIM + 32 * pj + l31) * DSTATE + 8 * hh;
    const float* earow = F.EA() + (size_t)(row0 + l) * NHEAD;
    const unsigned long long* ydt = (const unsigned long long*)F.YD() + ((size_t)(uu * 6) * 8 + F.wave) * 256 + F.lane;
    const unsigned long long* ztt = (const unsigned long long*)F.ZT() + ((size_t)(uu * 6) * 8 + F.wave) * 256 + F.lane;
    v4u cfr[8];
#pragma unroll
    for (int ks = 0; ks < 8; ++ks) cfr[ks] = *(const v4u*)(F.CC() + (size_t)(row0 + l) * 1024 + g * 128 + 16 * ks + 8 * hh);
    v4u sn[8]; unsigned long long ydn[4], zn[4]; float ean;
#define PZ_LOAD(r_) do { _Pragma("unroll") for (int ks = 0; ks < 8; ++ks) sn[ks] = *(const v4u*)(sing + (size_t)(6 * g + (r_)) * HDIM * DSTATE + 16 * ks); \
        _Pragma("unroll") for (int q = 0; q < 4; ++q) { ydn[q] = ydt[(size_t)(r_) * 2048 + q * 64]; zn[q] = ztt[(size_t)(r_) * 2048 + q * 64]; } ean = earow[6 * g + (r_)]; } while (0)
    PZ_LOAD(0);
    float ss = 0.f;
    __syncthreads();
#pragma unroll 1
    for (int r = 0; r < 6; ++r) {
        v4u sc[8]; unsigned long long yd[4], zc[4]; const float ea = ean;
#pragma unroll
        for (int ks = 0; ks < 8; ++ks) sc[ks] = sn[ks];
#pragma unroll
        for (int q = 0; q < 4; ++q) { yd[q] = ydn[q]; zc[q] = zn[q]; }
        if (r < 5) PZ_LOAD(r + 1);
        f32x16 acc;
#pragma unroll
        for (int i = 0; i < 16; ++i) acc[i] = 0.f;
#pragma unroll
        for (int ks = 0; ks < 8; ++ks) acc = mfma32(__builtin_bit_cast(s16x8, sc[ks]), __builtin_bit_cast(s16x8, cfr[ks]), acc);
        LAS unsigned char* yp = YZ + l * PZY + (r * 64 + 32 * pj + 4 * hh) * 2;
#pragma unroll
        for (int q = 0; q < 4; ++q) { const unsigned y01 = (unsigned)yd[q], y23 = (unsigned)(yd[q] >> 32), z01 = (unsigned)zc[q], z23 = (unsigned)(zc[q] >> 32);
            const float y0 = (acc[4 * q] * ea + bflo(y01)) * silu_f(bflo(z01)), y1 = (acc[4 * q + 1] * ea + bfhi(y01)) * silu_f(bfhi(z01));
            const float y2 = (acc[4 * q + 2] * ea + bflo(y23)) * silu_f(bflo(z23)), y3 = (acc[4 * q + 3] * ea + bfhi(y23)) * silu_f(bfhi(z23));
            ss += (y0 * y0 + y1 * y1) + (y2 * y2 + y3 * y3); u32x2 o; o.x = cvtpk(y0, y1); o.y = cvtpk(y2, y3); *(LAS u32x2*)(yp + 16 * q) = o; }
    }
#undef PZ_LOAD
    part[l * 4 + pj * 2 + hh] = ss;
    __syncthreads();
#pragma unroll 3
    for (int j = 0; j < 12; ++j) { const int ch = F.tid + NTHR * j, row = ch / 48, cc = ch - row * 48;
        const f32x4 pv = *(const LAS f32x4*)(part + row * 4); const float rstd = 1.f / sqrtf(((pv.x + pv.y) + (pv.z + pv.w)) * (1.f / 384.f) + EPS);
        const v4u yv = *(const LAS v4u*)(YZ + row * PZY + cc * 16);
        const f32x4 g0 = *(const f32x4*)(F.ssm_norm_g() + g * 384 + cc * 8), g1 = *(const f32x4*)(F.ssm_norm_g() + g * 384 + cc * 8 + 4);
        v4u o; o.x = cvtpk(bflo(yv.x) * rstd * g0.x, bfhi(yv.x) * rstd * g0.y); o.y = cvtpk(bflo(yv.y) * rstd * g0.z, bfhi(yv.y) * rstd * g0.w);
        o.z = cvtpk(bflo(yv.z) * rstd * g1.x, bfhi(yv.z) * rstd * g1.y); o.w = cvtpk(bflo(yv.w) * rstd * g1.z, bfhi(yv.w) * rstd * g1.w);
        *(v4u*)(F.MIX() + (size_t)(row0 + row) * DMIX + DPOOL + g * 384 + cc * 8) = o; }
}
constexpr int PT2 = 528;
template <int W> __device__ __forceinline__ void pool_stage_prompt(const Frame& F, LAS unsigned char* Ap, int m0, int gi) {
    for (int it = F.tid; it < 1024; it += NTHR) { const int cp = it & 127, to = it >> 7, mrow = m0 + 8 * to, tseq = mrow & 2047;
        const bf16* base = F.PROJ() + (size_t)mrow * PLD + gi * 256 + 2 * cp;
        unsigned raw[W + 7];
#pragma unroll
        for (int i = 0; i < W + 7; ++i) { const int dt = i - (W - 1); raw[i] = (tseq + dt >= 0) ? *(const unsigned*)(base + (ptrdiff_t)dt * PLD) : 0u; }
        float s0 = 0.f, s1 = 0.f;
#pragma unroll
        for (int i = 0; i < W - 1; ++i) { s0 += bflo(raw[i]); s1 += bfhi(raw[i]); }
#pragma unroll
        for (int o = 0; o < 8; ++o) { const float u0 = bflo(raw[o + W - 1]), u1 = bfhi(raw[o + W - 1]); s0 += u0; s1 += u1;
            const float inv = 1.f / (float)min(W, tseq + o + 1);
            *(LAS unsigned*)(Ap + (8 * to + o) * PT2 + cp * 4) = cvtpk(s0 * inv - u0, s1 * inv - u1);
            s0 -= bflo(raw[o]); s1 -= bfhi(raw[o]); }
    }
}
template <int W> __device__ __forceinline__ void pool_stage_sample(const Frame& F, LAS unsigned char* Ap, int m0, int gi) {
    for (int it = F.tid; it < 2048; it += NTHR) { const int cp = it & 127, sq = it >> 7, b = (m0 - NPR) / 4 + sq, ch = gi * 256 + 2 * cp;
        f32x2 hv[W - 1]; unsigned raw[4];
#pragma unroll
        for (int i = 0; i < W - 1; ++i) hv[i] = *(const f32x2*)(F.state_pool() + (size_t)(b * 15 + 15 - (W - 1) + i) * DPOOL + ch);
#pragma unroll
        for (int t = 0; t < 4; ++t) raw[t] = *(const unsigned*)(F.PROJ() + (size_t)(NPR + 4 * b + t) * PLD + ch);
        float e0[W + 3], e1[W + 3];
#pragma unroll
        for (int i = 0; i < W - 1; ++i) { e0[i] = hv[i].x; e1[i] = hv[i].y; }
#pragma unroll
        for (int t = 0; t < 4; ++t) { e0[W - 1 + t] = bflo(raw[t]); e1[W - 1 + t] = bfhi(raw[t]); }
        float s0 = 0.f, s1 = 0.f;
#pragma unroll
        for (int i = 0; i < W - 1; ++i) { s0 += e0[i]; s1 += e1[i]; }
#pragma unroll
        for (int t = 0; t < 4; ++t) { s0 += e0[W - 1 + t]; s1 += e1[W - 1 + t];
            *(LAS unsigned*)(Ap + (4 * sq + t) * PT2 + cp * 4) = cvtpk(s0 * (1.f / W) - e0[W - 1 + t], s1 * (1.f / W) - e1[W - 1 + t]);
            s0 -= e0[t]; s1 -= e1[t]; }
    }
}
__device__ __forceinline__ void pool_unit_mfma(Frame& F, int tile, int gi) {
    LAS unsigned char* Ap = F.lds;
    LAS unsigned char* Wt = F.lds + 33792;
    const int m0 = tile * 64, hh = F.lane >> 5, l31 = F.lane & 31;
    __syncthreads();
    if (m0 < NPR) {
        if (gi == 0) pool_stage_prompt<2>(F, Ap, m0, gi); else if (gi == 1) pool_stage_prompt<4>(F, Ap, m0, gi);
        else if (gi == 2) pool_stage_prompt<8>(F, Ap, m0, gi); else pool_stage_prompt<16>(F, Ap, m0, gi);
    } else {
        if (gi == 0) pool_stage_sample<2>(F, Ap, m0, gi); else if (gi == 1) pool_stage_sample<4>(F, Ap, m0, gi);
        else if (gi == 2) pool_stage_sample<8>(F, Ap, m0, gi); else pool_stage_sample<16>(F, Ap, m0, gi);
    }
    const int ti = F.wave >> 2, di = F.wave & 3;
    for (int dh = 0; dh < 2; ++dh) {
        if (dh) __syncthreads();
        { const bf16* wg = F.PWT() + (size_t)(gi * 256 + dh * 128) * 256;
#pragma unroll
          for (int j = 0; j < 8; ++j) { const int idx = F.tid + NTHR * j, d = idx >> 5, seg = idx & 31; *(LAS v4u*)(Wt + d * PT2 + seg * 16) = *(const v4u*)(wg + d * 256 + seg * 8); } }
        __syncthreads();
        f32x16 acc;
#pragma unroll
        for (int i = 0; i < 16; ++i) acc[i] = 0.f;
#pragma unroll
        for (int ks = 0; ks < 16; ++ks) acc = mfma32(*(const LAS s16x8*)(Ap + (32 * ti + l31) * PT2 + ks * 32 + hh * 16), *(const LAS s16x8*)(Wt + (32 * di + l31) * PT2 + ks * 32 + hh * 16), acc);
        const int d = gi * 256 + dh * 128 + 32 * di + l31; const float sc = F.pool_scale()[d];
#pragma unroll
        for (int i = 0; i < 16; ++i) { const size_t row = (size_t)(m0 + 32 * ti + (i & 3) + 8 * (i >> 2) + 4 * hh); const float gate = bf2f(F.PROJ()[row * PLD + C_GATE + d]);
            F.MIX()[row * DMIX + d] = (bf16)f2bf(acc[i] * sc * silu_f(gate)); }
    }
}
__device__ __forceinline__ void sample_unit(Frame& F, int pair, int g) {
    LAS float* T = (LAS float*)F.lds;
    LAS float* dts = T + 5120; LAS float* dec = dts + 48; LAS float* ys = dec + 48;
    const int sb0 = 2 * pair, row0 = NPR + sb0 * 4, p = F.tid >> 3, nq = F.tid & 7;
    const float* sbase = F.state_ssm() + ((size_t)(sb0 * NHEAD + 6 * g) * HDIM + p) * DSTATE + nq * 4;
    float* obase = F.out() + O_SSM_S + ((size_t)(sb0 * NHEAD + 6 * g) * HDIM + p) * DSTATE + nq * 4;
#define TASK_OFF(k) ((size_t)(((k) / 6) * NHEAD + ((k) % 6)) * HDIM * DSTATE)
    f32x4 S[3][4];
#pragma unroll
    for (int k = 0; k < 2; ++k) {
#pragma unroll
        for (int q = 0; q < 4; ++q) S[k][q] = *((const f32x4*)(sbase + TASK_OFF(k)) + 8 * q); }
    f32x2 hv[2][3], cw[2][4], cb[2]; unsigned raw[2][4]; int cidx[2], tok[2];
#pragma unroll
    for (int j = 0; j < 2; ++j) { const int it = F.tid + NTHR * j; const bool on = it < 640; const int sq = (on && it >= 320) ? 1 : 0, c = on ? 2 * (it - 320 * sq) : 0;
        const int xch = c < 128 ? 3072 + g * 128 + c : (c < 256 ? 4096 + g * 128 + (c - 128) : g * 384 + (c - 256));
        cidx[j] = on ? c : -1; tok[j] = 4 * sq;
#pragma unroll
        for (int i = 0; i < 3; ++i) hv[j][i] = *(const f32x2*)(F.state_conv() + (size_t)((sb0 + sq) * 3 + i) * DCONV + xch);
#pragma unroll
        for (int t = 0; t < 4; ++t) raw[j][t] = *(const unsigned*)(F.PROJ() + (size_t)(row0 + 4 * sq + t) * PLD + C_XBC + xch);
#pragma unroll
        for (int k = 0; k < 4; ++k) cw[j][k] = *(const f32x2*)(F.conv_w() + k * DCONV + xch);
        cb[j] = *(const f32x2*)(F.conv_b() + xch); }
    bf16 zr[6];
#pragma unroll
    for (int k = 0; k < 6; ++k) zr[k] = F.PROJ()[(size_t)(row0 + F.wave) * PLD + C_Z + g * 384 + F.lane + 64 * k];
    __syncthreads();
#pragma unroll
    for (int j = 0; j < 2; ++j) if (cidx[j] >= 0) { float e0[7], e1[7];
#pragma unroll
        for (int i = 0; i < 3; ++i) { e0[i] = hv[j][i].x; e1[i] = hv[j][i].y; }
#pragma unroll
        for (int t = 0; t < 4; ++t) { e0[3 + t] = bflo(raw[j][t]); e1[3 + t] = bfhi(raw[j][t]); }
#pragma unroll
        for (int t = 0; t < 4; ++t) { float a0 = cb[j].x, a1 = cb[j].y;
#pragma unroll
            for (int k = 0; k < 4; ++k) { a0 += e0[t + k] * cw[j][k].x; a1 += e1[t + k] * cw[j][k].y; }
            T[(tok[j] + t) * 640 + cidx[j]] = silu_f(a0); T[(tok[j] + t) * 640 + cidx[j] + 1] = silu_f(a1); } }
    if (F.tid < 48) { const int k = F.tid >> 2, t = F.tid & 3, sq = k / 6, h = 6 * g + (k - 6 * sq); const float dt = softplus_f(F.DTRAW()[(size_t)(row0 + 4 * sq + t) * 64 + h] + F.dt_bias()[h]);
        dts[F.tid] = dt; dec[F.tid] = __expf(-dt * __expf(F.a_log()[h])); }
    __syncthreads();
#pragma unroll
    for (int k = 0; k < 12; ++k) { const int sq = k / 6, r = k % 6, h = 6 * g + r, cur = k % 3; const float dsk = F.d_skip()[h];
        if (k + 2 < 12) {
#pragma unroll
            for (int q = 0; q < 4; ++q) S[(k + 2) % 3][q] = *((const f32x4*)(sbase + TASK_OFF(k + 2)) + 8 * q); }
#pragma unroll
        for (int t = 0; t < 4; ++t) { const LAS float* row = T + (4 * sq + t) * 640; const float x = row[256 + r * 64 + p], d = dec[k * 4 + t], dtx = dts[k * 4 + t] * x; float acc = 0.f;
#pragma unroll
            for (int q = 0; q < 4; ++q) { const f32x4 bv = *(const LAS f32x4*)(row + nq * 4 + 32 * q), cv = *(const LAS f32x4*)(row + 128 + nq * 4 + 32 * q);
                S[cur][q] = S[cur][q] * d + bv * dtx; const f32x4 pr = cv * S[cur][q]; acc += (pr.x + pr.y) + (pr.z + pr.w); }
            acc += __shfl_xor(acc, 1); acc += __shfl_xor(acc, 2); acc += __shfl_xor(acc, 4);
            if (nq == 0) ys[(4 * sq + t) * 384 + r * 64 + p] = acc + dsk * x; }
#pragma unroll
        for (int q = 0; q < 4; ++q) *((f32x4*)(obase + TASK_OFF(k)) + 8 * q) = S[cur][q]; }
#undef TASK_OFF
    __syncthreads();
    { float v[6]; float ss = 0.f;
#pragma unroll
      for (int k = 0; k < 6; ++k) { const int idx = F.lane + 64 * k; v[k] = ys[F.wave * 384 + idx] * silu_f(bf2f(zr[k])); ss += v[k] * v[k]; }
      const float rstd = 1.f / sqrtf(wave_sum(ss) * (1.f / 384.f) + EPS);
#pragma unroll
      for (int k = 0; k < 6; ++k) { const int idx = F.lane + 64 * k; F.MIX()[(size_t)(row0 + F.wave) * DMIX + DPOOL + g * 384 + idx] = (bf16)f2bf(v[k] * rstd * F.ssm_norm_g()[g * 384 + idx]); } }
}
__device__ __forceinline__ void copy_seg_bf16(const bf16* src, float* dst, int lane) {
    const v4u a = *((const v4u*)src + 2 * lane), b = *((const v4u*)src + 2 * lane + 1); f32x4* d = (f32x4*)dst + 4 * lane;
    d[0] = (f32x4){bflo(a.x), bfhi(a.x), bflo(a.y), bfhi(a.y)}; d[1] = (f32x4){bflo(a.z), bfhi(a.z), bflo(a.w), bfhi(a.w)};
    d[2] = (f32x4){bflo(b.x), bfhi(b.x), bflo(b.y), bfhi(b.y)}; d[3] = (f32x4){bflo(b.z), bfhi(b.z), bflo(b.w), bfhi(b.w)};
}
__device__ __forceinline__ void p2_copies(Frame& F) {
    const int gw = F.bid * NWAVES + F.wave, NGW = F.G * NWAVES;
    constexpr int NPP = 4 * 15, NPS = 128 * 15, NCP = 4 * 3 * 5, NCS = 128 * 3 * 5;
    for (int task = gw; task < NPP + NPS + NCP + NCS; task += NGW) {
        int t = task;
        if (t < NPP) { const int b = t / 15, r = t - b * 15; copy_seg_bf16(F.PROJ() + (size_t)(b * 2048 + 2033 + r) * PLD, F.out() + O_POOL_P + (size_t)t * DPOOL, F.lane); continue; }
        t -= NPP;
        if (t < NPS) { const int b = t / 15, r = t - b * 15; float* dst = F.out() + O_POOL_S + (size_t)t * DPOOL;
            if (r < 11) { const f32x4* sp = (const f32x4*)(F.state_pool() + (size_t)(b * 15 + r + 4) * DPOOL) + 4 * F.lane; f32x4* d = (f32x4*)dst + 4 * F.lane; d[0] = sp[0]; d[1] = sp[1]; d[2] = sp[2]; d[3] = sp[3]; }
            else copy_seg_bf16(F.PROJ() + (size_t)(NPR + b * 4 + r - 11) * PLD, dst, F.lane);
            continue; }
        t -= NPS;
        if (t < NCP) { const int row = t / 5, sg = t - row * 5, b = row / 3, r = row - b * 3;
            copy_seg_bf16(F.PROJ() + (size_t)(b * 2048 + 2045 + r) * PLD + C_XBC + sg * 1024, F.out() + O_CONV_P + (size_t)row * DCONV + sg * 1024, F.lane); continue; }
        t -= NCP;
        { const int row = t / 5, sg = t - row * 5, b = row / 3, r = row - b * 3;
          copy_seg_bf16(F.PROJ() + (size_t)(NPR + b * 4 + 1 + r) * PLD + C_XBC + sg * 1024, F.out() + O_CONV_S + (size_t)row * DCONV + sg * 1024, F.lane); }
    }
}

__device__ __forceinline__ void p3_gate_norm(Frame& F) {
    const int gw = F.bid * NWAVES + F.wave, NGW = F.G * NWAVES;
    for (int task = gw; task < NSM * NGRP; task += NGW) {
        const int m = NPR + (task >> 3), g = task & 7; float v[6]; float ss = 0.f;
#pragma unroll
        for (int k = 0; k < 6; ++k) { const int idx = g * 384 + F.lane + 64 * k; const float y = F.YBUF()[(size_t)m * DSSM + idx], z = bf2f(F.PROJ()[(size_t)m * PLD + C_Z + idx]);
            v[k] = y * silu_f(z); ss += v[k] * v[k]; }
        const float r = 1.f / sqrtf(wave_sum(ss) * (1.f / 384.f) + EPS);
#pragma unroll
        for (int k = 0; k < 6; ++k) { const int idx = g * 384 + F.lane + 64 * k; F.MIX()[(size_t)m * DMIX + DPOOL + idx] = (bf16)f2bf(v[k] * r * F.ssm_norm_g()[idx]); }
    }
}
__device__ __forceinline__ void p5_final_norm(Frame& F) {
    const int gw = F.bid * NWAVES + F.wave, NGW = F.G * NWAVES;
    for (int m = gw; m < MROWS; m += NGW) {
        GAS f32x4* yr = (GAS f32x4*)(F.out() + O_Y + (size_t)m * DMODEL) + F.lane; const GAS f32x4* gr = (const GAS f32x4*)F.final_g() + F.lane;
        f32x4 v[8]; float s = 0.f;
        if (m < NPR) {
#pragma unroll
            for (int j = 0; j < 8; ++j) v[j] = yr[64 * j];
        } else {
            const GAS f32x4* xr = (const GAS f32x4*)(F.x_sample() + (size_t)(m - NPR) * DMODEL) + F.lane;
#pragma unroll
            for (int j = 0; j < 8; ++j) v[j] = xr[64 * j];
#pragma unroll 4
            for (int sl = 0; sl < 16; ++sl) { const GAS f32x4* pr = (const GAS f32x4*)(F.YBUF() + (size_t)sl * (512 * 2048) + (size_t)(m - NPR) * DMODEL) + F.lane;
#pragma unroll
                for (int j = 0; j < 8; ++j) v[j] += pr[64 * j]; }
        }
#pragma unroll
        for (int j = 0; j < 8; ++j) s += (v[j].x * v[j].x + v[j].y * v[j].y) + (v[j].z * v[j].z + v[j].w * v[j].w);
        const float r = 1.f / sqrtf(wave_sum(s) * (1.f / DMODEL) + EPS);
#pragma unroll
        for (int j = 0; j < 8; ++j) { const f32x4 g = gr[64 * j]; yr[64 * j] = (f32x4){v[j].x * r * g.x, v[j].y * r * g.y, v[j].z * r * g.z, v[j].w * r * g.w}; }
    }
}

constexpr int N_PHASES = 10;
__global__ void __launch_bounds__(NTHR, 2) fwd(Args args) {
    extern __shared__ __attribute__((aligned(16))) unsigned char lds_raw[];
    Frame F{(LAS unsigned char*)lds_raw, (int)threadIdx.x, (int)(threadIdx.x & 63), __builtin_amdgcn_readfirstlane((int)(threadIdx.x >> 6)), (int)gridDim.x, (int)blockIdx.x, args};
    unsigned char* ws = args.ws;
    for (int u = F.tid; u < (LDS_BYTES - LDSCTL_OFF) / 4; u += NTHR) ((LAS unsigned*)(F.lds + LDSCTL_OFF))[u] = 0u;
    __syncthreads();
    const int lo = args.ph_lo, hi = args.ph_hi;
    XcdBarrier bar; bar.bar = (unsigned*)(ws + WS_CTL) + CW_BAR; bar.x = 0; bar.st = nullptr;
    if (hi - lo > 1) bar = xcd_barrier_post((unsigned*)(ws + WS_CTL) + CW_BAR, (volatile LAS unsigned*)(F.lds + MISC_OFF) + 8);
#define IN(k) (lo <= (k) && (k) < hi)
#define BOTH(k) (IN(k) && IN((k) + 1))
#ifndef PHMASK
#define PHMASK 0x3ff
#endif
    if ((PHMASK & 1) && IN(0)) { p0_prologue(F); if (BOTH(0)) xcd_barrier(bar); }
    if ((PHMASK & 2) && IN(1)) {
        pg8::Gemm g{F.XN(), F.WinT(), MROWS, NPROJ_PAD, DMODEL}; pg8::StaticOrder S; S.init(MROWS, NPROJ_PAD, DMODEL, F.G, F.bid);
        pg8::EpiProj E{F.PROJ(), F.DTRAW(), F.ZT()};
        pg8::gemm_phase<pg8::EpiProj, pg8::StaticOrder, true, true>(F.lds, g, S, E);
        if (BOTH(1)) xcd_barrier(bar);
    }
    const bool sfirst = (F.bid >> 3) & 1;
    if ((PHMASK & 8) && IN(3) && sfirst) { for (int u = F.bid; u < 512; u += F.G) sample_unit(F, u >> 3, u & 7); }
    if ((PHMASK & 4) && IN(2)) { for (int u = F.bid; u < 512; u += F.G) px_unit(F, u >> 7, (u >> 3) & 15, u & 7); }
    if ((PHMASK & 16) && IN(4)) { for (int u = F.bid; u < 544; u += F.G) pool_unit_mfma(F, u >> 2, u & 3); }
    if ((PHMASK & 8) && IN(3) && !sfirst) { for (int u = F.bid; u < 512; u += F.G) sample_unit(F, u >> 3, u & 7); }
    if ((PHMASK & 32) && IN(5)) { p2_copies(F); if (BOTH(5)) xcd_barrier(bar); }
    if ((PHMASK & 64) && IN(6)) { p2b_scan(F); if (BOTH(6)) xcd_barrier(bar); }
    if ((PHMASK & 128) && IN(7)) { for (int u = F.bid; u < 512; u += F.G) pz_unit(F, u >> 7, (u >> 3) & 15, u & 7); if (BOTH(7)) xcd_barrier(bar); }
    if ((PHMASK & 256) && IN(8)) {
        pg8::Gemm g{F.MIX(), F.WoutT(), MROWS, DMODEL, DMIX}; pg8::OutOrder S{F.bid};
        pg8::EpiOut2 E{F.x_prompt(), F.out(), F.YBUF()};
        pg8::gemm_phase<pg8::EpiOut2, pg8::OutOrder, true, true>(F.lds, g, S, E);
        if (BOTH(8)) xcd_barrier(bar);
    }
    if ((PHMASK & 512) && IN(9)) { p5_final_norm(F); }
#undef IN
#undef BOTH
}

#ifndef N_LAUNCHES
#define N_LAUNCHES 1
#endif
extern "C" void kernel_launch(void* const* d_in, const int* in_sizes, int n_in, void* d_out, int out_size, void* d_ws, size_t ws_size, hipStream_t stream) {
    static int grid = 0;
    if (grid == 0) {
        if (n_in != 17 || out_size != 73785344 || ws_size < WS_END) { fprintf(stderr, "kernel_launch: unexpected shapes: n_in %d out %d ws %zu\n", n_in, out_size, ws_size); grid = -1; return; }
        int dev = 0, cus = 0, per_cu = 0;
        if (hipGetDevice(&dev) != hipSuccess || hipDeviceGetAttribute(&cus, hipDeviceAttributeMultiprocessorCount, dev) != hipSuccess) { fprintf(stderr, "kernel_launch: device query failed\n"); grid = -1; return; }
        if (hipFuncSetAttribute((const void*)fwd, hipFuncAttributeMaxDynamicSharedMemorySize, LDS_BYTES) != hipSuccess) { fprintf(stderr, "kernel_launch: hipFuncSetAttribute failed\n"); grid = -1; return; }
        if (hipOccupancyMaxActiveBlocksPerMultiprocessor(&per_cu, (const void*)fwd, NTHR, LDS_BYTES) != hipSuccess || per_cu < 1) { fprintf(stderr, "kernel_launch: occupancy query says %d blocks per CU\n", per_cu); }
        (void)hipGetLastError();
        grid = cus;
    }
    if (grid < 0) return;
    (void)hipMemsetAsync((char*)d_ws + WS_CTL, 0, CTL_ZERO_BYTES, stream);
    Args a{};
    for (int i = 0; i < 17; ++i) a.in[i] = (const float*)d_in[i];
    a.out = (float*)d_out; a.ws = (unsigned char*)d_ws;
    if (N_LAUNCHES == 1) {
        a.ph_lo = 0; a.ph_hi = N_PHASES;
        void* kargs[] = {&a};
        hipError_t e = hipLaunchCooperativeKernel((const void*)fwd, dim3(grid), dim3(NTHR), kargs, LDS_BYTES, stream);
        if (e != hipSuccess) fprintf(stderr, "kernel_launch: cooperative launch failed: %s\n", hipGetErrorString(e));
#ifdef PROBE_PHASE
        a.ph_lo = PROBE_PHASE; a.ph_hi = PROBE_PHASE + 1; hipLaunchKernelGGL(fwd, dim3(grid), dim3(NTHR), LDS_BYTES, stream, a);
#ifdef PROBE_PHASE2
        a.ph_lo = PROBE_PHASE2; a.ph_hi = PROBE_PHASE2 + 1; hipLaunchKernelGGL(fwd, dim3(grid), dim3(NTHR), LDS_BYTES, stream, a);
#endif
#endif
    } else {
        for (int li = 0; li < N_PHASES; ++li) { a.ph_lo = li; a.ph_hi = li + 1; hipLaunchKernelGGL(fwd, dim3(grid), dim3(NTHR), LDS_BYTES, stream, a); }
    }
}
```
